# Optimizing an MI355X kernel written in HIP

```python
import jax, jax.numpy as jnp
from jax import lax
import numpy as np

D_MODEL = 1024
BATCH = 4
SEQ = 4096
DEPTH = 1
DEC_BATCH = 32
DEC_SEQ = 64
PAST_LEN = 2048

CHUNK = 64
D_CONV = 512
D_LRU = 512
D_MIX = D_CONV + D_LRU
N_LRU_HEADS = 8
LRU_HEAD_DIM = D_LRU // N_LRU_HEADS
CONV_A_WIDTH = 3
LRU_CONV_WIDTH = 4
LRU_C = 8.0
D_FF = 4 * D_MODEL
D_IN = 3 * D_CONV + 2 * D_LRU
EPS = 1e-6

kernel_name = "hymba_style_conv_rglru_stream_step"


def rms_norm(x, g):
    xf = x.astype(jnp.float32)
    y = xf * lax.rsqrt(jnp.mean(xf * xf, axis=-1, keepdims=True) + EPS)
    return (y * g.astype(jnp.float32)).astype(x.dtype)


def causal_depthwise_conv(x, buf, w):
    width = w.shape[0]
    t_len = x.shape[1]
    xp = jnp.concatenate([buf.astype(x.dtype), x], axis=1)
    y = xp[:, 0:t_len] * w[0]
    for k in range(1, width):
        y = y + xp[:, k:k + t_len] * w[k]
    return y, xp[:, t_len:]


def rg_lru(x, h0, wa, ba, wx, bx, a_param, reset_first):
    b_sz, t_len, _ = x.shape
    xh = x.reshape(b_sz, t_len, N_LRU_HEADS, LRU_HEAD_DIM)
    r = jax.nn.sigmoid(jnp.einsum("bthi,hij->bthj", xh, wa) + ba).reshape(b_sz, t_len, D_LRU)
    i = jax.nn.sigmoid(jnp.einsum("bthi,hij->bthj", xh, wx) + bx).reshape(b_sz, t_len, D_LRU)
    log_a = -LRU_C * r.astype(jnp.float32) * jax.nn.softplus(a_param.astype(jnp.float32))
    a = jnp.exp(log_a)
    mult = jnp.sqrt(-jnp.expm1(2.0 * log_a))
    if reset_first:
        mult = mult.at[:, 0].set(1.0)
    b = mult * (i * x).astype(jnp.float32)

    def step(h, ab):
        a_t, b_t = ab
        h = a_t * h + b_t
        return h, h

    h_last, hs = lax.scan(step, h0.astype(jnp.float32),
                          (jnp.swapaxes(a, 0, 1), jnp.swapaxes(b, 0, 1)))
    return jnp.swapaxes(hs, 0, 1).astype(x.dtype), h_last


def hybrid_layer(x, conv_a_buf, lru_buf, h0, reset_first, norm1_g, w_in, conv_a_w,
                 lru_conv_w, lru_conv_b, lru_wa, lru_ba, lru_wx, lru_bx, lru_a_param,
                 w_out, norm2_g, w_up, w_down):
    hn = rms_norm(x, norm1_g)
    proj = hn @ w_in
    g_b, g_c, x_a, x_l, g_l = jnp.split(
        proj, [D_CONV, 2 * D_CONV, 3 * D_CONV, 3 * D_CONV + D_LRU], axis=-1)
    c_a, new_conv_a = causal_depthwise_conv(g_c * x_a, conv_a_buf, conv_a_w)
    out_a = g_b * c_a
    c_l, new_lru_buf = causal_depthwise_conv(x_l, lru_buf, lru_conv_w)
    h_seq, h_last = rg_lru(c_l + lru_conv_b, h0, lru_wa, lru_ba, lru_wx, lru_bx,
                           lru_a_param, reset_first)
    out_b = h_seq * jax.nn.gelu(g_l)
    x = x + jnp.concatenate([out_a, out_b], axis=-1) @ w_out
    hm = rms_norm(x, norm2_g)
    x = x + jnp.square(jax.nn.relu(hm @ w_up)) @ w_down
    return x, new_conv_a, new_lru_buf, h_last


def setup_inputs(seed: int = 0) -> dict:
    key = jax.random.key(seed)
    ks = jax.random.split(key, 24)
    f32 = jnp.float32
    nrm = lambda k, s, scale: (jax.random.normal(k, s, f32) * scale)
    r0 = jax.random.uniform(ks[13], (DEPTH, D_LRU), f32, 0.9, 0.999)
    return {
        "x_prompt": nrm(ks[0], (BATCH, SEQ, D_MODEL), 1.0),
        "x_sample": nrm(ks[1], (DEC_BATCH, DEC_SEQ, D_MODEL), 1.0),
        "state_conv_a": nrm(ks[2], (DEPTH, DEC_BATCH, CONV_A_WIDTH - 1, D_CONV), 1.0),
        "state_lru_conv": nrm(ks[3], (DEPTH, DEC_BATCH, LRU_CONV_WIDTH - 1, D_LRU), 1.0),
        "state_lru_h": nrm(ks[4], (DEPTH, DEC_BATCH, D_LRU), 0.5),
        "norm1_g": 1.0 + nrm(ks[5], (DEPTH, D_MODEL), 0.02),
        "w_in": nrm(ks[6], (DEPTH, D_MODEL, D_IN), D_MODEL ** -0.5),
        "conv_a_w": nrm(ks[7], (DEPTH, CONV_A_WIDTH, D_CONV), CONV_A_WIDTH ** -0.5),
        "lru_conv_w": nrm(ks[8], (DEPTH, LRU_CONV_WIDTH, D_LRU), LRU_CONV_WIDTH ** -0.5),
        "lru_conv_b": nrm(ks[9], (DEPTH, D_LRU), 0.01),
        "lru_wa": nrm(ks[10], (DEPTH, N_LRU_HEADS, LRU_HEAD_DIM, LRU_HEAD_DIM), LRU_HEAD_DIM ** -0.5),
        "lru_ba": nrm(ks[11], (DEPTH, N_LRU_HEADS, LRU_HEAD_DIM), 0.01),
        "lru_wx": nrm(ks[12], (DEPTH, N_LRU_HEADS, LRU_HEAD_DIM, LRU_HEAD_DIM), LRU_HEAD_DIM ** -0.5),
        "lru_bx": nrm(ks[14], (DEPTH, N_LRU_HEADS, LRU_HEAD_DIM), 0.01),
        "lru_a_param": jnp.log(jnp.expm1(-jnp.log(r0))),
        "w_out": nrm(ks[15], (DEPTH, D_MIX, D_MODEL), D_MIX ** -0.5),
        "norm2_g": 1.0 + nrm(ks[16], (DEPTH, D_MODEL), 0.02),
        "w_up": nrm(ks[17], (DEPTH, D_MODEL, D_FF), D_MODEL ** -0.5),
        "w_down": nrm(ks[18], (DEPTH, D_FF, D_MODEL), D_FF ** -0.5),
        "norm_f_g": 1.0 + nrm(ks[19], (D_MODEL,), 0.02),
    }


def reference(x_prompt, x_sample, state_conv_a, state_lru_conv, state_lru_h,
              norm1_g, w_in, conv_a_w, lru_conv_w, lru_conv_b, lru_wa, lru_ba,
              lru_wx, lru_bx, lru_a_param, w_out, norm2_g, w_up, w_down, norm_f_g):
    n_p = x_prompt.shape[0]
    xp = x_prompt
    xs = x_sample
    pa, pl, ph, sa, sl, sh = [], [], [], [], [], []
    for l in range(DEPTH):
        layer_w = (norm1_g[l], w_in[l], conv_a_w[l], lru_conv_w[l], lru_conv_b[l],
                   lru_wa[l], lru_ba[l], lru_wx[l], lru_bx[l], lru_a_param[l],
                   w_out[l], norm2_g[l], w_up[l], w_down[l])
        zero_a = jnp.zeros((n_p, CONV_A_WIDTH - 1, D_CONV), xp.dtype)
        zero_l = jnp.zeros((n_p, LRU_CONV_WIDTH - 1, D_LRU), xp.dtype)
        zero_h = jnp.zeros((n_p, D_LRU), jnp.float32)
        xp, ca, cl, hl = hybrid_layer(xp, zero_a, zero_l, zero_h, True, *layer_w)
        pa.append(ca); pl.append(cl); ph.append(hl)
        xs, ca, cl, hl = hybrid_layer(xs, state_conv_a[l], state_lru_conv[l],
                                      state_lru_h[l], False, *layer_w)
        sa.append(ca); sl.append(cl); sh.append(hl)
    y_prompt = rms_norm(xp, norm_f_g)
    y_sample = rms_norm(xs, norm_f_g)
    return (y_prompt, y_sample, jnp.stack(pa), jnp.stack(pl), jnp.stack(ph),
            jnp.stack(sa), jnp.stack(sl), jnp.stack(sh))
```

```cpp
#include <hip/hip_runtime.h>
#include <hip/hip_cooperative_groups.h>
#include <cstdio>
#include <cstdint>
namespace cg = cooperative_groups;
#ifndef MK_MODE
#define MK_MODE 1
#endif
namespace pg8 {
#define PG8_LAS __attribute__((address_space(3)))
typedef unsigned short bf16_t;
typedef short bf16x8 __attribute__((ext_vector_type(8)));
typedef float f32x4 __attribute__((ext_vector_type(4)));
typedef unsigned u32x4 __attribute__((ext_vector_type(4)));
constexpr int BM = 256, BK = 64, HALF = 128, HTB = HALF * BK * 2  , STAGE_BYTES = 8 * HTB, NXCD = 8, WGM = 8;

__host__ __device__ __forceinline__ int lds_byte(int r, int c) { const int st = (r >> 4) * 2 + (c >> 5), rr = r & 15, cc = c & 31, ob = rr * 64 + cc * 2; return st * 1024 + (ob ^ (((ob >> 9) & 1) << 5)); }
__host__ __device__ __forceinline__ void stage_rc(int b, int& R, int& C) { const int st = b / 1024, sb = b % 1024, swz = sb ^ (((sb >> 9) & 1) << 5); R = (st >> 1) * 16 + swz / 64; C = (st & 1) * 32 + (swz % 64) / 2; }
__host__ __device__ __forceinline__ int perm32(int rho) { const int n = rho >> 4, i = rho & 15; return 8 * (i >> 2) + 4 * n + (i & 3); }

struct Unit { int pm, pn; };
struct Gemm { const bf16_t* A; const bf16_t* Bt; int M, N, K; };

struct StaticOrder {
    int nM, nN, nwg, G, c;
    __host__ __device__ void init(int M, int N, int G_, int c_) { nM = M / BM; nN = N / BM; nwg = nM * nN; G = G_; c = c_; }
    __host__ __device__ bool next(int i, Unit& u) const {
        const long L = (long)i * G + c; if (L >= nwg) return false;
        int wgid = (int)L; { const int q = nwg / NXCD, r = nwg % NXCD, xcd = wgid % NXCD, off = wgid / NXCD; wgid = (xcd < r ? xcd * (q + 1) : r * (q + 1) + (xcd - r) * q) + off; }
        const int nig = WGM * nN, gid = wgid / nig, fm = gid * WGM, gsz = (nM - fm) < WGM ? (nM - fm) : WGM;
        u.pm = fm + ((wgid % nig) % gsz); u.pn = (wgid % nig) / gsz; return true;
    }
    __device__ __forceinline__ void a_ready(const Unit&) const {}
    __device__ __forceinline__ void done(const Unit&) const {}
};

__device__ __forceinline__ unsigned cvt_pk_bf16(float lo, float hi) { unsigned r; asm volatile("v_cvt_pk_bf16_f32 %0, %1, %2" : "=v"(r) : "v"(lo), "v"(hi)); return r; }
typedef float f32x2 __attribute__((ext_vector_type(2)));
__device__ __forceinline__ f32x2 gelu_pk(f32x2 v) {
    const f32x2 av = __builtin_elementwise_abs(v), d = av * 0.2316418882f + 1.0f;
    f32x2 t; t.x = __builtin_amdgcn_rcpf(d.x); t.y = __builtin_amdgcn_rcpf(d.y);
    f32x2 q = t * 0.5307027145f + (-0.7265760135f); q = q * t + 0.7107068705f; q = q * t + (-0.142248368f); q = q * t + 0.127414796f; q = q * t;
    const f32x2 s = (v * v) * (-0.72134752044f);
    f32x2 e; e.x = __builtin_amdgcn_exp2f(s.x); e.y = __builtin_amdgcn_exp2f(s.y);
    const f32x2 m = v * (q * e), r = v - m;
    f32x2 o; o.x = v.x < 0.f ? m.x : r.x; o.y = v.y < 0.f ? m.y : r.y; return o;
}

typedef unsigned u32x2 __attribute__((ext_vector_type(2)));
struct EpiProj {
    static constexpr bool PERM = true, AFTER_DRAIN = false;
    bf16_t* O; int ldc;
    __device__ __forceinline__ void operator()(const f32x4 (&acc)[2][2][4][2], const Unit& u, int wr, int wc, int fr, int fq) const {
        const int row0 = u.pm * BM + wr * 64 + fr, col0 = u.pn * BM + wc * 32 + 8 * fq;
#pragma unroll
        for (int ai = 0; ai < 2; ++ai)
#pragma unroll
            for (int m = 0; m < 4; ++m) { bf16_t* rowp = O + (size_t)(row0 + ai * HALF + m * 16) * ldc + col0;
#pragma unroll
                for (int bj = 0; bj < 2; ++bj) { const f32x4 v0 = acc[ai][bj][m][0], v1 = acc[ai][bj][m][1];
                    u32x4 w; w.x = cvt_pk_bf16(v0[0], v0[1]); w.y = cvt_pk_bf16(v0[2], v0[3]); w.z = cvt_pk_bf16(v1[0], v1[1]); w.w = cvt_pk_bf16(v1[2], v1[3]);
                    *(u32x4*)(rowp + bj * HALF) = w; } }
    }
};
struct EpiX1 {
    static constexpr bool PERM = false, AFTER_DRAIN = false;
    const float* xp; const float* xs; float* out; bf16_t* x1b; float* ss;
    __device__ __forceinline__ void operator()(const f32x4 (&acc)[2][2][4][2], const Unit& u, int wr, int wc, int fr, int fq) const {
        const int row0 = u.pm * BM + wr * 64 + fr, col0 = u.pn * BM + wc * 32 + 4 * fq;
        const float* xin = (u.pm < 64) ? xp : xs - (size_t)16384 * 1024;
#pragma unroll
        for (int ai = 0; ai < 2; ++ai)
#pragma unroll
            for (int m = 0; m < 4; ++m) { const size_t off = (size_t)(row0 + ai * HALF + m * 16) * 1024 + col0; float s = 0.f;
#pragma unroll
                for (int bj = 0; bj < 2; ++bj)
#pragma unroll
                    for (int n = 0; n < 2; ++n) { const size_t o = off + bj * HALF + n * 16; const f32x4 v = *(const f32x4*)(xin + o) + acc[ai][bj][m][n];
                        *(f32x4*)(out + o) = v; u32x2 w; w.x = cvt_pk_bf16(v[0], v[1]); w.y = cvt_pk_bf16(v[2], v[3]); *(u32x2*)(x1b + o) = w;
                        s += (v[0] * v[0] + v[1] * v[1]) + (v[2] * v[2] + v[3] * v[3]); }
                s += __shfl_xor(s, 16); s += __shfl_xor(s, 32);
                if (fq == 0) ss[(size_t)(row0 + ai * HALF + m * 16) * 16 + u.pn * 4 + wc] = s; }
    }
};
struct EpiUp {
    static constexpr bool PERM = true, AFTER_DRAIN = false;
    bf16_t* H; const float* ss; float eps;
    __device__ __forceinline__ void operator()(const f32x4 (&acc)[2][2][4][2], const Unit& u, int wr, int wc, int fr, int fq) const {
        const int row0 = u.pm * BM + wr * 64 + fr, col0 = u.pn * BM + wc * 32 + 8 * fq;
#pragma unroll
        for (int ai = 0; ai < 2; ++ai)
#pragma unroll
            for (int m = 0; m < 4; ++m) { const int r = row0 + ai * HALF + m * 16; const f32x4* sp = (const f32x4*)(ss + (size_t)r * 16);
                const f32x4 t = (sp[0] + sp[1]) + (sp[2] + sp[3]); const float rs2 = 1.0f / (((t[0] + t[1]) + (t[2] + t[3])) * (1.0f / 1024.0f) + eps);
                bf16_t* rowp = H + (size_t)r * 4096 + col0;
#pragma unroll
                for (int bj = 0; bj < 2; ++bj) { f32x4 v0 = acc[ai][bj][m][0], v1 = acc[ai][bj][m][1];
#pragma unroll
                    for (int j = 0; j < 4; ++j) { const float a = fmaxf(v0[j], 0.f), b = fmaxf(v1[j], 0.f); v0[j] = a * a * rs2; v1[j] = b * b * rs2; }
                    u32x4 w; w.x = cvt_pk_bf16(v0[0], v0[1]); w.y = cvt_pk_bf16(v0[2], v0[3]); w.z = cvt_pk_bf16(v1[0], v1[1]); w.w = cvt_pk_bf16(v1[2], v1[3]);
                    *(u32x4*)(rowp + bj * HALF) = w; } }
    }
};
struct EpiDown {
    static constexpr bool PERM = false, AFTER_DRAIN = false;
    float* out;
    __device__ __forceinline__ void operator()(const f32x4 (&acc)[2][2][4][2], const Unit& u, int wr, int wc, int fr, int fq) const {
        const int row0 = u.pm * BM + wr * 64 + fr, col0 = u.pn * BM + wc * 32 + 4 * fq;
#pragma unroll
        for (int ai = 0; ai < 2; ++ai)
#pragma unroll
            for (int m = 0; m < 4; ++m) { float* rowp = out + (size_t)(row0 + ai * HALF + m * 16) * 1024 + col0;
#pragma unroll
                for (int bj = 0; bj < 2; ++bj)
#pragma unroll
                    for (int n = 0; n < 2; ++n) { f32x4* p = (f32x4*)(rowp + bj * HALF + n * 16); *p = *p + acc[ai][bj][m][n]; } }
    }
};

template <class Epi, class Sched, bool ALIGN_EPI = false, bool SP2 = false>
__device__ __forceinline__ void gemm_phase(PG8_LAS unsigned char* lds, const Gemm g, const Sched& S, const Epi& E) {
    const int tid = threadIdx.x, wid = __builtin_amdgcn_readfirstlane(tid >> 6), lane = tid & 63, wr = wid >> 2, wc = wid & 3, fr = lane & 15, fq = lane >> 4;
    const int K = g.K, nt = K / BK;
    unsigned voffA[2], voffB[2];
#pragma unroll
    for (int i = 0; i < 2; ++i) { int R, C; stage_rc(tid * 16 + i * 8192, R, C); const int Rb = Epi::PERM ? ((R & ~31) + perm32(R & 31)) : R;
        voffA[i] = (unsigned)(R * K + C) * 2u; voffB[i] = (unsigned)(Rb * K + C) * 2u; }
    const size_t kstep = (size_t)(BK * 2);
    const size_t hstep = (size_t)HALF * K * 2;
    const size_t tstep = 2 * hstep;
    const unsigned ldsw = (unsigned)wid * 1024u;
    const int aoff = lds_byte(wr * 64 + fr, fq * 8), boff = lds_byte(wc * 32 + fr, fq * 8);
#define PG8_SA(b, h) (((b) * 2 + (h)) * HTB)
#define PG8_SB(b, h) ((4 + (b) * 2 + (h)) * HTB)
#define PG8_STAGE(bufoff, gbase, voff) do { _Pragma("unroll") for (int _i = 0; _i < 2; ++_i) \
        __builtin_amdgcn_global_load_lds((const unsigned*)((const char*)(gbase) + (voff)[_i]), (PG8_LAS unsigned*)(lds + (bufoff) + ldsw + _i * 8192), 16, 0, 0); } while (0)
#define PG8_LDA(dst, b, h) do { _Pragma("unroll") for (int m = 0; m < 4; ++m) _Pragma("unroll") for (int k = 0; k < 2; ++k) dst[m][k] = *(const PG8_LAS bf16x8*)(lds + PG8_SA(b, h) + aoff + m * 2048 + k * 1024); } while (0)
#define PG8_LDB(dst, b, h) do { _Pragma("unroll") for (int n = 0; n < 2; ++n) _Pragma("unroll") for (int k = 0; k < 2; ++k) dst[n][k] = *(const PG8_LAS bf16x8*)(lds + PG8_SB(b, h) + boff + n * 2048 + k * 1024); } while (0)
#define PG8_MMA(ai, bj, At, Bt) do { __builtin_amdgcn_s_setprio(1); _Pragma("unroll") for (int m = 0; m < 4; ++m) _Pragma("unroll") for (int n = 0; n < 2; ++n) _Pragma("unroll") for (int k = 0; k < 2; ++k) \
        acc[ai][bj][m][n] = __builtin_amdgcn_mfma_f32_16x16x32_bf16(Bt[n][k], At[m][k], acc[ai][bj][m][n], 0, 0, 0); __builtin_amdgcn_s_setprio(0); } while (0)
#define PG8_WAIT_V(n) asm volatile("s_waitcnt vmcnt(" #n ")" ::: "memory")
#define PG8_WAIT_L(n) asm volatile("s_waitcnt lgkmcnt(" #n ")" ::: "memory")
#define PG8_BAR __builtin_amdgcn_s_barrier()
#define PG8_SCHED __builtin_amdgcn_sched_barrier(0)
    Unit cur, nxt; int ui = 0;
    if (!S.next(0, cur)) return;
    f32x4 acc[2][2][4][2];
#pragma unroll
    for (int a = 0; a < 2; ++a)
#pragma unroll
        for (int b = 0; b < 2; ++b)
#pragma unroll
            for (int m = 0; m < 4; ++m)
#pragma unroll
                for (int n = 0; n < 2; ++n) acc[a][b][m][n] = (f32x4){0.f, 0.f, 0.f, 0.f};
    bf16x8 At[4][2], B0[2][2], B1[2][2];
    const char* cA = (const char*)g.A + (size_t)cur.pm * tstep; const char* cB = (const char*)g.Bt + (size_t)cur.pn * tstep;
    S.a_ready(cur);
    if constexpr (SP2) {
        PG8_STAGE(PG8_SB(0, 0), cB, voffB); PG8_STAGE(PG8_SB(0, 1), cB + hstep, voffB); PG8_STAGE(PG8_SA(0, 0), cA, voffA); PG8_STAGE(PG8_SA(0, 1), cA + hstep, voffA);
        if (wr == 1) PG8_BAR;
        PG8_WAIT_V(2); PG8_BAR;
        PG8_STAGE(PG8_SB(1, 0), cB + kstep, voffB); PG8_STAGE(PG8_SA(1, 0), cA + kstep, voffA); PG8_STAGE(PG8_SB(1, 1), cB + hstep + kstep, voffB);
        PG8_WAIT_V(6); PG8_BAR;
    } else {
        PG8_STAGE(PG8_SB(0, 0), cB, voffB); PG8_STAGE(PG8_SA(0, 0), cA, voffA); PG8_STAGE(PG8_SB(0, 1), cB + hstep, voffB); PG8_STAGE(PG8_SA(0, 1), cA + hstep, voffA);
        if (wr == 1) PG8_BAR;
        PG8_WAIT_V(4); PG8_BAR;
        PG8_STAGE(PG8_SB(1, 0), cB + kstep, voffB); PG8_STAGE(PG8_SA(1, 0), cA + kstep, voffA); PG8_STAGE(PG8_SB(1, 1), cB + hstep + kstep, voffB);
        PG8_WAIT_V(6); PG8_BAR;
    }
    for (;;) {
        const bool has_next = S.next(ui + 1, nxt);
        const char* nA = has_next ? (const char*)g.A + (size_t)nxt.pm * tstep : cA; const char* nB = has_next ? (const char*)g.Bt + (size_t)nxt.pn * tstep : cB;
        for (int t = 0; t < nt; t += 2) {
            const bool last = (t == nt - 2);
            const char* a1 = cA + (size_t)(t + 1) * kstep;
            const char* a2 = last ? nA : cA + (size_t)(t + 2) * kstep; const char* b2 = last ? nB : cB + (size_t)(t + 2) * kstep;
            const char* a3 = a2 + kstep; const char* b3 = b2 + kstep;
            if (last && has_next) S.a_ready(nxt);
            if constexpr (SP2) {
            PG8_LDB(B0, 0, 0); PG8_LDB(B1, 0, 1); PG8_SCHED; PG8_LDA(At, 0, 0); PG8_STAGE(PG8_SA(1, 1), a1 + hstep, voffA);
            PG8_WAIT_V(8); PG8_WAIT_L(0); PG8_BAR; PG8_MMA(0, 0, At, B0); PG8_MMA(0, 1, At, B1); PG8_BAR; PG8_SCHED;
            PG8_LDA(At, 0, 1); PG8_STAGE(PG8_SB(0, 0), b2, voffB); PG8_STAGE(PG8_SB(0, 1), b2 + hstep, voffB); PG8_STAGE(PG8_SA(0, 0), a2, voffA);
            PG8_WAIT_V(8); PG8_WAIT_L(0); PG8_BAR; PG8_MMA(1, 0, At, B0); PG8_MMA(1, 1, At, B1); PG8_BAR; PG8_SCHED;
            PG8_LDB(B0, 1, 0); PG8_LDB(B1, 1, 1); PG8_SCHED; PG8_LDA(At, 1, 0); PG8_STAGE(PG8_SA(0, 1), a2 + hstep, voffA);
            PG8_WAIT_V(8); PG8_WAIT_L(0); PG8_BAR; PG8_MMA(0, 0, At, B0); PG8_MMA(0, 1, At, B1); PG8_BAR; PG8_SCHED;
            PG8_LDA(At, 1, 1); PG8_STAGE(PG8_SB(1, 0), b3, voffB); PG8_STAGE(PG8_SB(1, 1), b3 + hstep, voffB); PG8_STAGE(PG8_SA(1, 0), a3, voffA);
            PG8_WAIT_V(8); PG8_WAIT_L(0); PG8_BAR; PG8_MMA(1, 0, At, B0); PG8_MMA(1, 1, At, B1); PG8_BAR; PG8_SCHED;
            } else {
            PG8_LDB(B0, 0, 0); PG8_SCHED; PG8_LDA(At, 0, 0); PG8_STAGE(PG8_SA(1, 1), a1 + hstep, voffA);
            PG8_WAIT_L(8); PG8_BAR; PG8_WAIT_L(0); PG8_MMA(0, 0, At, B0); PG8_BAR; PG8_SCHED;
            PG8_LDB(B1, 0, 1); PG8_STAGE(PG8_SB(0, 0), b2, voffB);
            PG8_BAR; PG8_WAIT_L(0); PG8_MMA(0, 1, At, B1); PG8_BAR;
            PG8_LDA(At, 0, 1); PG8_STAGE(PG8_SA(0, 0), a2, voffA);
            PG8_BAR; PG8_WAIT_L(0); PG8_MMA(1, 0, At, B0); PG8_BAR; PG8_SCHED;
            PG8_STAGE(PG8_SB(0, 1), b2 + hstep, voffB);
            PG8_WAIT_V(6); PG8_BAR; PG8_MMA(1, 1, At, B1); PG8_BAR;
            PG8_LDB(B0, 1, 0); PG8_SCHED; PG8_LDA(At, 1, 0); PG8_STAGE(PG8_SA(0, 1), a2 + hstep, voffA);
            PG8_WAIT_L(8); PG8_BAR; PG8_WAIT_L(0); PG8_MMA(0, 0, At, B0); PG8_BAR; PG8_SCHED;
            PG8_LDB(B1, 1, 1); PG8_STAGE(PG8_SB(1, 0), b3, voffB);
            PG8_BAR; PG8_WAIT_L(0); PG8_MMA(0, 1, At, B1); PG8_BAR;
            PG8_LDA(At, 1, 1); PG8_STAGE(PG8_SA(1, 0), a3, voffA);
            PG8_BAR; PG8_WAIT_L(0); PG8_MMA(1, 0, At, B0); PG8_BAR; PG8_SCHED;
            PG8_STAGE(PG8_SB(1, 1), b3 + hstep, voffB);
            PG8_WAIT_V(6); PG8_BAR; PG8_MMA(1, 1, At, B1); PG8_BAR;
            }
        }
        if constexpr (ALIGN_EPI) { if (wr == 0) PG8_BAR; }
        if constexpr (!Epi::AFTER_DRAIN) { E(acc, cur, wr, wc, fr, fq); S.done(cur); }
        if (!has_next) break;
#pragma unroll
        for (int a = 0; a < 2; ++a)
#pragma unroll
            for (int b = 0; b < 2; ++b)
#pragma unroll
                for (int m = 0; m < 4; ++m)
#pragma unroll
                    for (int n = 0; n < 2; ++n) acc[a][b][m][n] = (f32x4){0.f, 0.f, 0.f, 0.f};
        cur = nxt; cA = nA; cB = nB; ++ui;
        if constexpr (ALIGN_EPI) { if (wr == 1) PG8_BAR; }
    }
    PG8_WAIT_V(0);
    if constexpr (!ALIGN_EPI) { if (wr == 0) PG8_BAR; }
    PG8_BAR;
    if constexpr (Epi::AFTER_DRAIN) { E.fused(acc, cur, wr, wc, fr, fq, lds, wid, lane); S.done(cur); }
#undef PG8_SA
#undef PG8_SB
#undef PG8_STAGE
#undef PG8_LDA
#undef PG8_LDB
#undef PG8_MMA
#undef PG8_WAIT_V
#undef PG8_WAIT_L
#undef PG8_BAR
#undef PG8_SCHED
}
}
#ifndef PG8_SP2
#define PG8_SP2 true
#endif
#ifndef PG8_ALIGN
#define PG8_ALIGN true
#endif
constexpr int NWAVES = 8;
constexpr int D = 1024, DIN = 2560, FF = 4096, DC = 512, DL = 512;
constexpr int MP = 4 * 4096, MS = 32 * 64, M = MP + MS;
constexpr int NCHUNK = M / 64, NPCHUNK = MP / 64;
constexpr float EPS = 1e-6f;
constexpr size_t O_YP = 0, O_YS = (size_t)MP * D, O_CAP = (size_t)M * D, O_LCP = O_CAP + 4 * 2 * 512, O_LHP = O_LCP + 4 * 3 * 512, O_CAS = O_LHP + 4 * 512, O_LCS = O_CAS + 32 * 2 * 512, O_LHS = O_LCS + 32 * 3 * 512, O_END = O_LHS + 32 * 512;
constexpr size_t MiB = 1u << 20;
constexpr size_t WS_CTL = 0, CTL_ZERO_BYTES = 1 * MiB;
constexpr size_t WS_WIN = 2 * MiB, WS_WOUT = 8 * MiB, WS_WUP = 10 * MiB, WS_WDN = 18 * MiB;
constexpr size_t WS_GW = 26 * MiB;
constexpr size_t WS_HC = WS_GW + 131072;
constexpr size_t WS_SS = 27 * MiB;
constexpr size_t WS_SUM = 29 * MiB;
constexpr size_t WS_XN = 32 * MiB;
constexpr size_t WS_H = 68 * MiB;
constexpr size_t WS_PROJ = 68 * MiB;
constexpr size_t WS_MIX = 160 * MiB;
constexpr size_t WS_END = 212 * MiB;
static_assert(WS_XN + (size_t)M * D * 2 <= WS_H && WS_PROJ + (size_t)M * DIN * 2 <= WS_MIX && WS_MIX + (size_t)M * D * 2 <= WS_END && WS_H + (size_t)M * FF * 2 <= WS_END, "d_ws map");
static_assert(WS_SS + (size_t)M * 16 * 4 <= WS_SUM && WS_SUM + (size_t)NPCHUNK * 2 * 512 * 4 <= WS_XN, "d_ws map (small)");
constexpr int CW_BAR = 4096;
constexpr int RING_OFF = 0, RING_BYTES = 131072;
constexpr int LDSCTL_OFF = RING_BYTES, MISC_OFF = LDSCTL_OFF + 320;
constexpr int LDS_BYTES = 147456;
#define GAS __attribute__((address_space(1)))
#define LAS __attribute__((address_space(3)))
typedef unsigned short bf16;
typedef unsigned v4u __attribute__((ext_vector_type(4)));
typedef unsigned v2u __attribute__((ext_vector_type(2)));
typedef float f32x4 __attribute__((ext_vector_type(4)));
typedef short bf16x8 __attribute__((ext_vector_type(8)));
typedef GAS unsigned gu32;
#define RLX_AGENT __ATOMIC_RELAXED, __HIP_MEMORY_SCOPE_AGENT
#define LDS_WAIT() asm volatile("s_waitcnt lgkmcnt(0)" ::: "memory")
#define VM_WAIT() asm volatile("s_waitcnt vmcnt(0)" ::: "memory")
__device__ __forceinline__ unsigned f2bf(float f) { unsigned u = __builtin_bit_cast(unsigned, f); return (u + 0x7fffu + ((u >> 16) & 1u)) >> 16; }
__device__ __forceinline__ unsigned pk2(float lo, float hi) { return f2bf(lo) | (f2bf(hi) << 16); }
__device__ __forceinline__ f32x4 ld_bf16x4(const bf16* p) { const v2u w = *(const v2u*)p; f32x4 r; r.x = __uint_as_float(w.x << 16); r.y = __uint_as_float(w.x & 0xffff0000u); r.z = __uint_as_float(w.y << 16); r.w = __uint_as_float(w.y & 0xffff0000u); return r; }
__device__ __forceinline__ void st_bf16x4(bf16* p, f32x4 v) { v2u w; w.x = pg8::cvt_pk_bf16(v.x, v.y); w.y = pg8::cvt_pk_bf16(v.z, v.w); *(v2u*)p = w; }
__device__ __forceinline__ float fast_rcp(float x) { return __builtin_amdgcn_rcpf(x); }
__device__ __forceinline__ float fast_exp(float x) { return __builtin_amdgcn_exp2f(x * 1.44269504089f); }
__device__ __forceinline__ float sigmoidf_(float x) { return fast_rcp(1.0f + fast_exp(-x)); }
template <int S> __device__ __forceinline__ float dpp_shr(float v, float ident) {
    return __builtin_bit_cast(float, __builtin_amdgcn_update_dpp(__builtin_bit_cast(int, ident), __builtin_bit_cast(int, v), 0x110 + S, 0xf, 0xf, false));
}
#if MK_MODE == 2
#define XB_TMO      128
#define XB_XCNT(j)  (256  + 64 * (j))
#define XB_XSUB(j)  (1280 + 64 * (j))
#define XB_XGEN(j)  (2304 + 64 * (j))
#define XB_TOP      3328
#define XB_TOPGEN   3392
#define XCD_BAR_WORDS 3456
#define XB_SPIN_CAP (1u << 18)

__device__ __forceinline__ unsigned xb_ld(unsigned* p)              { return __hip_atomic_load(p, __ATOMIC_RELAXED, __HIP_MEMORY_SCOPE_AGENT); }
__device__ __forceinline__ unsigned xb_add(unsigned* p, unsigned v) { return __hip_atomic_fetch_add(p, v, __ATOMIC_RELAXED, __HIP_MEMORY_SCOPE_AGENT); }
__device__ __forceinline__ unsigned xb_xcc_id() { return (unsigned)__builtin_amdgcn_s_getreg((3 << 11) | 20) & 0xFu; }
#define XB_SPIN(cond, bar) do { unsigned _sp = 0; while (cond) { __builtin_amdgcn_s_sleep(1); \
    if ((++_sp & 255u) == 0u) { if (xb_ld(&(bar)[XB_TMO])) break; if (_sp > XB_SPIN_CAP) { atomicAdd(&(bar)[XB_TMO], 1u); break; } } } } while (0)

struct XcdBarrier {
    unsigned* bar; unsigned x;
    volatile LAS unsigned* st;
};

__device__ __forceinline__ XcdBarrier xcd_barrier_post(unsigned* bar, volatile LAS unsigned* st) {
    XcdBarrier b; b.bar = bar; b.x = xb_xcc_id(); b.st = st;
    if (threadIdx.x == 0) (void)xb_add(&bar[XB_XCNT(b.x)], 1u);
    return b;
}
__device__ __forceinline__ void xcd_barrier_complete(unsigned* bar, unsigned x, unsigned& nloc, unsigned& nx) {
    const unsigned G = gridDim.x * gridDim.y * gridDim.z;
    unsigned sum, cnt, mine, sp = 0u;
    for (;;) {
        sum = 0u; cnt = 0u; mine = 0u;
#pragma unroll
        for (unsigned j = 0; j < 16; ++j) { const unsigned c = xb_ld(&bar[XB_XCNT(j)]); sum += c; cnt += (c > 0u) ? 1u : 0u; mine = (j == x) ? c : mine; }
        if (sum == G) break;
        __builtin_amdgcn_s_sleep(1);
        if ((++sp & 255u) == 0u) { if (xb_ld(&bar[XB_TMO])) break; if (sp > XB_SPIN_CAP) { atomicAdd(&bar[XB_TMO], 1u); break; } }
    }
    nloc = mine > 0u ? mine : 1u; nx = cnt > 0u ? cnt : 1u;
}

__device__ __forceinline__ void xcd_barrier(const XcdBarrier& b) {
    asm volatile("s_waitcnt vmcnt(0)" ::: "memory");
    __syncthreads();
    if (threadIdx.x == 0) {
        unsigned* bar = b.bar;
        __builtin_amdgcn_s_waitcnt(0);
        unsigned nloc = b.st[0], nx = b.st[1];
        if (nloc == 0u) { xcd_barrier_complete(bar, b.x, nloc, nx); b.st[0] = nloc; b.st[1] = nx; }
        const unsigned old = xb_add(&bar[XB_XSUB(b.x)], 1u);
        const unsigned gen = old / nloc;
        if (old + 1u == (gen + 1u) * nloc) {
            __builtin_amdgcn_fence(__ATOMIC_RELEASE, "agent");
            asm volatile("s_waitcnt vmcnt(0)" ::: "memory");
            const unsigned og = xb_add(&bar[XB_TOP], 1u);
            const unsigned tg = og / nx;
            if (og + 1u == (tg + 1u) * nx) xb_add(&bar[XB_TOPGEN], 1u);
            else XB_SPIN(xb_ld(&bar[XB_TOPGEN]) == tg, bar);
            __builtin_amdgcn_fence(__ATOMIC_ACQUIRE, "agent");
            xb_add(&bar[XB_XGEN(b.x)], 1u);
            asm volatile("s_waitcnt vmcnt(0)" ::: "memory");
        } else {
            XB_SPIN(xb_ld(&bar[XB_XGEN(b.x)]) == gen, bar);
            __builtin_amdgcn_fence(__ATOMIC_ACQUIRE, "agent");
            asm volatile("s_waitcnt vmcnt(0)" ::: "memory");
        }
    }
    __syncthreads();
}
#endif
struct Args {
    const float* xp; const float* xs; const float* st_ca; const float* st_lc; const float* st_lh; const float* g1; const float* w_in; const float* conv_a_w; const float* lru_conv_w;
    const float* lru_conv_b; const float* lru_wa; const float* lru_ba; const float* lru_wx; const float* lru_bx; const float* lru_a_param; const float* w_out; const float* g2;
    const float* w_up; const float* w_down; const float* gf; float* out; unsigned char* ws; int ph_lo, ph_hi;
};
__device__ __forceinline__ float wave_sum(float v) {
#pragma unroll
    for (int o = 1; o < 64; o <<= 1) v += __shfl_xor(v, o);
    return v;
}
__device__ __forceinline__ void p0_transpose_item(const float* W, const float* g, int K, int N, bf16* WT, LAS float* scr, int item, int lane) {
    const int nblk = N / 32, kb = item / nblk, nb = item % nblk, k0 = 64 * kb, n0 = 32 * nb;
#pragma unroll 8
    for (int i = 0; i < 32; ++i) { const int kk = 2 * i + (lane >> 5); float v = W[(size_t)(k0 + kk) * N + n0 + (lane & 31)]; if (g) v *= g[k0 + kk]; scr[kk * 33 + (lane & 31)] = v; }
    LDS_WAIT(); asm volatile("" ::: "memory");
    const int c = lane & 7;
#pragma unroll
    for (int j = 0; j < 4; ++j) { const int n = (lane >> 3) + 8 * j; const LAS float* s = scr + (8 * c) * 33 + n;
        v4u o; o.x = pk2(s[0 * 33], s[1 * 33]); o.y = pk2(s[2 * 33], s[3 * 33]); o.z = pk2(s[4 * 33], s[5 * 33]); o.w = pk2(s[6 * 33], s[7 * 33]);
        *(GAS v4u*)(WT + (size_t)(n0 + n) * K + k0 + 8 * c) = o; }
    LDS_WAIT(); asm volatile("" ::: "memory");
}
__device__ __forceinline__ void rms_row_bf16(const float* xrow, const float* g, bf16* orow, int lane) {
    const GAS f32x4* xr = (const GAS f32x4*)xrow + lane; const GAS f32x4* gr = (const GAS f32x4*)g + lane;
    f32x4 v[4]; float s = 0.f;
#pragma unroll
    for (int j = 0; j < 4; ++j) { v[j] = xr[64 * j]; s += (v[j].x * v[j].x + v[j].y * v[j].y) + (v[j].z * v[j].z + v[j].w * v[j].w); }
    const float rs = 1.0f / sqrtf(wave_sum(s) * (1.f / D) + EPS);
    GAS v2u* o8 = (GAS v2u*)orow + lane;
#pragma unroll
    for (int j = 0; j < 4; ++j) { const f32x4 gg = gr[64 * j]; v2u w; w.x = pk2(v[j].x * rs * gg.x, v[j].y * rs * gg.y); w.y = pk2(v[j].z * rs * gg.z, v[j].w * rs * gg.w); o8[64 * j] = w; }
}
__device__ __forceinline__ void rms_row_f32_inplace(float* xrow, const float* g, int lane) {
    GAS f32x4* xr = (GAS f32x4*)xrow + lane; const GAS f32x4* gr = (const GAS f32x4*)g + lane;
    f32x4 v[4]; float s = 0.f;
#pragma unroll
    for (int j = 0; j < 4; ++j) { v[j] = xr[64 * j]; s += (v[j].x * v[j].x + v[j].y * v[j].y) + (v[j].z * v[j].z + v[j].w * v[j].w); }
    const float rs = 1.0f / sqrtf(wave_sum(s) * (1.f / D) + EPS);
#pragma unroll
    for (int j = 0; j < 4; ++j) { const f32x4 gg = gr[64 * j]; xr[64 * j] = v[j] * rs * gg; }
}
__device__ __forceinline__ void p0_prologue(const Args& A, LAS unsigned char* lds, int gw, int NGW, int wave, int lane) {
    LAS float* scr = (LAS float*)(lds + RING_OFF + wave * 16384);
    unsigned char* ws = A.ws;
    constexpr int I_IN = (D / 64) * (DIN / 32), I_OUT = (D / 64) * (D / 32), I_UP = (D / 64) * (FF / 32), I_DN = (FF / 64) * (D / 32);
    constexpr int NITEMS = I_IN + I_OUT + I_UP + I_DN;
    for (int it = gw; it < NITEMS; it += NGW) {
        int r = it;
        if (r < I_IN) { p0_transpose_item(A.w_in, nullptr, D, DIN, (bf16*)(ws + WS_WIN), scr, r, lane); continue; } r -= I_IN;
        if (r < I_OUT) { p0_transpose_item(A.w_out, nullptr, D, D, (bf16*)(ws + WS_WOUT), scr, r, lane); continue; } r -= I_OUT;
        if (r < I_UP) { p0_transpose_item(A.w_up, A.g2, D, FF, (bf16*)(ws + WS_WUP), scr, r, lane); continue; } r -= I_UP;
        p0_transpose_item(A.w_down, nullptr, FF, D, (bf16*)(ws + WS_WDN), scr, r, lane);
    }
    for (int idx = gw; idx < 128; idx += NGW) {
        const int hd = idx >> 4, gate = (idx >> 3) & 1, jt = (idx >> 1) & 3, ks = idx & 1, jj = lane & 15, q = lane >> 4;
        const float* W = (gate ? A.lru_wx : A.lru_wa) + hd * 4096 + 16 * jt + jj;
        float v[8];
#pragma unroll
        for (int e = 0; e < 8; ++e) v[e] = W[(32 * ks + 16 * (e >> 2) + 4 * q + (e & 3)) * 64];
        v4u o; o.x = pk2(v[0], v[1]); o.y = pk2(v[2], v[3]); o.z = pk2(v[4], v[5]); o.w = pk2(v[6], v[7]);
        *(GAS v4u*)((bf16*)(ws + WS_GW) + (size_t)idx * 512 + lane * 8) = o;
    }
    if (gw >= NGW - 8) {
        const int hd = NGW - 1 - gw, c = hd * 64 + lane; float* hc = (float*)(ws + WS_HC) + hd * 704 + lane;
#pragma unroll
        for (int k = 0; k < 4; ++k) hc[k * 64] = A.lru_conv_w[k * 512 + c];
        hc[256] = A.lru_conv_b[c]; hc[320] = A.lru_ba[c]; hc[384] = A.lru_bx[c];
        { const float x = A.lru_a_param[c]; hc[448] = x > 20.f ? x : log1pf(expf(x)); }
#pragma unroll
        for (int k = 0; k < 3; ++k) hc[512 + k * 64] = A.conv_a_w[k * 512 + c];
    }
    for (int m = gw; m < M; m += NGW) rms_row_bf16(m < MP ? A.xp + (size_t)m * D : A.xs + (size_t)(m - MP) * D, A.g1, (bf16*)(ws + WS_XN) + (size_t)m * D, lane);
}
typedef __amdgpu_buffer_rsrc_t rsrc_t;
__device__ __forceinline__ f32x4 bld_bf16x4(rsrc_t r, int voff, int soff) { const v2u w = __builtin_amdgcn_raw_buffer_load_b64(r, voff, soff, 0); f32x4 o; o.x = __uint_as_float(w.x << 16); o.y = __uint_as_float(w.x & 0xffff0000u); o.z = __uint_as_float(w.y << 16); o.w = __uint_as_float(w.y & 0xffff0000u); return o; }
__device__ __forceinline__ void bst_bf16x4(rsrc_t r, int voff, int soff, f32x4 v) { v2u w; w.x = pg8::cvt_pk_bf16(v.x, v.y); w.y = pg8::cvt_pk_bf16(v.z, v.w); __builtin_amdgcn_raw_buffer_store_b64(w, r, voff, soff, 0); }
#define MEMFENCE() asm volatile("" ::: "memory")
template <bool FINAL>
__device__ __forceinline__ void mix_item(const Args& A, rsrc_t rP, rsrc_t rM, rsrc_t rC, rsrc_t rS, int ck, int hd, int lane) {
    const int tl = lane & 15, q = lane >> 4;
    const int vg = hd * 16384 + lane * 16, vc = 131072 + hd * 2816 + q * 16, vs = hd * 256 + q * 16;
#define LDC(arr, n) __builtin_bit_cast(f32x4, __builtin_amdgcn_raw_buffer_load_b128(rC, vc, (arr) * 256 + (n) * 64, 0))
#define LDG(gate, jt, ks) __builtin_bit_cast(bf16x8, __builtin_amdgcn_raw_buffer_load_b128(rC, vg, (((gate) * 4 + (jt)) * 2 + (ks)) * 1024, 0))
    const bool is_sample = ck >= NPCHUNK, first = is_sample || ((ck & 63) == 0), lastc = is_sample || ((ck & 63) == 63);
    const int sb = is_sample ? ck - NPCHUNK : ck >> 6;
    const int row0 = ck * 64, cb = hd * 64 + 4 * q;
    const int vb0 = ((row0 + tl) * DIN + cb) * 2, mb0 = ((row0 + tl) * D + cb) * 2;
    f32x4 cl[4][4];
#pragma unroll
    for (int n = 0; n < 4; ++n) {
        const int c = cb + 16 * n;
        const f32x4 w0 = LDC(0, n), w1 = LDC(1, n), w2 = LDC(2, n), w3 = LDC(3, n), bb = LDC(4, n);
#pragma unroll
        for (int m = 0; m < 4; ++m) {
            f32x4 x[4];
#pragma unroll
            for (int k = 0; k < 4; ++k) {
                if (m > 0 || k == 3) x[k] = bld_bf16x4(rP, vb0, ((16 * m - 3 + k) * DIN + 1536 + 16 * n) * 2);
                else { const int tk = tl - 3 + k;
                    if (!first || tk >= 0) x[k] = bld_bf16x4(rP, vb0 - (3 - k) * DIN * 2, (1536 + 16 * n) * 2);
                    else if (is_sample) x[k] = *(const f32x4*)(A.st_lc + (size_t)(sb * 3 + 3 + tk) * 512 + c);
                    else x[k] = (f32x4){0.f, 0.f, 0.f, 0.f}; } }
            cl[m][n] = bb + w0 * x[0] + w1 * x[1] + w2 * x[2] + w3 * x[3];
            if (FINAL && m == 3) { if (lastc && tl >= 13) *(f32x4*)(A.out + (is_sample ? O_LCS : O_LCP) + (size_t)(sb * 3 + tl - 13) * 512 + c) = x[3]; }
        }
        if (n & 1) asm volatile("" : "+v"(cl[0][n - 1]), "+v"(cl[1][n - 1]), "+v"(cl[2][n - 1]), "+v"(cl[3][n - 1]), "+v"(cl[0][n]), "+v"(cl[1][n]), "+v"(cl[2][n]), "+v"(cl[3][n]) :: "memory");
    }
    bf16x8 bfr[4][2];
#pragma unroll
    for (int m = 0; m < 4; ++m)
#pragma unroll
        for (int ks = 0; ks < 2; ++ks) { v4u w; const f32x4 a = cl[m][2 * ks], b = cl[m][2 * ks + 1];
            w.x = pg8::cvt_pk_bf16(a.x, a.y); w.y = pg8::cvt_pk_bf16(a.z, a.w); w.z = pg8::cvt_pk_bf16(b.x, b.y); w.w = pg8::cvt_pk_bf16(b.z, b.w); bfr[m][ks] = __builtin_bit_cast(bf16x8, w); }
    const bool reset0 = !is_sample && ((ck & 63) == 0) && tl == 0;
#pragma unroll
    for (int jt = 0; jt < 4; ++jt) {
        const int c = cb + 16 * jt;
        const bf16x8 ar0 = LDG(0, jt, 0), ar1 = LDG(0, jt, 1), ai0 = LDG(1, jt, 0), ai1 = LDG(1, jt, 1);
        const f32x4 ba4 = LDC(5, jt), bx4 = LDC(6, jt), sp4 = LDC(7, jt);
        f32x4 hc = {0.f, 0.f, 0.f, 0.f}, ac = {1.f, 1.f, 1.f, 1.f};
        if (FINAL) {
            if (is_sample) hc = *(const f32x4*)(A.st_lh + (size_t)sb * 512 + c);
            else for (int i = ck & ~63; i < ck; ++i) { const f32x4 pv = __builtin_bit_cast(f32x4, __builtin_amdgcn_raw_buffer_load_b128(rS, vs, i * 4096 + jt * 64, 0)), sv = __builtin_bit_cast(f32x4, __builtin_amdgcn_raw_buffer_load_b128(rS, vs, i * 4096 + 2048 + jt * 64, 0)); hc = pv * hc + sv; }
        }
#pragma unroll
        for (int m = 0; m < 4; ++m) {
            f32x4 zr = {0.f, 0.f, 0.f, 0.f}, zi = {0.f, 0.f, 0.f, 0.f};
            zr = __builtin_amdgcn_mfma_f32_16x16x32_bf16(ar0, bfr[m][0], zr, 0, 0, 0); zr = __builtin_amdgcn_mfma_f32_16x16x32_bf16(ar1, bfr[m][1], zr, 0, 0, 0);
            zi = __builtin_amdgcn_mfma_f32_16x16x32_bf16(ai0, bfr[m][0], zi, 0, 0, 0); zi = __builtin_amdgcn_mfma_f32_16x16x32_bf16(ai1, bfr[m][1], zi, 0, 0, 0);
            f32x4 hv;
#pragma unroll
            for (int r = 0; r < 4; ++r) {
                const float rr = sigmoidf_(zr[r] + ba4[r]), ii = sigmoidf_(zi[r] + bx4[r]);
                const float la = -8.0f * rr * sp4[r], x2 = 2.0f * la;
                float a = fast_exp(la);
                float t = 1.0f - a * a; if (x2 > -0.02f) t = -x2 * (1.0f + x2 * (0.5f + x2 * (1.0f / 6.0f)));
                float mult = __builtin_amdgcn_sqrtf(t); if (m == 0 && reset0) mult = 1.0f;
                float b = mult * (ii * cl[m][jt][r]);
                { const float ap = dpp_shr<1>(a, 1.0f), bp = dpp_shr<1>(b, 0.0f); b = fmaf(a, bp, b); a = a * ap; }
                { const float ap = dpp_shr<2>(a, 1.0f), bp = dpp_shr<2>(b, 0.0f); b = fmaf(a, bp, b); a = a * ap; }
                { const float ap = dpp_shr<4>(a, 1.0f), bp = dpp_shr<4>(b, 0.0f); b = fmaf(a, bp, b); a = a * ap; }
                { const float ap = dpp_shr<8>(a, 1.0f), bp = dpp_shr<8>(b, 0.0f); b = fmaf(a, bp, b); a = a * ap; }
                const float h = fmaf(a, hc[r], b); hv[r] = h;
                hc[r] = __shfl(h, lane | 15);
                if (!FINAL) ac[r] = ac[r] * __shfl(a, lane | 15);
            }
            if (FINAL) {
                const f32x4 g = bld_bf16x4(rP, vb0, (16 * m * DIN + 2048 + 16 * jt) * 2); f32x4 o;
#pragma unroll
                for (int r = 0; r < 4; ++r) { const float gg = g[r]; o[r] = hv[r] * gg * sigmoidf_(1.5957691216f * (gg + 0.044715f * gg * gg * gg)); }
                bst_bf16x4(rM, mb0, (16 * m * D + 512 + 16 * jt) * 2, o);
            }
        }
        if (FINAL) { if (lastc && tl == 15) *(f32x4*)(A.out + (is_sample ? O_LHS : O_LHP) + (size_t)sb * 512 + c) = hc; }
        else if (tl == 0) { __builtin_amdgcn_raw_buffer_store_b128(__builtin_bit_cast(v4u, ac), rS, vs, ck * 4096 + jt * 64, 0); __builtin_amdgcn_raw_buffer_store_b128(__builtin_bit_cast(v4u, hc), rS, vs, ck * 4096 + 2048 + jt * 64, 0); }
        MEMFENCE();
    }
    if (FINAL) {
#pragma unroll
        for (int n = 0; n < 4; ++n) {
            const int c = cb + 16 * n;
            const f32x4 w0 = LDC(8, n), w1 = LDC(9, n), w2 = LDC(10, n);
#pragma unroll
            for (int m = 0; m < 4; ++m) {
                f32x4 u[3];
#pragma unroll
                for (int k = 0; k < 3; ++k) {
                    if (m > 0 || k == 2) { const int so = ((16 * m - 2 + k) * DIN + 16 * n) * 2; u[k] = bld_bf16x4(rP, vb0, so + 1024) * bld_bf16x4(rP, vb0, so + 2048); }
                    else { const int tk = tl - 2 + k;
                        if (!first || tk >= 0) { const int vo = vb0 - (2 - k) * DIN * 2; u[k] = bld_bf16x4(rP, vo, 16 * n * 2 + 1024) * bld_bf16x4(rP, vo, 16 * n * 2 + 2048); }
                        else if (is_sample) u[k] = *(const f32x4*)(A.st_ca + (size_t)(sb * 2 + 2 + tk) * 512 + c);
                        else u[k] = (f32x4){0.f, 0.f, 0.f, 0.f}; } }
                const f32x4 ca = w0 * u[0] + w1 * u[1] + w2 * u[2], gb = bld_bf16x4(rP, vb0, (16 * m * DIN + 16 * n) * 2);
                bst_bf16x4(rM, mb0, (16 * m * D + 16 * n) * 2, gb * ca);
                if (m == 3) { if (lastc && tl >= 14) *(f32x4*)(A.out + (is_sample ? O_CAS : O_CAP) + (size_t)(sb * 2 + tl - 14) * 512 + c) = u[2]; }
            }
            MEMFENCE();
        }
    }
#undef LDC
#undef LDG
}
constexpr int N_PHASES = 8;
__global__ void __launch_bounds__(NWAVES * 64, 2) fwd_kernel(Args args) {
    extern __shared__ __attribute__((aligned(16))) unsigned char lds_raw[];
    LAS unsigned char* lds = (LAS unsigned char*)lds_raw;
    const int tid = threadIdx.x, lane = tid & 63, wave = __builtin_amdgcn_readfirstlane(tid >> 6);
    const int G = gridDim.x, bx = blockIdx.x, vcu = (G % 8 == 0) ? (bx % 8) * (G / 8) + bx / 8 : bx;
    const int gw = vcu * NWAVES + wave, NGW = G * NWAVES;
    unsigned char* ws = args.ws;
#if MK_MODE == 2
    volatile LAS unsigned* MISC = (volatile LAS unsigned*)(lds + MISC_OFF);
    for (int u = tid; u < (LDS_BYTES - LDSCTL_OFF) / 4; u += NWAVES * 64) ((LAS unsigned*)(lds + LDSCTL_OFF))[u] = 0u;
    __syncthreads();
    XcdBarrier bar = xcd_barrier_post((unsigned*)(ws + WS_CTL) + CW_BAR, MISC + 8);
#define GRID_BAR() xcd_barrier(bar)
#elif MK_MODE == 0
    cg::grid_group grid = cg::this_grid();
#define GRID_BAR() grid.sync()
#else
#define GRID_BAR() do {} while (0)
#endif
    const int lo = args.ph_lo, hi = args.ph_hi;
#ifndef PH_MASK
#define PH_MASK 0xff
#endif
#define IN(k) (((PH_MASK >> (k)) & 1) && lo <= (k) && (k) < hi)
#define SEAM(k) do { if (IN(k) && IN((k) + 1)) GRID_BAR(); } while (0)

    if (IN(0)) { p0_prologue(args, lds, gw, NGW, wave, lane); } SEAM(0);
    if (IN(1)) {
        pg8::Gemm g{(const bf16*)(ws + WS_XN), (const bf16*)(ws + WS_WIN), M, DIN, D}; pg8::StaticOrder S; S.init(M, DIN, G, bx);
        pg8::EpiProj E{(bf16*)(ws + WS_PROJ), DIN};
        pg8::gemm_phase<pg8::EpiProj, pg8::StaticOrder, PG8_ALIGN, PG8_SP2>(lds + RING_OFF, g, S, E);
    } SEAM(1);
    const rsrc_t rP = __builtin_amdgcn_make_buffer_rsrc((void*)(ws + WS_PROJ), 0, (int)((size_t)M * DIN * 2), 0x00020000), rM = __builtin_amdgcn_make_buffer_rsrc((void*)(ws + WS_MIX), 0, (int)((size_t)M * D * 2), 0x00020000),
        rC = __builtin_amdgcn_make_buffer_rsrc((void*)(ws + WS_GW), 0, 131072 + 8 * 2816, 0x00020000), rS = __builtin_amdgcn_make_buffer_rsrc((void*)(ws + WS_SUM), 0, NPCHUNK * 4096, 0x00020000);
    if (IN(2)) { for (int it = gw; it < NPCHUNK * 8; it += NGW) mix_item<false>(args, rP, rM, rC, rS, it >> 3, it & 7, lane); } SEAM(2);
    if (IN(3)) { for (int it = gw; it < NCHUNK * 8; it += NGW) mix_item<true>(args, rP, rM, rC, rS, it >> 3, it & 7, lane); } SEAM(3);
    if (IN(4)) {
        pg8::Gemm g{(const bf16*)(ws + WS_MIX), (const bf16*)(ws + WS_WOUT), M, D, D}; pg8::StaticOrder S; S.init(M, D, G, bx);
        pg8::EpiX1 E{args.xp, args.xs, args.out, (bf16*)(ws + WS_XN), (float*)(ws + WS_SS)};
        pg8::gemm_phase<pg8::EpiX1, pg8::StaticOrder, PG8_ALIGN, PG8_SP2>(lds + RING_OFF, g, S, E);
    } SEAM(4);
    if (IN(5)) {
        pg8::Gemm g{(const bf16*)(ws + WS_XN), (const bf16*)(ws + WS_WUP), M, FF, D}; pg8::StaticOrder S; S.init(M, FF, G, bx);
        pg8::EpiUp E{(bf16*)(ws + WS_H), (const float*)(ws + WS_SS), EPS};
        pg8::gemm_phase<pg8::EpiUp, pg8::StaticOrder, PG8_ALIGN, PG8_SP2>(lds + RING_OFF, g, S, E);
    } SEAM(5);
    if (IN(6)) {
        pg8::Gemm g{(const bf16*)(ws + WS_H), (const bf16*)(ws + WS_WDN), M, D, FF}; pg8::StaticOrder S; S.init(M, D, G, bx);
        pg8::EpiDown E{args.out};
        pg8::gemm_phase<pg8::EpiDown, pg8::StaticOrder, PG8_ALIGN, PG8_SP2>(lds + RING_OFF, g, S, E);
    } SEAM(6);
    if (IN(7)) { for (int m = gw; m < M; m += NGW) rms_row_f32_inplace(args.out + (size_t)m * D, args.gf, lane); }
#undef IN
#undef SEAM
}

extern "C" void kernel_launch(void* const* d_in, const int* in_sizes, int n_in, void* d_out, int out_size, void* d_ws, size_t ws_size, hipStream_t stream) {
    static int grid = 0;
    if (grid == 0) {
        if (n_in != 20 || out_size != (int)O_END || ws_size < WS_END) { fprintf(stderr, "kernel_launch: unexpected shapes (n_in %d out %d ws %zu)\n", n_in, out_size, ws_size); grid = -1; return; }
        int dev = 0, cus = 0, per_cu = 0;
        if (hipGetDevice(&dev) != hipSuccess || hipDeviceGetAttribute(&cus, hipDeviceAttributeMultiprocessorCount, dev) != hipSuccess) { grid = -1; return; }
        if (hipFuncSetAttribute((const void*)fwd_kernel, hipFuncAttributeMaxDynamicSharedMemorySize, LDS_BYTES) != hipSuccess) { fprintf(stderr, "kernel_launch: hipFuncSetAttribute failed\n"); grid = -1; return; }
        if (hipOccupancyMaxActiveBlocksPerMultiprocessor(&per_cu, (const void*)fwd_kernel, NWAVES * 64, LDS_BYTES) != hipSuccess || per_cu < 1) { fprintf(stderr, "kernel_launch: occupancy query says %d blocks per CU\n", per_cu); per_cu = 1; }
        (void)hipGetLastError();
        grid = cus;
    }
    if (grid < 0) return;
    Args a{};
    a.xp = (const float*)d_in[0]; a.xs = (const float*)d_in[1]; a.st_ca = (const float*)d_in[2]; a.st_lc = (const float*)d_in[3]; a.st_lh = (const float*)d_in[4]; a.g1 = (const float*)d_in[5];
    a.w_in = (const float*)d_in[6]; a.conv_a_w = (const float*)d_in[7]; a.lru_conv_w = (const float*)d_in[8]; a.lru_conv_b = (const float*)d_in[9]; a.lru_wa = (const float*)d_in[10];
    a.lru_ba = (const float*)d_in[11]; a.lru_wx = (const float*)d_in[12]; a.lru_bx = (const float*)d_in[13]; a.lru_a_param = (const float*)d_in[14]; a.w_out = (const float*)d_in[15];
    a.g2 = (const float*)d_in[16]; a.w_up = (const float*)d_in[17]; a.w_down = (const float*)d_in[18]; a.gf = (const float*)d_in[19]; a.out = (float*)d_out; a.ws = (unsigned char*)d_ws;
#if MK_MODE == 1
    for (int p = 0; p < N_PHASES; ++p) { a.ph_lo = p; a.ph_hi = p + 1; hipLaunchKernelGGL(fwd_kernel, dim3(grid), dim3(NWAVES * 64), LDS_BYTES, stream, a); }
#elif MK_MODE == 0
    a.ph_lo = 0; a.ph_hi = N_PHASES;
    void* kargs[] = {&a};
    hipError_t e = hipLaunchCooperativeKernel((const void*)fwd_kernel, dim3(grid), dim3(NWAVES * 64), kargs, LDS_BYTES, stream);
    if (e != hipSuccess) fprintf(stderr, "kernel_launch: cooperative launch failed: %s (grid %d)\n", hipGetErrorString(e), grid);
#else
    if (hipMemsetAsync((char*)d_ws + WS_CTL, 0, CTL_ZERO_BYTES, stream) != hipSuccess) { fprintf(stderr, "kernel_launch: memset failed\n"); return; }
    a.ph_lo = 0; a.ph_hi = N_PHASES;
    hipLaunchKernelGGL(fwd_kernel, dim3(grid), dim3(NWAVES * 64), LDS_BYTES, stream, a);
#endif
    const hipError_t le = hipPeekAtLastError();
    if (le != hipSuccess) fprintf(stderr, "kernel_launch: launch failed: %s\n", hipGetErrorName(le));
}
```

```cpp
#include <hip/hip_runtime.h>
#include <hip/hip_cooperative_groups.h>
#include <cstdio>
#include <cstdint>
namespace cg = cooperative_groups;
#ifndef MK_MODE
#define MK_MODE 0
#endif
namespace pg8 {
#define PG8_LAS __attribute__((address_space(3)))
typedef unsigned short bf16_t;
typedef short bf16x8 __attribute__((ext_vector_type(8)));
typedef float f32x4 __attribute__((ext_vector_type(4)));
typedef unsigned u32x4 __attribute__((ext_vector_type(4)));
constexpr int BM = 256, BK = 64, HALF = 128, HTB = HALF * BK * 2  , STAGE_BYTES = 8 * HTB, NXCD = 8, WGM = 8;

__host__ __device__ __forceinline__ int lds_byte(int r, int c) { const int st = (r >> 4) * 2 + (c >> 5), rr = r & 15, cc = c & 31, ob = rr * 64 + cc * 2; return st * 1024 + (ob ^ (((ob >> 9) & 1) << 5)); }
__host__ __device__ __forceinline__ void stage_rc(int b, int& R, int& C) { const int st = b / 1024, sb = b % 1024, swz = sb ^ (((sb >> 9) & 1) << 5); R = (st >> 1) * 16 + swz / 64; C = (st & 1) * 32 + (swz % 64) / 2; }
__host__ __device__ __forceinline__ int perm32(int rho) { const int n = rho >> 4, i = rho & 15; return 8 * (i >> 2) + 4 * n + (i & 3); }

struct Unit { int pm, pn; };
struct Gemm { const bf16_t* A; const bf16_t* Bt; int M, N, K; };

struct StaticOrder {
    int nM, nN, nwg, G, c;
    __host__ __device__ void init(int M, int N, int G_, int c_) { nM = M / BM; nN = N / BM; nwg = nM * nN; G = G_; c = c_; }
    __host__ __device__ bool next(int i, Unit& u) const {
        const long L = (long)i * G + c; if (L >= nwg) return false;
        int wgid = (int)L; { const int q = nwg / NXCD, r = nwg % NXCD, xcd = wgid % NXCD, off = wgid / NXCD; wgid = (xcd < r ? xcd * (q + 1) : r * (q + 1) + (xcd - r) * q) + off; }
        const int nig = WGM * nN, gid = wgid / nig, fm = gid * WGM, gsz = (nM - fm) < WGM ? (nM - fm) : WGM;
        u.pm = fm + ((wgid % nig) % gsz); u.pn = (wgid % nig) / gsz; return true;
    }
    __device__ __forceinline__ void a_ready(const Unit&) const {}
    __device__ __forceinline__ void done(const Unit&) const {}
};

__device__ __forceinline__ unsigned cvt_pk_bf16(float lo, float hi) { unsigned r; asm volatile("v_cvt_pk_bf16_f32 %0, %1, %2" : "=v"(r) : "v"(lo), "v"(hi)); return r; }
typedef float f32x2 __attribute__((ext_vector_type(2)));
__device__ __forceinline__ f32x2 gelu_pk(f32x2 v) {
    const f32x2 av = __builtin_elementwise_abs(v), d = av * 0.2316418882f + 1.0f;
    f32x2 t; t.x = __builtin_amdgcn_rcpf(d.x); t.y = __builtin_amdgcn_rcpf(d.y);
    f32x2 q = t * 0.5307027145f + (-0.7265760135f); q = q * t + 0.7107068705f; q = q * t + (-0.142248368f); q = q * t + 0.127414796f; q = q * t;
    const f32x2 s = (v * v) * (-0.72134752044f);
    f32x2 e; e.x = __builtin_amdgcn_exp2f(s.x); e.y = __builtin_amdgcn_exp2f(s.y);
    const f32x2 m = v * (q * e), r = v - m;
    f32x2 o; o.x = v.x < 0.f ? m.x : r.x; o.y = v.y < 0.f ? m.y : r.y; return o;
}

typedef unsigned u32x2 __attribute__((ext_vector_type(2)));
struct EpiProj {
    static constexpr bool PERM = true, AFTER_DRAIN = false;
    bf16_t* O; int ldc;
    __device__ __forceinline__ void operator()(const f32x4 (&acc)[2][2][4][2], const Unit& u, int wr, int wc, int fr, int fq) const {
        const int row0 = u.pm * BM + wr * 64 + fr, col0 = u.pn * BM + wc * 32 + 8 * fq;
#pragma unroll
        for (int ai = 0; ai < 2; ++ai)
#pragma unroll
            for (int m = 0; m < 4; ++m) { bf16_t* rowp = O + (size_t)(row0 + ai * HALF + m * 16) * ldc + col0;
#pragma unroll
                for (int bj = 0; bj < 2; ++bj) { const f32x4 v0 = acc[ai][bj][m][0], v1 = acc[ai][bj][m][1];
                    u32x4 w; w.x = cvt_pk_bf16(v0[0], v0[1]); w.y = cvt_pk_bf16(v0[2], v0[3]); w.z = cvt_pk_bf16(v1[0], v1[1]); w.w = cvt_pk_bf16(v1[2], v1[3]);
                    *(u32x4*)(rowp + bj * HALF) = w; } }
    }
};
struct EpiX1 {
    static constexpr bool PERM = false, AFTER_DRAIN = false;
    const float* xp; const float* xs; float* out; bf16_t* x1b; float* ss;
    __device__ __forceinline__ void operator()(const f32x4 (&acc)[2][2][4][2], const Unit& u, int wr, int wc, int fr, int fq) const {
        const int row0 = u.pm * BM + wr * 64 + fr, col0 = u.pn * BM + wc * 32 + 4 * fq;
        const float* xin = (u.pm < 64) ? xp : xs - (size_t)16384 * 1024;
#pragma unroll
        for (int ai = 0; ai < 2; ++ai)
#pragma unroll
            for (int m = 0; m < 4; ++m) { const size_t off = (size_t)(row0 + ai * HALF + m * 16) * 1024 + col0; float s = 0.f;
#pragma unroll
                for (int bj = 0; bj < 2; ++bj)
#pragma unroll
                    for (int n = 0; n < 2; ++n) { const size_t o = off + bj * HALF + n * 16; const f32x4 v = *(const f32x4*)(xin + o) + acc[ai][bj][m][n];
                        *(f32x4*)(out + o) = v; u32x2 w; w.x = cvt_pk_bf16(v[0], v[1]); w.y = cvt_pk_bf16(v[2], v[3]); *(u32x2*)(x1b + o) = w;
                        s += (v[0] * v[0] + v[1] * v[1]) + (v[2] * v[2] + v[3] * v[3]); }
                s += __shfl_xor(s, 16); s += __shfl_xor(s, 32);
                if (fq == 0) ss[(size_t)(row0 + ai * HALF + m * 16) * 16 + u.pn * 4 + wc] = s; }
    }
};
struct EpiUp {
    static constexpr bool PERM = true, AFTER_DRAIN = false;
    bf16_t* H; const float* ss; float eps;
    __device__ __forceinline__ void operator()(const f32x4 (&acc)[2][2][4][2], const Unit& u, int wr, int wc, int fr, int fq) const {
        const int row0 = u.pm * BM + wr * 64 + fr, col0 = u.pn * BM + wc * 32 + 8 * fq;
#pragma unroll
        for (int ai = 0; ai < 2; ++ai)
#pragma unroll
            for (int m = 0; m < 4; ++m) { const int r = row0 + ai * HALF + m * 16; const f32x4* sp = (const f32x4*)(ss + (size_t)r * 16);
                const f32x4 t = (sp[0] + sp[1]) + (sp[2] + sp[3]); const float rs2 = 1.0f / (((t[0] + t[1]) + (t[2] + t[3])) * (1.0f / 1024.0f) + eps);
                bf16_t* rowp = H + (size_t)r * 4096 + col0;
#pragma unroll
                for (int bj = 0; bj < 2; ++bj) { f32x4 v0 = acc[ai][bj][m][0], v1 = acc[ai][bj][m][1];
#pragma unroll
                    for (int j = 0; j < 4; ++j) { const float a = fmaxf(v0[j], 0.f), b = fmaxf(v1[j], 0.f); v0[j] = a * a * rs2; v1[j] = b * b * rs2; }
                    u32x4 w; w.x = cvt_pk_bf16(v0[0], v0[1]); w.y = cvt_pk_bf16(v0[2], v0[3]); w.z = cvt_pk_bf16(v1[0], v1[1]); w.w = cvt_pk_bf16(v1[2], v1[3]);
                    *(u32x4*)(rowp + bj * HALF) = w; } }
    }
};
struct EpiDown {
    static constexpr bool PERM = false, AFTER_DRAIN = false;
    float* out;
    __device__ __forceinline__ void operator()(const f32x4 (&acc)[2][2][4][2], const Unit& u, int wr, int wc, int fr, int fq) const {
        const int row0 = u.pm * BM + wr * 64 + fr, col0 = u.pn * BM + wc * 32 + 4 * fq;
#pragma unroll
        for (int ai = 0; ai < 2; ++ai)
#pragma unroll
            for (int m = 0; m < 4; ++m) { float* rowp = out + (size_t)(row0 + ai * HALF + m * 16) * 1024 + col0;
#pragma unroll
                for (int bj = 0; bj < 2; ++bj)
#pragma unroll
                    for (int n = 0; n < 2; ++n) { f32x4* p = (f32x4*)(rowp + bj * HALF + n * 16); *p = *p + acc[ai][bj][m][n]; } }
    }
};

template <class Epi, class Sched, bool ALIGN_EPI = false, bool SP2 = false>
__device__ __forceinline__ void gemm_phase(PG8_LAS unsigned char* lds, const Gemm g, const Sched& S, const Epi& E) {
    const int tid = threadIdx.x, wid = __builtin_amdgcn_readfirstlane(tid >> 6), lane = tid & 63, wr = wid >> 2, wc = wid & 3, fr = lane & 15, fq = lane >> 4;
    const int K = g.K, nt = K / BK;
    unsigned voffA[2], voffB[2];
#pragma unroll
    for (int i = 0; i < 2; ++i) { int R, C; stage_rc(tid * 16 + i * 8192, R, C); const int Rb = Epi::PERM ? ((R & ~31) + perm32(R & 31)) : R;
        voffA[i] = (unsigned)(R * K + C) * 2u; voffB[i] = (unsigned)(Rb * K + C) * 2u; }
    const size_t kstep = (size_t)(BK * 2);
    const size_t hstep = (size_t)HALF * K * 2;
    const size_t tstep = 2 * hstep;
    const unsigned ldsw = (unsigned)wid * 1024u;
    const int aoff = lds_byte(wr * 64 + fr, fq * 8), boff = lds_byte(wc * 32 + fr, fq * 8);
#define PG8_SA(b, h) (((b) * 2 + (h)) * HTB)
#define PG8_SB(b, h) ((4 + (b) * 2 + (h)) * HTB)
#define PG8_STAGE(bufoff, gbase, voff) do { _Pragma("unroll") for (int _i = 0; _i < 2; ++_i) \
        __builtin_amdgcn_global_load_lds((const unsigned*)((const char*)(gbase) + (voff)[_i]), (PG8_LAS unsigned*)(lds + (bufoff) + ldsw + _i * 8192), 16, 0, 0); } while (0)
#define PG8_LDA(dst, b, h) do { _Pragma("unroll") for (int m = 0; m < 4; ++m) _Pragma("unroll") for (int k = 0; k < 2; ++k) dst[m][k] = *(const PG8_LAS bf16x8*)(lds + PG8_SA(b, h) + aoff + m * 2048 + k * 1024); } while (0)
#define PG8_LDB(dst, b, h) do { _Pragma("unroll") for (int n = 0; n < 2; ++n) _Pragma("unroll") for (int k = 0; k < 2; ++k) dst[n][k] = *(const PG8_LAS bf16x8*)(lds + PG8_SB(b, h) + boff + n * 2048 + k * 1024); } while (0)
#define PG8_MMA(ai, bj, At, Bt) do { __builtin_amdgcn_s_setprio(1); _Pragma("unroll") for (int m = 0; m < 4; ++m) _Pragma("unroll") for (int n = 0; n < 2; ++n) _Pragma("unroll") for (int k = 0; k < 2; ++k) \
        acc[ai][bj][m][n] = __builtin_amdgcn_mfma_f32_16x16x32_bf16(Bt[n][k], At[m][k], acc[ai][bj][m][n], 0, 0, 0); __builtin_amdgcn_s_setprio(0); } while (0)
#define PG8_WAIT_V(n) asm volatile("s_waitcnt vmcnt(" #n ")" ::: "memory")
#define PG8_WAIT_L(n) asm volatile("s_waitcnt lgkmcnt(" #n ")" ::: "memory")
#define PG8_BAR __builtin_amdgcn_s_barrier()
#define PG8_SCHED __builtin_amdgcn_sched_barrier(0)
    Unit cur, nxt; int ui = 0;
    if (!S.next(0, cur)) return;
    f32x4 acc[2][2][4][2];
#pragma unroll
    for (int a = 0; a < 2; ++a)
#pragma unroll
        for (int b = 0; b < 2; ++b)
#pragma unroll
            for (int m = 0; m < 4; ++m)
#pragma unroll
                for (int n = 0; n < 2; ++n) acc[a][b][m][n] = (f32x4){0.f, 0.f, 0.f, 0.f};
    bf16x8 At[4][2], B0[2][2], B1[2][2];
    const char* cA = (const char*)g.A + (size_t)cur.pm * tstep; const char* cB = (const char*)g.Bt + (size_t)cur.pn * tstep;
    S.a_ready(cur);
    if constexpr (SP2) {
        PG8_STAGE(PG8_SB(0, 0), cB, voffB); PG8_STAGE(PG8_SB(0, 1), cB + hstep, voffB); PG8_STAGE(PG8_SA(0, 0), cA, voffA); PG8_STAGE(PG8_SA(0, 1), cA + hstep, voffA);
        if (wr == 1) PG8_BAR;
        PG8_WAIT_V(2); PG8_BAR;
        PG8_STAGE(PG8_SB(1, 0), cB + kstep, voffB); PG8_STAGE(PG8_SA(1, 0), cA + kstep, voffA); PG8_STAGE(PG8_SB(1, 1), cB + hstep + kstep, voffB);
        PG8_WAIT_V(6); PG8_BAR;
    } else {
        PG8_STAGE(PG8_SB(0, 0), cB, voffB); PG8_STAGE(PG8_SA(0, 0), cA, voffA); PG8_STAGE(PG8_SB(0, 1), cB + hstep, voffB); PG8_STAGE(PG8_SA(0, 1), cA + hstep, voffA);
        if (wr == 1) PG8_BAR;
        PG8_WAIT_V(4); PG8_BAR;
        PG8_STAGE(PG8_SB(1, 0), cB + kstep, voffB); PG8_STAGE(PG8_SA(1, 0), cA + kstep, voffA); PG8_STAGE(PG8_SB(1, 1), cB + hstep + kstep, voffB);
        PG8_WAIT_V(6); PG8_BAR;
    }
    for (;;) {
        const bool has_next = S.next(ui + 1, nxt);
        const char* nA = has_next ? (const char*)g.A + (size_t)nxt.pm * tstep : cA; const char* nB = has_next ? (const char*)g.Bt + (size_t)nxt.pn * tstep : cB;
        for (int t = 0; t < nt; t += 2) {
            const bool last = (t == nt - 2);
            const char* a1 = cA + (size_t)(t + 1) * kstep;
            const char* a2 = last ? nA : cA + (size_t)(t + 2) * kstep; const char* b2 = last ? nB : cB + (size_t)(t + 2) * kstep;
            const char* a3 = a2 + kstep; const char* b3 = b2 + kstep;
            if (last && has_next) S.a_ready(nxt);
            if constexpr (SP2) {
            PG8_LDB(B0, 0, 0); PG8_LDB(B1, 0, 1); PG8_SCHED; PG8_LDA(At, 0, 0); PG8_STAGE(PG8_SA(1, 1), a1 + hstep, voffA);
            PG8_WAIT_V(8); PG8_WAIT_L(0); PG8_BAR; PG8_MMA(0, 0, At, B0); PG8_MMA(0, 1, At, B1); PG8_BAR; PG8_SCHED;
            PG8_LDA(At, 0, 1); PG8_STAGE(PG8_SB(0, 0), b2, voffB); PG8_STAGE(PG8_SB(0, 1), b2 + hstep, voffB); PG8_STAGE(PG8_SA(0, 0), a2, voffA);
            PG8_WAIT_V(8); PG8_WAIT_L(0); PG8_BAR; PG8_MMA(1, 0, At, B0); PG8_MMA(1, 1, At, B1); PG8_BAR; PG8_SCHED;
            PG8_LDB(B0, 1, 0); PG8_LDB(B1, 1, 1); PG8_SCHED; PG8_LDA(At, 1, 0); PG8_STAGE(PG8_SA(0, 1), a2 + hstep, voffA);
            PG8_WAIT_V(8); PG8_WAIT_L(0); PG8_BAR; PG8_MMA(0, 0, At, B0); PG8_MMA(0, 1, At, B1); PG8_BAR; PG8_SCHED;
            PG8_LDA(At, 1, 1); PG8_STAGE(PG8_SB(1, 0), b3, voffB); PG8_STAGE(PG8_SB(1, 1), b3 + hstep, voffB); PG8_STAGE(PG8_SA(1, 0), a3, voffA);
            PG8_WAIT_V(8); PG8_WAIT_L(0); PG8_BAR; PG8_MMA(1, 0, At, B0); PG8_MMA(1, 1, At, B1); PG8_BAR; PG8_SCHED;
            } else {
            PG8_LDB(B0, 0, 0); PG8_SCHED; PG8_LDA(At, 0, 0); PG8_STAGE(PG8_SA(1, 1), a1 + hstep, voffA);
            PG8_WAIT_L(8); PG8_BAR; PG8_WAIT_L(0); PG8_MMA(0, 0, At, B0); PG8_BAR; PG8_SCHED;
            PG8_LDB(B1, 0, 1); PG8_STAGE(PG8_SB(0, 0), b2, voffB);
            PG8_BAR; PG8_WAIT_L(0); PG8_MMA(0, 1, At, B1); PG8_BAR;
            PG8_LDA(At, 0, 1); PG8_STAGE(PG8_SA(0, 0), a2, voffA);
            PG8_BAR; PG8_WAIT_L(0); PG8_MMA(1, 0, At, B0); PG8_BAR; PG8_SCHED;
            PG8_STAGE(PG8_SB(0, 1), b2 + hstep, voffB);
            PG8_WAIT_V(6); PG8_BAR; PG8_MMA(1, 1, At, B1); PG8_BAR;
            PG8_LDB(B0, 1, 0); PG8_SCHED; PG8_LDA(At, 1, 0); PG8_STAGE(PG8_SA(0, 1), a2 + hstep, voffA);
            PG8_WAIT_L(8); PG8_BAR; PG8_WAIT_L(0); PG8_MMA(0, 0, At, B0); PG8_BAR; PG8_SCHED;
            PG8_LDB(B1, 1, 1); PG8_STAGE(PG8_SB(1, 0), b3, voffB);
            PG8_BAR; PG8_WAIT_L(0); PG8_MMA(0, 1, At, B1); PG8_BAR;
            PG8_LDA(At, 1, 1); PG8_STAGE(PG8_SA(1, 0), a3, voffA);
            PG8_BAR; PG8_WAIT_L(0); PG8_MMA(1, 0, At, B0); PG8_BAR; PG8_SCHED;
            PG8_STAGE(PG8_SB(1, 1), b3 + hstep, voffB);
            PG8_WAIT_V(6); PG8_BAR; PG8_MMA(1, 1, At, B1); PG8_BAR;
            }
        }
        if constexpr (ALIGN_EPI) { if (wr == 0) PG8_BAR; }
        if constexpr (!Epi::AFTER_DRAIN) { E(acc, cur, wr, wc, fr, fq); S.done(cur); }
        if (!has_next) break;
#pragma unroll
        for (int a = 0; a < 2; ++a)
#pragma unroll
            for (int b = 0; b < 2; ++b)
#pragma unroll
                for (int m = 0; m < 4; ++m)
#pragma unroll
                    for (int n = 0; n < 2; ++n) acc[a][b][m][n] = (f32x4){0.f, 0.f, 0.f, 0.f};
        cur = nxt; cA = nA; cB = nB; ++ui;
        if constexpr (ALIGN_EPI) { if (wr == 1) PG8_BAR; }
    }
    PG8_WAIT_V(0);
    if constexpr (!ALIGN_EPI) { if (wr == 0) PG8_BAR; }
    PG8_BAR;
    if constexpr (Epi::AFTER_DRAIN) { E.fused(acc, cur, wr, wc, fr, fq, lds, wid, lane); S.done(cur); }
#undef PG8_SA
#undef PG8_SB
#undef PG8_STAGE
#undef PG8_LDA
#undef PG8_LDB
#undef PG8_MMA
#undef PG8_WAIT_V
#undef PG8_WAIT_L
#undef PG8_BAR
#undef PG8_SCHED
}
}
#ifndef PG8_SP2
#define PG8_SP2 true
#endif
#ifndef PG8_ALIGN
#define PG8_ALIGN true
#endif
constexpr int NWAVES = 8;
constexpr int D = 1024, DIN = 2560, FF = 4096, DC = 512, DL = 512;
constexpr int MP = 4 * 4096, MS = 32 * 64, M = MP + MS;
constexpr int NCHUNK = M / 64, NPCHUNK = MP / 64;
constexpr float EPS = 1e-6f;
constexpr size_t O_YP = 0, O_YS = (size_t)MP * D, O_CAP = (size_t)M * D, O_LCP = O_CAP + 4 * 2 * 512, O_LHP = O_LCP + 4 * 3 * 512, O_CAS = O_LHP + 4 * 512, O_LCS = O_CAS + 32 * 2 * 512, O_LHS = O_LCS + 32 * 3 * 512, O_END = O_LHS + 32 * 512;
constexpr size_t MiB = 1u << 20;
constexpr size_t WS_CTL = 0, CTL_ZERO_BYTES = 1 * MiB;
constexpr size_t WS_WIN = 2 * MiB, WS_WOUT = 8 * MiB, WS_WUP = 10 * MiB, WS_WDN = 18 * MiB;
constexpr size_t WS_GW = 26 * MiB;
constexpr size_t WS_HC = WS_GW + 131072;
constexpr size_t WS_SS = 27 * MiB;
constexpr size_t WS_SUM = 29 * MiB;
constexpr size_t WS_XN = 32 * MiB;
constexpr size_t WS_H = 68 * MiB;
constexpr size_t WS_PROJ = 68 * MiB;
constexpr size_t WS_MIX = 160 * MiB;
constexpr size_t WS_END = 212 * MiB;
static_assert(WS_XN + (size_t)M * D * 2 <= WS_H && WS_PROJ + (size_t)M * DIN * 2 <= WS_MIX && WS_MIX + (size_t)M * D * 2 <= WS_END && WS_H + (size_t)M * FF * 2 <= WS_END, "d_ws map");
static_assert(WS_SS + (size_t)M * 16 * 4 <= WS_SUM && WS_SUM + (size_t)NPCHUNK * 2 * 512 * 4 <= WS_XN, "d_ws map (small)");
constexpr int CW_BAR = 4096;
constexpr int RING_OFF = 0, RING_BYTES = 131072;
constexpr int LDSCTL_OFF = RING_BYTES, MISC_OFF = LDSCTL_OFF + 320;
constexpr int LDS_BYTES = 147456;
#define GAS __attribute__((address_space(1)))
#define LAS __attribute__((address_space(3)))
typedef unsigned short bf16;
typedef unsigned v4u __attribute__((ext_vector_type(4)));
typedef unsigned v2u __attribute__((ext_vector_type(2)));
typedef float f32x4 __attribute__((ext_vector_type(4)));
typedef short bf16x8 __attribute__((ext_vector_type(8)));
typedef GAS unsigned gu32;
#define RLX_AGENT __ATOMIC_RELAXED, __HIP_MEMORY_SCOPE_AGENT
#define LDS_WAIT() asm volatile("s_waitcnt lgkmcnt(0)" ::: "memory")
#define VM_WAIT() asm volatile("s_waitcnt vmcnt(0)" ::: "memory")
__device__ __forceinline__ unsigned f2bf(float f) { unsigned u = __builtin_bit_cast(unsigned, f); return (u + 0x7fffu + ((u >> 16) & 1u)) >> 16; }
__device__ __forceinline__ unsigned pk2(float lo, float hi) { return f2bf(lo) | (f2bf(hi) << 16); }
__device__ __forceinline__ f32x4 ld_bf16x4(const bf16* p) { const v2u w = *(const v2u*)p; f32x4 r; r.x = __uint_as_float(w.x << 16); r.y = __uint_as_float(w.x & 0xffff0000u); r.z = __uint_as_float(w.y << 16); r.w = __uint_as_float(w.y & 0xffff0000u); return r; }
__device__ __forceinline__ void st_bf16x4(bf16* p, f32x4 v) { v2u w; w.x = pg8::cvt_pk_bf16(v.x, v.y); w.y = pg8::cvt_pk_bf16(v.z, v.w); *(v2u*)p = w; }
__device__ __forceinline__ float fast_rcp(float x) { return __builtin_amdgcn_rcpf(x); }
__device__ __forceinline__ float fast_exp(float x) { return __builtin_amdgcn_exp2f(x * 1.44269504089f); }
__device__ __forceinline__ float sigmoidf_(float x) { return fast_rcp(1.0f + fast_exp(-x)); }
template <int S> __device__ __forceinline__ float dpp_shr(float v, float ident) {
    return __builtin_bit_cast(float, __builtin_amdgcn_update_dpp(__builtin_bit_cast(int, ident), __builtin_bit_cast(int, v), 0x110 + S, 0xf, 0xf, false));
}
#if MK_MODE == 2
#define XB_TMO      128
#define XB_XCNT(j)  (256  + 64 * (j))
#define XB_XSUB(j)  (1280 + 64 * (j))
#define XB_XGEN(j)  (2304 + 64 * (j))
#define XB_TOP      3328
#define XB_TOPGEN   3392
#define XCD_BAR_WORDS 3456
#define XB_SPIN_CAP (1u << 18)

__device__ __forceinline__ unsigned xb_ld(unsigned* p)              { return __hip_atomic_load(p, __ATOMIC_RELAXED, __HIP_MEMORY_SCOPE_AGENT); }
__device__ __forceinline__ unsigned xb_add(unsigned* p, unsigned v) { return __hip_atomic_fetch_add(p, v, __ATOMIC_RELAXED, __HIP_MEMORY_SCOPE_AGENT); }
__device__ __forceinline__ unsigned xb_xcc_id() { return (unsigned)__builtin_amdgcn_s_getreg((3 << 11) | 20) & 0xFu; }
#define XB_SPIN(cond, bar) do { unsigned _sp = 0; while (cond) { __builtin_amdgcn_s_sleep(1); \
    if ((++_sp & 255u) == 0u) { if (xb_ld(&(bar)[XB_TMO])) break; if (_sp > XB_SPIN_CAP) { atomicAdd(&(bar)[XB_TMO], 1u); break; } } } } while (0)

struct XcdBarrier {
    unsigned* bar; unsigned x;
    volatile LAS unsigned* st;
};

__device__ __forceinline__ XcdBarrier xcd_barrier_post(unsigned* bar, volatile LAS unsigned* st) {
    XcdBarrier b; b.bar = bar; b.x = xb_xcc_id(); b.st = st;
    if (threadIdx.x == 0) (void)xb_add(&bar[XB_XCNT(b.x)], 1u);
    return b;
}
__device__ __forceinline__ void xcd_barrier_complete(unsigned* bar, unsigned x, unsigned& nloc, unsigned& nx) {
    const unsigned G = gridDim.x * gridDim.y * gridDim.z;
    unsigned sum, cnt, mine, sp = 0u;
    for (;;) {
        sum = 0u; cnt = 0u; mine = 0u;
#pragma unroll
        for (unsigned j = 0; j < 16; ++j) { const unsigned c = xb_ld(&bar[XB_XCNT(j)]); sum += c; cnt += (c > 0u) ? 1u : 0u; mine = (j == x) ? c : mine; }
        if (sum == G) break;
        __builtin_amdgcn_s_sleep(1);
        if ((++sp & 255u) == 0u) { if (xb_ld(&bar[XB_TMO])) break; if (sp > XB_SPIN_CAP) { atomicAdd(&bar[XB_TMO], 1u); break; } }
    }
    nloc = mine > 0u ? mine : 1u; nx = cnt > 0u ? cnt : 1u;
}

__device__ __forceinline__ void xcd_barrier(const XcdBarrier& b) {
    asm volatile("s_waitcnt vmcnt(0)" ::: "memory");
    __syncthreads();
    if (threadIdx.x == 0) {
        unsigned* bar = b.bar;
        __builtin_amdgcn_s_waitcnt(0);
        unsigned nloc = b.st[0], nx = b.st[1];
        if (nloc == 0u) { xcd_barrier_complete(bar, b.x, nloc, nx); b.st[0] = nloc; b.st[1] = nx; }
        const unsigned old = xb_add(&bar[XB_XSUB(b.x)], 1u);
        const unsigned gen = old / nloc;
        if (old + 1u == (gen + 1u) * nloc) {
            __builtin_amdgcn_fence(__ATOMIC_RELEASE, "agent");
            asm volatile("s_waitcnt vmcnt(0)" ::: "memory");
            const unsigned og = xb_add(&bar[XB_TOP], 1u);
            const unsigned tg = og / nx;
            if (og + 1u == (tg + 1u) * nx) xb_add(&bar[XB_TOPGEN], 1u);
            else XB_SPIN(xb_ld(&bar[XB_TOPGEN]) == tg, bar);
            __builtin_amdgcn_fence(__ATOMIC_ACQUIRE, "agent");
            xb_add(&bar[XB_XGEN(b.x)], 1u);
            asm volatile("s_waitcnt vmcnt(0)" ::: "memory");
        } else {
            XB_SPIN(xb_ld(&bar[XB_XGEN(b.x)]) == gen, bar);
            __builtin_amdgcn_fence(__ATOMIC_ACQUIRE, "agent");
            asm volatile("s_waitcnt vmcnt(0)" ::: "memory");
        }
    }
    __syncthreads();
}
#endif
struct Args {
    const float* xp; const float* xs; const float* st_ca; const float* st_lc; const float* st_lh; const float* g1; const float* w_in; const float* conv_a_w; const float* lru_conv_w;
    const float* lru_conv_b; const float* lru_wa; const float* lru_ba; const float* lru_wx; const float* lru_bx; const float* lru_a_param; const float* w_out; const float* g2;
    const float* w_up; const float* w_down; const float* gf; float* out; unsigned char* ws; int ph_lo, ph_hi;
};
__device__ __forceinline__ float wave_sum(float v) {
#pragma unroll
    for (int o = 1; o < 64; o <<= 1) v += __shfl_xor(v, o);
    return v;
}
__device__ __forceinline__ void p0_transpose_item(const float* W, const float* g, int K, int N, bf16* WT, LAS float* scr, int item, int lane) {
    const int nblk = N / 32, kb = item / nblk, nb = item % nblk, k0 = 64 * kb, n0 = 32 * nb;
#pragma unroll 8
    for (int i = 0; i < 32; ++i) { const int kk = 2 * i + (lane >> 5); float v = W[(size_t)(k0 + kk) * N + n0 + (lane & 31)]; if (g) v *= g[k0 + kk]; scr[kk * 33 + (lane & 31)] = v; }
    LDS_WAIT(); asm volatile("" ::: "memory");
    const int c = lane & 7;
#pragma unroll
    for (int j = 0; j < 4; ++j) { const int n = (lane >> 3) + 8 * j; const LAS float* s = scr + (8 * c) * 33 + n;
        v4u o; o.x = pk2(s[0 * 33], s[1 * 33]); o.y = pk2(s[2 * 33], s[3 * 33]); o.z = pk2(s[4 * 33], s[5 * 33]); o.w = pk2(s[6 * 33], s[7 * 33]);
        *(GAS v4u*)(WT + (size_t)(n0 + n) * K + k0 + 8 * c) = o; }
    LDS_WAIT(); asm volatile("" ::: "memory");
}
__device__ __forceinline__ void rms_row_bf16(const float* xrow, const float* g, bf16* orow, int lane) {
    const GAS f32x4* xr = (const GAS f32x4*)xrow + lane; const GAS f32x4* gr = (const GAS f32x4*)g + lane;
    f32x4 v[4]; float s = 0.f;
#pragma unroll
    for (int j = 0; j < 4; ++j) { v[j] = xr[64 * j]; s += (v[j].x * v[j].x + v[j].y * v[j].y) + (v[j].z * v[j].z + v[j].w * v[j].w); }
    const float rs = 1.0f / sqrtf(wave_sum(s) * (1.f / D) + EPS);
    GAS v2u* o8 = (GAS v2u*)orow + lane;
#pragma unroll
    for (int j = 0; j < 4; ++j) { const f32x4 gg = gr[64 * j]; v2u w; w.x = pk2(v[j].x * rs * gg.x, v[j].y * rs * gg.y); w.y = pk2(v[j].z * rs * gg.z, v[j].w * rs * gg.w); o8[64 * j] = w; }
}
__device__ __forceinline__ void rms_row_f32_inplace(float* xrow, const float* g, int lane) {
    GAS f32x4* xr = (GAS f32x4*)xrow + lane; const GAS f32x4* gr = (const GAS f32x4*)g + lane;
    f32x4 v[4]; float s = 0.f;
#pragma unroll
    for (int j = 0; j < 4; ++j) { v[j] = xr[64 * j]; s += (v[j].x * v[j].x + v[j].y * v[j].y) + (v[j].z * v[j].z + v[j].w * v[j].w); }
    const float rs = 1.0f / sqrtf(wave_sum(s) * (1.f / D) + EPS);
#pragma unroll
    for (int j = 0; j < 4; ++j) { const f32x4 gg = gr[64 * j]; xr[64 * j] = v[j] * rs * gg; }
}
__device__ __forceinline__ void p0_prologue(const Args& A, LAS unsigned char* lds, int gw, int NGW, int wave, int lane) {
    LAS float* scr = (LAS float*)(lds + RING_OFF + wave * 16384);
    unsigned char* ws = A.ws;
    constexpr int I_IN = (D / 64) * (DIN / 32), I_OUT = (D / 64) * (D / 32), I_UP = (D / 64) * (FF / 32), I_DN = (FF / 64) * (D / 32);
    constexpr int NITEMS = I_IN + I_OUT + I_UP + I_DN;
    for (int it = gw; it < NITEMS; it += NGW) {
        int r = it;
        if (r < I_IN) { p0_transpose_item(A.w_in, nullptr, D, DIN, (bf16*)(ws + WS_WIN), scr, r, lane); continue; } r -= I_IN;
        if (r < I_OUT) { p0_transpose_item(A.w_out, nullptr, D, D, (bf16*)(ws + WS_WOUT), scr, r, lane); continue; } r -= I_OUT;
        if (r < I_UP) { p0_transpose_item(A.w_up, A.g2, D, FF, (bf16*)(ws + WS_WUP), scr, r, lane); continue; } r -= I_UP;
        p0_transpose_item(A.w_down, nullptr, FF, D, (bf16*)(ws + WS_WDN), scr, r, lane);
    }
    for (int idx = gw; idx < 128; idx += NGW) {
        const int hd = idx >> 4, gate = (idx >> 3) & 1, jt = (idx >> 1) & 3, ks = idx & 1, jj = lane & 15, q = lane >> 4;
        const float* W = (gate ? A.lru_wx : A.lru_wa) + hd * 4096 + 16 * jt + jj;
        float v[8];
#pragma unroll
        for (int e = 0; e < 8; ++e) v[e] = W[(32 * ks + 16 * (e >> 2) + 4 * q + (e & 3)) * 64];
        v4u o; o.x = pk2(v[0], v[1]); o.y = pk2(v[2], v[3]); o.z = pk2(v[4], v[5]); o.w = pk2(v[6], v[7]);
        *(GAS v4u*)((bf16*)(ws + WS_GW) + (size_t)idx * 512 + lane * 8) = o;
    }
    if (gw >= NGW - 8) {
        const int hd = NGW - 1 - gw, c = hd * 64 + lane; float* hc = (float*)(ws + WS_HC) + hd * 704 + lane;
#pragma unroll
        for (int k = 0; k < 4; ++k) hc[k * 64] = A.lru_conv_w[k * 512 + c];
        hc[256] = A.lru_conv_b[c]; hc[320] = A.lru_ba[c]; hc[384] = A.lru_bx[c];
        { const float x = A.lru_a_param[c]; hc[448] = x > 20.f ? x : log1pf(expf(x)); }
#pragma unroll
        for (int k = 0; k < 3; ++k) hc[512 + k * 64] = A.conv_a_w[k * 512 + c];
    }
    for (int m = gw; m < M; m += NGW) rms_row_bf16(m < MP ? A.xp + (size_t)m * D : A.xs + (size_t)(m - MP) * D, A.g1, (bf16*)(ws + WS_XN) + (size_t)m * D, lane);
}
typedef __amdgpu_buffer_rsrc_t rsrc_t;
__device__ __forceinline__ f32x4 bld_bf16x4(rsrc_t r, int voff, int soff) { const v2u w = __builtin_amdgcn_raw_buffer_load_b64(r, voff, soff, 0); f32x4 o; o.x = __uint_as_float(w.x << 16); o.y = __uint_as_float(w.x & 0xffff0000u); o.z = __uint_as_float(w.y << 16); o.w = __uint_as_float(w.y & 0xffff0000u); return o; }
__device__ __forceinline__ void bst_bf16x4(rsrc_t r, int voff, int soff, f32x4 v) { v2u w; w.x = pg8::cvt_pk_bf16(v.x, v.y); w.y = pg8::cvt_pk_bf16(v.z, v.w); __builtin_amdgcn_raw_buffer_store_b64(w, r, voff, soff, 0); }
#define MEMFENCE() asm volatile("" ::: "memory")
template <bool FINAL>
__device__ __forceinline__ void mix_item(const Args& A, rsrc_t rP, rsrc_t rM, rsrc_t rC, rsrc_t rS, int ck, int hd, int lane) {
    const int tl = lane & 15, q = lane >> 4;
    const int vg = hd * 16384 + lane * 16, vc = 131072 + hd * 2816 + q * 16, vs = hd * 256 + q * 16;
#define LDC(arr, n) __builtin_bit_cast(f32x4, __builtin_amdgcn_raw_buffer_load_b128(rC, vc, (arr) * 256 + (n) * 64, 0))
#define LDG(gate, jt, ks) __builtin_bit_cast(bf16x8, __builtin_amdgcn_raw_buffer_load_b128(rC, vg, (((gate) * 4 + (jt)) * 2 + (ks)) * 1024, 0))
    const bool is_sample = ck >= NPCHUNK, first = is_sample || ((ck & 63) == 0), lastc = is_sample || ((ck & 63) == 63);
    const int sb = is_sample ? ck - NPCHUNK : ck >> 6;
    const int row0 = ck * 64, cb = hd * 64 + 4 * q;
    const int vb0 = ((row0 + tl) * DIN + cb) * 2, mb0 = ((row0 + tl) * D + cb) * 2;
    f32x4 cl[4][4];
#pragma unroll
    for (int n = 0; n < 4; ++n) {
        const int c = cb + 16 * n;
        const f32x4 w0 = LDC(0, n), w1 = LDC(1, n), w2 = LDC(2, n), w3 = LDC(3, n), bb = LDC(4, n);
#pragma unroll
        for (int m = 0; m < 4; ++m) {
            f32x4 x[4];
#pragma unroll
            for (int k = 0; k < 4; ++k) {
                if (m > 0 || k == 3) x[k] = bld_bf16x4(rP, vb0, ((16 * m - 3 + k) * DIN + 1536 + 16 * n) * 2);
                else { const int tk = tl - 3 + k;
                    if (!first || tk >= 0) x[k] = bld_bf16x4(rP, vb0 - (3 - k) * DIN * 2, (1536 + 16 * n) * 2);
                    else if (is_sample) x[k] = *(const f32x4*)(A.st_lc + (size_t)(sb * 3 + 3 + tk) * 512 + c);
                    else x[k] = (f32x4){0.f, 0.f, 0.f, 0.f}; } }
            cl[m][n] = bb + w0 * x[0] + w1 * x[1] + w2 * x[2] + w3 * x[3];
            if (FINAL && m == 3) { if (lastc && tl >= 13) *(f32x4*)(A.out + (is_sample ? O_LCS : O_LCP) + (size_t)(sb * 3 + tl - 13) * 512 + c) = x[3]; }
        }
        if (n & 1) asm volatile("" : "+v"(cl[0][n - 1]), "+v"(cl[1][n - 1]), "+v"(cl[2][n - 1]), "+v"(cl[3][n - 1]), "+v"(cl[0][n]), "+v"(cl[1][n]), "+v"(cl[2][n]), "+v"(cl[3][n]) :: "memory");
    }
    bf16x8 bfr[4][2];
#pragma unroll
    for (int m = 0; m < 4; ++m)
#pragma unroll
        for (int ks = 0; ks < 2; ++ks) { v4u w; const f32x4 a = cl[m][2 * ks], b = cl[m][2 * ks + 1];
            w.x = pg8::cvt_pk_bf16(a.x, a.y); w.y = pg8::cvt_pk_bf16(a.z, a.w); w.z = pg8::cvt_pk_bf16(b.x, b.y); w.w = pg8::cvt_pk_bf16(b.z, b.w); bfr[m][ks] = __builtin_bit_cast(bf16x8, w); }
    const bool reset0 = !is_sample && ((ck & 63) == 0) && tl == 0;
#pragma unroll
    for (int jt = 0; jt < 4; ++jt) {
        const int c = cb + 16 * jt;
        const bf16x8 ar0 = LDG(0, jt, 0), ar1 = LDG(0, jt, 1), ai0 = LDG(1, jt, 0), ai1 = LDG(1, jt, 1);
        const f32x4 ba4 = LDC(5, jt), bx4 = LDC(6, jt), sp4 = LDC(7, jt);
        f32x4 hc = {0.f, 0.f, 0.f, 0.f}, ac = {1.f, 1.f, 1.f, 1.f};
        if (FINAL) {
            if (is_sample) hc = *(const f32x4*)(A.st_lh + (size_t)sb * 512 + c);
            else for (int i = ck & ~63; i < ck; ++i) { const f32x4 pv = __builtin_bit_cast(f32x4, __builtin_amdgcn_raw_buffer_load_b128(rS, vs, i * 4096 + jt * 64, 0)), sv = __builtin_bit_cast(f32x4, __builtin_amdgcn_raw_buffer_load_b128(rS, vs, i * 4096 + 2048 + jt * 64, 0)); hc = pv * hc + sv; }
        }
#pragma unroll
        for (int m = 0; m < 4; ++m) {
            f32x4 zr = {0.f, 0.f, 0.f, 0.f}, zi = {0.f, 0.f, 0.f, 0.f};
            zr = __builtin_amdgcn_mfma_f32_16x16x32_bf16(ar0, bfr[m][0], zr, 0, 0, 0); zr = __builtin_amdgcn_mfma_f32_16x16x32_bf16(ar1, bfr[m][1], zr, 0, 0, 0);
            zi = __builtin_amdgcn_mfma_f32_16x16x32_bf16(ai0, bfr[m][0], zi, 0, 0, 0); zi = __builtin_amdgcn_mfma_f32_16x16x32_bf16(ai1, bfr[m][1], zi, 0, 0, 0);
            f32x4 hv;
#pragma unroll
            for (int r = 0; r < 4; ++r) {
                const float rr = sigmoidf_(zr[r] + ba4[r]), ii = sigmoidf_(zi[r] + bx4[r]);
                const float la = -8.0f * rr * sp4[r], x2 = 2.0f * la;
                float a = fast_exp(la);
                float t = 1.0f - a * a; if (x2 > -0.02f) t = -x2 * (1.0f + x2 * (0.5f + x2 * (1.0f / 6.0f)));
                float mult = __builtin_amdgcn_sqrtf(t); if (m == 0 && reset0) mult = 1.0f;
                float b = mult * (ii * cl[m][jt][r]);
                { const float ap = dpp_shr<1>(a, 1.0f), bp = dpp_shr<1>(b, 0.0f); b = fmaf(a, bp, b); a = a * ap; }
                { const float ap = dpp_shr<2>(a, 1.0f), bp = dpp_shr<2>(b, 0.0f); b = fmaf(a, bp, b); a = a * ap; }
                { const float ap = dpp_shr<4>(a, 1.0f), bp = dpp_shr<4>(b, 0.0f); b = fmaf(a, bp, b); a = a * ap; }
                { const float ap = dpp_shr<8>(a, 1.0f), bp = dpp_shr<8>(b, 0.0f); b = fmaf(a, bp, b); a = a * ap; }
                const float h = fmaf(a, hc[r], b); hv[r] = h;
                hc[r] = __shfl(h, lane | 15);
                if (!FINAL) ac[r] = ac[r] * __shfl(a, lane | 15);
            }
            if (FINAL) {
                const f32x4 g = bld_bf16x4(rP, vb0, (16 * m * DIN + 2048 + 16 * jt) * 2); f32x4 o;
#pragma unroll
                for (int r = 0; r < 4; ++r) { const float gg = g[r]; o[r] = hv[r] * gg * sigmoidf_(1.5957691216f * (gg + 0.044715f * gg * gg * gg)); }
                bst_bf16x4(rM, mb0, (16 * m * D + 512 + 16 * jt) * 2, o);
            }
        }
        if (FINAL) { if (lastc && tl == 15) *(f32x4*)(A.out + (is_sample ? O_LHS : O_LHP) + (size_t)sb * 512 + c) = hc; }
        else if (tl == 0) { __builtin_amdgcn_raw_buffer_store_b128(__builtin_bit_cast(v4u, ac), rS, vs, ck * 4096 + jt * 64, 0); __builtin_amdgcn_raw_buffer_store_b128(__builtin_bit_cast(v4u, hc), rS, vs, ck * 4096 + 2048 + jt * 64, 0); }
        MEMFENCE();
    }
    if (FINAL) {
#pragma unroll
        for (int n = 0; n < 4; ++n) {
            const int c = cb + 16 * n;
            const f32x4 w0 = LDC(8, n), w1 = LDC(9, n), w2 = LDC(10, n);
#pragma unroll
            for (int m = 0; m < 4; ++m) {
                f32x4 u[3];
#pragma unroll
                for (int k = 0; k < 3; ++k) {
                    if (m > 0 || k == 2) { const int so = ((16 * m - 2 + k) * DIN + 16 * n) * 2; u[k] = bld_bf16x4(rP, vb0, so + 1024) * bld_bf16x4(rP, vb0, so + 2048); }
                    else { const int tk = tl - 2 + k;
                        if (!first || tk >= 0) { const int vo = vb0 - (2 - k) * DIN * 2; u[k] = bld_bf16x4(rP, vo, 16 * n * 2 + 1024) * bld_bf16x4(rP, vo, 16 * n * 2 + 2048); }
                        else if (is_sample) u[k] = *(const f32x4*)(A.st_ca + (size_t)(sb * 2 + 2 + tk) * 512 + c);
                        else u[k] = (f32x4){0.f, 0.f, 0.f, 0.f}; } }
                const f32x4 ca = w0 * u[0] + w1 * u[1] + w2 * u[2], gb = bld_bf16x4(rP, vb0, (16 * m * DIN + 16 * n) * 2);
                bst_bf16x4(rM, mb0, (16 * m * D + 16 * n) * 2, gb * ca);
                if (m == 3) { if (lastc && tl >= 14) *(f32x4*)(A.out + (is_sample ? O_CAS : O_CAP) + (size_t)(sb * 2 + tl - 14) * 512 + c) = u[2]; }
            }
            MEMFENCE();
        }
    }
#undef LDC
#undef LDG
}
constexpr int N_PHASES = 8;
__global__ void __launch_bounds__(NWAVES * 64, 2) fwd_kernel(Args args) {
    extern __shared__ __attribute__((aligned(16))) unsigned char lds_raw[];
    LAS unsigned char* lds = (LAS unsigned char*)lds_raw;
    const int tid = threadIdx.x, lane = tid & 63, wave = __builtin_amdgcn_readfirstlane(tid >> 6);
    const int G = gridDim.x, bx = blockIdx.x, vcu = (G % 8 == 0) ? (bx % 8) * (G / 8) + bx / 8 : bx;
    const int gw = vcu * NWAVES + wave, NGW = G * NWAVES;
    unsigned char* ws = args.ws;
#if MK_MODE == 2
    volatile LAS unsigned* MISC = (volatile LAS unsigned*)(lds + MISC_OFF);
    for (int u = tid; u < (LDS_BYTES - LDSCTL_OFF) / 4; u += NWAVES * 64) ((LAS unsigned*)(lds + LDSCTL_OFF))[u] = 0u;
    __syncthreads();
    XcdBarrier bar = xcd_barrier_post((unsigned*)(ws + WS_CTL) + CW_BAR, MISC + 8);
#define GRID_BAR() xcd_barrier(bar)
#elif MK_MODE == 0
    cg::grid_group grid = cg::this_grid();
#define GRID_BAR() grid.sync()
#else
#define GRID_BAR() do {} while (0)
#endif
    const int lo = args.ph_lo, hi = args.ph_hi;
#ifndef PH_MASK
#define PH_MASK 0xff
#endif
#define IN(k) (((PH_MASK >> (k)) & 1) && lo <= (k) && (k) < hi)
#define SEAM(k) do { if (IN(k) && IN((k) + 1)) GRID_BAR(); } while (0)

    if (IN(0)) { p0_prologue(args, lds, gw, NGW, wave, lane); } SEAM(0);
    if (IN(1)) {
        pg8::Gemm g{(const bf16*)(ws + WS_XN), (const bf16*)(ws + WS_WIN), M, DIN, D}; pg8::StaticOrder S; S.init(M, DIN, G, bx);
        pg8::EpiProj E{(bf16*)(ws + WS_PROJ), DIN};
        pg8::gemm_phase<pg8::EpiProj, pg8::StaticOrder, PG8_ALIGN, PG8_SP2>(lds + RING_OFF, g, S, E);
    } SEAM(1);
    const rsrc_t rP = __builtin_amdgcn_make_buffer_rsrc((void*)(ws + WS_PROJ), 0, (int)((size_t)M * DIN * 2), 0x00020000), rM = __builtin_amdgcn_make_buffer_rsrc((void*)(ws + WS_MIX), 0, (int)((size_t)M * D * 2), 0x00020000),
        rC = __builtin_amdgcn_make_buffer_rsrc((void*)(ws + WS_GW), 0, 131072 + 8 * 2816, 0x00020000), rS = __builtin_amdgcn_make_buffer_rsrc((void*)(ws + WS_SUM), 0, NPCHUNK * 4096, 0x00020000);
    if (IN(2)) { for (int it = gw; it < NPCHUNK * 8; it += NGW) mix_item<false>(args, rP, rM, rC, rS, it >> 3, it & 7, lane); } SEAM(2);
    if (IN(3)) { for (int it = gw; it < NCHUNK * 8; it += NGW) mix_item<true>(args, rP, rM, rC, rS, it >> 3, it & 7, lane); } SEAM(3);
    if (IN(4)) {
        pg8::Gemm g{(const bf16*)(ws + WS_MIX), (const bf16*)(ws + WS_WOUT), M, D, D}; pg8::StaticOrder S; S.init(M, D, G, bx);
        pg8::EpiX1 E{args.xp, args.xs, args.out, (bf16*)(ws + WS_XN), (float*)(ws + WS_SS)};
        pg8::gemm_phase<pg8::EpiX1, pg8::StaticOrder, PG8_ALIGN, PG8_SP2>(lds + RING_OFF, g, S, E);
    } SEAM(4);
    if (IN(5)) {
        pg8::Gemm g{(const bf16*)(ws + WS_XN), (const bf16*)(ws + WS_WUP), M, FF, D}; pg8::StaticOrder S; S.init(M, FF, G, bx);
        pg8::EpiUp E{(bf16*)(ws + WS_H), (const float*)(ws + WS_SS), EPS};
        pg8::gemm_phase<pg8::EpiUp, pg8::StaticOrder, PG8_ALIGN, PG8_SP2>(lds + RING_OFF, g, S, E);
    } SEAM(5);
    if (IN(6)) {
        pg8::Gemm g{(const bf16*)(ws + WS_H), (const bf16*)(ws + WS_WDN), M, D, FF}; pg8::StaticOrder S; S.init(M, D, G, bx);
        pg8::EpiDown E{args.out};
        pg8::gemm_phase<pg8::EpiDown, pg8::StaticOrder, PG8_ALIGN, PG8_SP2>(lds + RING_OFF, g, S, E);
    } SEAM(6);
    if (IN(7)) { for (int m = gw; m < M; m += NGW) rms_row_f32_inplace(args.out + (size_t)m * D, args.gf, lane); }
#undef IN
#undef SEAM
}

extern "C" void kernel_launch(void* const* d_in, const int* in_sizes, int n_in, void* d_out, int out_size, void* d_ws, size_t ws_size, hipStream_t stream) {
    static int grid = 0;
    if (grid == 0) {
        if (n_in != 20 || out_size != (int)O_END || ws_size < WS_END) { fprintf(stderr, "kernel_launch: unexpected shapes (n_in %d out %d ws %zu)\n", n_in, out_size, ws_size); grid = -1; return; }
        int dev = 0, cus = 0, per_cu = 0;
        if (hipGetDevice(&dev) != hipSuccess || hipDeviceGetAttribute(&cus, hipDeviceAttributeMultiprocessorCount, dev) != hipSuccess) { grid = -1; return; }
        if (hipFuncSetAttribute((const void*)fwd_kernel, hipFuncAttributeMaxDynamicSharedMemorySize, LDS_BYTES) != hipSuccess) { fprintf(stderr, "kernel_launch: hipFuncSetAttribute failed\n"); grid = -1; return; }
        if (hipOccupancyMaxActiveBlocksPerMultiprocessor(&per_cu, (const void*)fwd_kernel, NWAVES * 64, LDS_BYTES) != hipSuccess || per_cu < 1) { fprintf(stderr, "kernel_launch: occupancy query says %d blocks per CU\n", per_cu); per_cu = 1; }
        (void)hipGetLastError();
        grid = cus;
    }
    if (grid < 0) return;
    Args a{};
    a.xp = (const float*)d_in[0]; a.xs = (const float*)d_in[1]; a.st_ca = (const float*)d_in[2]; a.st_lc = (const float*)d_in[3]; a.st_lh = (const float*)d_in[4]; a.g1 = (const float*)d_in[5];
    a.w_in = (const float*)d_in[6]; a.conv_a_w = (const float*)d_in[7]; a.lru_conv_w = (const float*)d_in[8]; a.lru_conv_b = (const float*)d_in[9]; a.lru_wa = (const float*)d_in[10];
    a.lru_ba = (const float*)d_in[11]; a.lru_wx = (const float*)d_in[12]; a.lru_bx = (const float*)d_in[13]; a.lru_a_param = (const float*)d_in[14]; a.w_out = (const float*)d_in[15];
    a.g2 = (const float*)d_in[16]; a.w_up = (const float*)d_in[17]; a.w_down = (const float*)d_in[18]; a.gf = (const float*)d_in[19]; a.out = (float*)d_out; a.ws = (unsigned char*)d_ws;
#if MK_MODE == 1
    for (int p = 0; p < N_PHASES; ++p) { a.ph_lo = p; a.ph_hi = p + 1; hipLaunchKernelGGL(fwd_kernel, dim3(grid), dim3(NWAVES * 64), LDS_BYTES, stream, a); }
#elif MK_MODE == 0
    a.ph_lo = 0; a.ph_hi = N_PHASES;
    void* kargs[] = {&a};
    hipError_t e = hipLaunchCooperativeKernel((const void*)fwd_kernel, dim3(grid), dim3(NWAVES * 64), kargs, LDS_BYTES, stream);
    if (e != hipSuccess) fprintf(stderr, "kernel_launch: cooperative launch failed: %s (grid %d)\n", hipGetErrorString(e), grid);
#else
    if (hipMemsetAsync((char*)d_ws + WS_CTL, 0, CTL_ZERO_BYTES, stream) != hipSuccess) { fprintf(stderr, "kernel_launch: memset failed\n"); return; }
    a.ph_lo = 0; a.ph_hi = N_PHASES;
    hipLaunchKernelGGL(fwd_kernel, dim3(grid), dim3(NWAVES * 64), LDS_BYTES, stream, a);
#endif
    const hipError_t le = hipPeekAtLastError();
    if (le != hipSuccess) fprintf(stderr, "kernel_launch: launch failed: %s\n", hipGetErrorName(le));
}
```

```cpp
#include <hip/hip_runtime.h>
#include <hip/hip_cooperative_groups.h>
#include <cstdio>
#include <cstdint>
namespace cg = cooperative_groups;
#ifndef MK_MODE
#define MK_MODE 2
#endif
namespace pg8 {
#define PG8_LAS __attribute__((address_space(3)))
typedef unsigned short bf16_t;
typedef short bf16x8 __attribute__((ext_vector_type(8)));
typedef float f32x4 __attribute__((ext_vector_type(4)));
typedef unsigned u32x4 __attribute__((ext_vector_type(4)));
constexpr int BM = 256, BK = 64, HALF = 128, HTB = HALF * BK * 2  , STAGE_BYTES = 8 * HTB, NXCD = 8, WGM = 8;

__host__ __device__ __forceinline__ int lds_byte(int r, int c) { const int st = (r >> 4) * 2 + (c >> 5), rr = r & 15, cc = c & 31, ob = rr * 64 + cc * 2; return st * 1024 + (ob ^ (((ob >> 9) & 1) << 5)); }
__host__ __device__ __forceinline__ void stage_rc(int b, int& R, int& C) { const int st = b / 1024, sb = b % 1024, swz = sb ^ (((sb >> 9) & 1) << 5); R = (st >> 1) * 16 + swz / 64; C = (st & 1) * 32 + (swz % 64) / 2; }
__host__ __device__ __forceinline__ int perm32(int rho) { const int n = rho >> 4, i = rho & 15; return 8 * (i >> 2) + 4 * n + (i & 3); }

struct Unit { int pm, pn; };
struct Gemm { const bf16_t* A; const bf16_t* Bt; int M, N, K; };

struct StaticOrder {
    int nM, nN, nwg, G, c;
    __host__ __device__ void init(int M, int N, int G_, int c_) { nM = M / BM; nN = N / BM; nwg = nM * nN; G = G_; c = c_; }
    __host__ __device__ bool next(int i, Unit& u) const {
        const long L = (long)i * G + c; if (L >= nwg) return false;
        int wgid = (int)L; { const int q = nwg / NXCD, r = nwg % NXCD, xcd = wgid % NXCD, off = wgid / NXCD; wgid = (xcd < r ? xcd * (q + 1) : r * (q + 1) + (xcd - r) * q) + off; }
        const int nig = WGM * nN, gid = wgid / nig, fm = gid * WGM, gsz = (nM - fm) < WGM ? (nM - fm) : WGM;
        u.pm = fm + ((wgid % nig) % gsz); u.pn = (wgid % nig) / gsz; return true;
    }
    __device__ __forceinline__ void a_ready(const Unit&) const {}
    __device__ __forceinline__ void done(const Unit&) const {}
};

__device__ __forceinline__ unsigned cvt_pk_bf16(float lo, float hi) { unsigned r; asm volatile("v_cvt_pk_bf16_f32 %0, %1, %2" : "=v"(r) : "v"(lo), "v"(hi)); return r; }
typedef float f32x2 __attribute__((ext_vector_type(2)));
__device__ __forceinline__ f32x2 gelu_pk(f32x2 v) {
    const f32x2 av = __builtin_elementwise_abs(v), d = av * 0.2316418882f + 1.0f;
    f32x2 t; t.x = __builtin_amdgcn_rcpf(d.x); t.y = __builtin_amdgcn_rcpf(d.y);
    f32x2 q = t * 0.5307027145f + (-0.7265760135f); q = q * t + 0.7107068705f; q = q * t + (-0.142248368f); q = q * t + 0.127414796f; q = q * t;
    const f32x2 s = (v * v) * (-0.72134752044f);
    f32x2 e; e.x = __builtin_amdgcn_exp2f(s.x); e.y = __builtin_amdgcn_exp2f(s.y);
    const f32x2 m = v * (q * e), r = v - m;
    f32x2 o; o.x = v.x < 0.f ? m.x : r.x; o.y = v.y < 0.f ? m.y : r.y; return o;
}

typedef unsigned u32x2 __attribute__((ext_vector_type(2)));
struct EpiProj {
    static constexpr bool PERM = true, AFTER_DRAIN = false;
    bf16_t* O; int ldc;
    __device__ __forceinline__ void operator()(const f32x4 (&acc)[2][2][4][2], const Unit& u, int wr, int wc, int fr, int fq) const {
        const int row0 = u.pm * BM + wr * 64 + fr, col0 = u.pn * BM + wc * 32 + 8 * fq;
#pragma unroll
        for (int ai = 0; ai < 2; ++ai)
#pragma unroll
            for (int m = 0; m < 4; ++m) { bf16_t* rowp = O + (size_t)(row0 + ai * HALF + m * 16) * ldc + col0;
#pragma unroll
                for (int bj = 0; bj < 2; ++bj) { const f32x4 v0 = acc[ai][bj][m][0], v1 = acc[ai][bj][m][1];
                    u32x4 w; w.x = cvt_pk_bf16(v0[0], v0[1]); w.y = cvt_pk_bf16(v0[2], v0[3]); w.z = cvt_pk_bf16(v1[0], v1[1]); w.w = cvt_pk_bf16(v1[2], v1[3]);
                    *(u32x4*)(rowp + bj * HALF) = w; } }
    }
};
struct EpiX1 {
    static constexpr bool PERM = false, AFTER_DRAIN = false;
    const float* xp; const float* xs; float* out; bf16_t* x1b; float* ss;
    __device__ __forceinline__ void operator()(const f32x4 (&acc)[2][2][4][2], const Unit& u, int wr, int wc, int fr, int fq) const {
        const int row0 = u.pm * BM + wr * 64 + fr, col0 = u.pn * BM + wc * 32 + 4 * fq;
        const float* xin = (u.pm < 64) ? xp : xs - (size_t)16384 * 1024;
#pragma unroll
        for (int ai = 0; ai < 2; ++ai)
#pragma unroll
            for (int m = 0; m < 4; ++m) { const size_t off = (size_t)(row0 + ai * HALF + m * 16) * 1024 + col0; float s = 0.f;
#pragma unroll
                for (int bj = 0; bj < 2; ++bj)
#pragma unroll
                    for (int n = 0; n < 2; ++n) { const size_t o = off + bj * HALF + n * 16; const f32x4 v = *(const f32x4*)(xin + o) + acc[ai][bj][m][n];
                        *(f32x4*)(out + o) = v; u32x2 w; w.x = cvt_pk_bf16(v[0], v[1]); w.y = cvt_pk_bf16(v[2], v[3]); *(u32x2*)(x1b + o) = w;
                        s += (v[0] * v[0] + v[1] * v[1]) + (v[2] * v[2] + v[3] * v[3]); }
                s += __shfl_xor(s, 16); s += __shfl_xor(s, 32);
                if (fq == 0) ss[(size_t)(row0 + ai * HALF + m * 16) * 16 + u.pn * 4 + wc] = s; }
    }
};
struct EpiUp {
    static constexpr bool PERM = true, AFTER_DRAIN = false;
    bf16_t* H; const float* ss; float eps;
    __device__ __forceinline__ void operator()(const f32x4 (&acc)[2][2][4][2], const Unit& u, int wr, int wc, int fr, int fq) const {
        const int row0 = u.pm * BM + wr * 64 + fr, col0 = u.pn * BM + wc * 32 + 8 * fq;
#pragma unroll
        for (int ai = 0; ai < 2; ++ai)
#pragma unroll
            for (int m = 0; m < 4; ++m) { const int r = row0 + ai * HALF + m * 16; const f32x4* sp = (const f32x4*)(ss + (size_t)r * 16);
                const f32x4 t = (sp[0] + sp[1]) + (sp[2] + sp[3]); const float rs2 = 1.0f / (((t[0] + t[1]) + (t[2] + t[3])) * (1.0f / 1024.0f) + eps);
                bf16_t* rowp = H + (size_t)r * 4096 + col0;
#pragma unroll
                for (int bj = 0; bj < 2; ++bj) { f32x4 v0 = acc[ai][bj][m][0], v1 = acc[ai][bj][m][1];
#pragma unroll
                    for (int j = 0; j < 4; ++j) { const float a = fmaxf(v0[j], 0.f), b = fmaxf(v1[j], 0.f); v0[j] = a * a * rs2; v1[j] = b * b * rs2; }
                    u32x4 w; w.x = cvt_pk_bf16(v0[0], v0[1]); w.y = cvt_pk_bf16(v0[2], v0[3]); w.z = cvt_pk_bf16(v1[0], v1[1]); w.w = cvt_pk_bf16(v1[2], v1[3]);
                    *(u32x4*)(rowp + bj * HALF) = w; } }
    }
};
struct EpiDown {
    static constexpr bool PERM = false, AFTER_DRAIN = false;
    float* out;
    __device__ __forceinline__ void operator()(const f32x4 (&acc)[2][2][4][2], const Unit& u, int wr, int wc, int fr, int fq) const {
        const int row0 = u.pm * BM + wr * 64 + fr, col0 = u.pn * BM + wc * 32 + 4 * fq;
#pragma unroll
        for (int ai = 0; ai < 2; ++ai)
#pragma unroll
            for (int m = 0; m < 4; ++m) { float* rowp = out + (size_t)(row0 + ai * HALF + m * 16) * 1024 + col0;
#pragma unroll
                for (int bj = 0; bj < 2; ++bj)
#pragma unroll
                    for (int n = 0; n < 2; ++n) { f32x4* p = (f32x4*)(rowp + bj * HALF + n * 16); *p = *p + acc[ai][bj][m][n]; } }
    }
};

template <class Epi, class Sched, bool ALIGN_EPI = false, bool SP2 = false>
__device__ __forceinline__ void gemm_phase(PG8_LAS unsigned char* lds, const Gemm g, const Sched& S, const Epi& E) {
    const int tid = threadIdx.x, wid = __builtin_amdgcn_readfirstlane(tid >> 6), lane = tid & 63, wr = wid >> 2, wc = wid & 3, fr = lane & 15, fq = lane >> 4;
    const int K = g.K, nt = K / BK;
    unsigned voffA[2], voffB[2];
#pragma unroll
    for (int i = 0; i < 2; ++i) { int R, C; stage_rc(tid * 16 + i * 8192, R, C); const int Rb = Epi::PERM ? ((R & ~31) + perm32(R & 31)) : R;
        voffA[i] = (unsigned)(R * K + C) * 2u; voffB[i] = (unsigned)(Rb * K + C) * 2u; }
    const size_t kstep = (size_t)(BK * 2);
    const size_t hstep = (size_t)HALF * K * 2;
    const size_t tstep = 2 * hstep;
    const unsigned ldsw = (unsigned)wid * 1024u;
    const int aoff = lds_byte(wr * 64 + fr, fq * 8), boff = lds_byte(wc * 32 + fr, fq * 8);
#define PG8_SA(b, h) (((b) * 2 + (h)) * HTB)
#define PG8_SB(b, h) ((4 + (b) * 2 + (h)) * HTB)
#define PG8_STAGE(bufoff, gbase, voff) do { _Pragma("unroll") for (int _i = 0; _i < 2; ++_i) \
        __builtin_amdgcn_global_load_lds((const unsigned*)((const char*)(gbase) + (voff)[_i]), (PG8_LAS unsigned*)(lds + (bufoff) + ldsw + _i * 8192), 16, 0, 0); } while (0)
#define PG8_LDA(dst, b, h) do { _Pragma("unroll") for (int m = 0; m < 4; ++m) _Pragma("unroll") for (int k = 0; k < 2; ++k) dst[m][k] = *(const PG8_LAS bf16x8*)(lds + PG8_SA(b, h) + aoff + m * 2048 + k * 1024); } while (0)
#define PG8_LDB(dst, b, h) do { _Pragma("unroll") for (int n = 0; n < 2; ++n) _Pragma("unroll") for (int k = 0; k < 2; ++k) dst[n][k] = *(const PG8_LAS bf16x8*)(lds + PG8_SB(b, h) + boff + n * 2048 + k * 1024); } while (0)
#define PG8_MMA(ai, bj, At, Bt) do { __builtin_amdgcn_s_setprio(1); _Pragma("unroll") for (int m = 0; m < 4; ++m) _Pragma("unroll") for (int n = 0; n < 2; ++n) _Pragma("unroll") for (int k = 0; k < 2; ++k) \
        acc[ai][bj][m][n] = __builtin_amdgcn_mfma_f32_16x16x32_bf16(Bt[n][k], At[m][k], acc[ai][bj][m][n], 0, 0, 0); __builtin_amdgcn_s_setprio(0); } while (0)
#define PG8_WAIT_V(n) asm volatile("s_waitcnt vmcnt(" #n ")" ::: "memory")
#define PG8_WAIT_L(n) asm volatile("s_waitcnt lgkmcnt(" #n ")" ::: "memory")
#define PG8_BAR __builtin_amdgcn_s_barrier()
#define PG8_SCHED __builtin_amdgcn_sched_barrier(0)
    Unit cur, nxt; int ui = 0;
    if (!S.next(0, cur)) return;
    f32x4 acc[2][2][4][2];
#pragma unroll
    for (int a = 0; a < 2; ++a)
#pragma unroll
        for (int b = 0; b < 2; ++b)
#pragma unroll
            for (int m = 0; m < 4; ++m)
#pragma unroll
                for (int n = 0; n < 2; ++n) acc[a][b][m][n] = (f32x4){0.f, 0.f, 0.f, 0.f};
    bf16x8 At[4][2], B0[2][2], B1[2][2];
    const char* cA = (const char*)g.A + (size_t)cur.pm * tstep; const char* cB = (const char*)g.Bt + (size_t)cur.pn * tstep;
    S.a_ready(cur);
    if constexpr (SP2) {
        PG8_STAGE(PG8_SB(0, 0), cB, voffB); PG8_STAGE(PG8_SB(0, 1), cB + hstep, voffB); PG8_STAGE(PG8_SA(0, 0), cA, voffA); PG8_STAGE(PG8_SA(0, 1), cA + hstep, voffA);
        if (wr == 1) PG8_BAR;
        PG8_WAIT_V(2); PG8_BAR;
        PG8_STAGE(PG8_SB(1, 0), cB + kstep, voffB); PG8_STAGE(PG8_SA(1, 0), cA + kstep, voffA); PG8_STAGE(PG8_SB(1, 1), cB + hstep + kstep, voffB);
        PG8_WAIT_V(6); PG8_BAR;
    } else {
        PG8_STAGE(PG8_SB(0, 0), cB, voffB); PG8_STAGE(PG8_SA(0, 0), cA, voffA); PG8_STAGE(PG8_SB(0, 1), cB + hstep, voffB); PG8_STAGE(PG8_SA(0, 1), cA + hstep, voffA);
        if (wr == 1) PG8_BAR;
        PG8_WAIT_V(4); PG8_BAR;
        PG8_STAGE(PG8_SB(1, 0), cB + kstep, voffB); PG8_STAGE(PG8_SA(1, 0), cA + kstep, voffA); PG8_STAGE(PG8_SB(1, 1), cB + hstep + kstep, voffB);
        PG8_WAIT_V(6); PG8_BAR;
    }
    for (;;) {
        const bool has_next = S.next(ui + 1, nxt);
        const char* nA = has_next ? (const char*)g.A + (size_t)nxt.pm * tstep : cA; const char* nB = has_next ? (const char*)g.Bt + (size_t)nxt.pn * tstep : cB;
        for (int t = 0; t < nt; t += 2) {
            const bool last = (t == nt - 2);
            const char* a1 = cA + (size_t)(t + 1) * kstep;
            const char* a2 = last ? nA : cA + (size_t)(t + 2) * kstep; const char* b2 = last ? nB : cB + (size_t)(t + 2) * kstep;
            const char* a3 = a2 + kstep; const char* b3 = b2 + kstep;
            if (last && has_next) S.a_ready(nxt);
            if constexpr (SP2) {
            PG8_LDB(B0, 0, 0); PG8_LDB(B1, 0, 1); PG8_SCHED; PG8_LDA(At, 0, 0); PG8_STAGE(PG8_SA(1, 1), a1 + hstep, voffA);
            PG8_WAIT_V(8); PG8_WAIT_L(0); PG8_BAR; PG8_MMA(0, 0, At, B0); PG8_MMA(0, 1, At, B1); PG8_BAR; PG8_SCHED;
            PG8_LDA(At, 0, 1); PG8_STAGE(PG8_SB(0, 0), b2, voffB); PG8_STAGE(PG8_SB(0, 1), b2 + hstep, voffB); PG8_STAGE(PG8_SA(0, 0), a2, voffA);
            PG8_WAIT_V(8); PG8_WAIT_L(0); PG8_BAR; PG8_MMA(1, 0, At, B0); PG8_MMA(1, 1, At, B1); PG8_BAR; PG8_SCHED;
            PG8_LDB(B0, 1, 0); PG8_LDB(B1, 1, 1); PG8_SCHED; PG8_LDA(At, 1, 0); PG8_STAGE(PG8_SA(0, 1), a2 + hstep, voffA);
            PG8_WAIT_V(8); PG8_WAIT_L(0); PG8_BAR; PG8_MMA(0, 0, At, B0); PG8_MMA(0, 1, At, B1); PG8_BAR; PG8_SCHED;
            PG8_LDA(At, 1, 1); PG8_STAGE(PG8_SB(1, 0), b3, voffB); PG8_STAGE(PG8_SB(1, 1), b3 + hstep, voffB); PG8_STAGE(PG8_SA(1, 0), a3, voffA);
            PG8_WAIT_V(8); PG8_WAIT_L(0); PG8_BAR; PG8_MMA(1, 0, At, B0); PG8_MMA(1, 1, At, B1); PG8_BAR; PG8_SCHED;
            } else {
            PG8_LDB(B0, 0, 0); PG8_SCHED; PG8_LDA(At, 0, 0); PG8_STAGE(PG8_SA(1, 1), a1 + hstep, voffA);
            PG8_WAIT_L(8); PG8_BAR; PG8_WAIT_L(0); PG8_MMA(0, 0, At, B0); PG8_BAR; PG8_SCHED;
            PG8_LDB(B1, 0, 1); PG8_STAGE(PG8_SB(0, 0), b2, voffB);
            PG8_BAR; PG8_WAIT_L(0); PG8_MMA(0, 1, At, B1); PG8_BAR;
            PG8_LDA(At, 0, 1); PG8_STAGE(PG8_SA(0, 0), a2, voffA);
            PG8_BAR; PG8_WAIT_L(0); PG8_MMA(1, 0, At, B0); PG8_BAR; PG8_SCHED;
            PG8_STAGE(PG8_SB(0, 1), b2 + hstep, voffB);
            PG8_WAIT_V(6); PG8_BAR; PG8_MMA(1, 1, At, B1); PG8_BAR;
            PG8_LDB(B0, 1, 0); PG8_SCHED; PG8_LDA(At, 1, 0); PG8_STAGE(PG8_SA(0, 1), a2 + hstep, voffA);
            PG8_WAIT_L(8); PG8_BAR; PG8_WAIT_L(0); PG8_MMA(0, 0, At, B0); PG8_BAR; PG8_SCHED;
            PG8_LDB(B1, 1, 1); PG8_STAGE(PG8_SB(1, 0), b3, voffB);
            PG8_BAR; PG8_WAIT_L(0); PG8_MMA(0, 1, At, B1); PG8_BAR;
            PG8_LDA(At, 1, 1); PG8_STAGE(PG8_SA(1, 0), a3, voffA);
            PG8_BAR; PG8_WAIT_L(0); PG8_MMA(1, 0, At, B0); PG8_BAR; PG8_SCHED;
            PG8_STAGE(PG8_SB(1, 1), b3 + hstep, voffB);
            PG8_WAIT_V(6); PG8_BAR; PG8_MMA(1, 1, At, B1); PG8_BAR;
            }
        }
        if constexpr (ALIGN_EPI) { if (wr == 0) PG8_BAR; }
        if constexpr (!Epi::AFTER_DRAIN) { E(acc, cur, wr, wc, fr, fq); S.done(cur); }
        if (!has_next) break;
#pragma unroll
        for (int a = 0; a < 2; ++a)
#pragma unroll
            for (int b = 0; b < 2; ++b)
#pragma unroll
                for (int m = 0; m < 4; ++m)
#pragma unroll
                    for (int n = 0; n < 2; ++n) acc[a][b][m][n] = (f32x4){0.f, 0.f, 0.f, 0.f};
        cur = nxt; cA = nA; cB = nB; ++ui;
        if constexpr (ALIGN_EPI) { if (wr == 1) PG8_BAR; }
    }
    PG8_WAIT_V(0);
    if constexpr (!ALIGN_EPI) { if (wr == 0) PG8_BAR; }
    PG8_BAR;
    if constexpr (Epi::AFTER_DRAIN) { E.fused(acc, cur, wr, wc, fr, fq, lds, wid, lane); S.done(cur); }
#undef PG8_SA
#undef PG8_SB
#undef PG8_STAGE
#undef PG8_LDA
#undef PG8_LDB
#undef PG8_MMA
#undef PG8_WAIT_V
#undef PG8_WAIT_L
#undef PG8_BAR
#undef PG8_SCHED
}
}
#ifndef PG8_SP2
#define PG8_SP2 true
#endif
#ifndef PG8_ALIGN
#define PG8_ALIGN true
#endif
constexpr int NWAVES = 8;
constexpr int D = 1024, DIN = 2560, FF = 4096, DC = 512, DL = 512;
constexpr int MP = 4 * 4096, MS = 32 * 64, M = MP + MS;
constexpr int NCHUNK = M / 64, NPCHUNK = MP / 64;
constexpr float EPS = 1e-6f;
constexpr size_t O_YP = 0, O_YS = (size_t)MP * D, O_CAP = (size_t)M * D, O_LCP = O_CAP + 4 * 2 * 512, O_LHP = O_LCP + 4 * 3 * 512, O_CAS = O_LHP + 4 * 512, O_LCS = O_CAS + 32 * 2 * 512, O_LHS = O_LCS + 32 * 3 * 512, O_END = O_LHS + 32 * 512;
constexpr size_t MiB = 1u << 20;
constexpr size_t WS_CTL = 0, CTL_ZERO_BYTES = 1 * MiB;
constexpr size_t WS_WIN = 2 * MiB, WS_WOUT = 8 * MiB, WS_WUP = 10 * MiB, WS_WDN = 18 * MiB;
constexpr size_t WS_GW = 26 * MiB;
constexpr size_t WS_HC = WS_GW + 131072;
constexpr size_t WS_SS = 27 * MiB;
constexpr size_t WS_SUM = 29 * MiB;
constexpr size_t WS_XN = 32 * MiB;
constexpr size_t WS_H = 68 * MiB;
constexpr size_t WS_PROJ = 68 * MiB;
constexpr size_t WS_MIX = 160 * MiB;
constexpr size_t WS_END = 212 * MiB;
static_assert(WS_XN + (size_t)M * D * 2 <= WS_H && WS_PROJ + (size_t)M * DIN * 2 <= WS_MIX && WS_MIX + (size_t)M * D * 2 <= WS_END && WS_H + (size_t)M * FF * 2 <= WS_END, "d_ws map");
static_assert(WS_SS + (size_t)M * 16 * 4 <= WS_SUM && WS_SUM + (size_t)NPCHUNK * 2 * 512 * 4 <= WS_XN, "d_ws map (small)");
constexpr int CW_BAR = 4096;
constexpr int RING_OFF = 0, RING_BYTES = 131072;
constexpr int LDSCTL_OFF = RING_BYTES, MISC_OFF = LDSCTL_OFF + 320;
constexpr int LDS_BYTES = 147456;
#define GAS __attribute__((address_space(1)))
#define LAS __attribute__((address_space(3)))
typedef unsigned short bf16;
typedef unsigned v4u __attribute__((ext_vector_type(4)));
typedef unsigned v2u __attribute__((ext_vector_type(2)));
typedef float f32x4 __attribute__((ext_vector_type(4)));
typedef short bf16x8 __attribute__((ext_vector_type(8)));
typedef GAS unsigned gu32;
#define RLX_AGENT __ATOMIC_RELAXED, __HIP_MEMORY_SCOPE_AGENT
#define LDS_WAIT() asm volatile("s_waitcnt lgkmcnt(0)" ::: "memory")
#define VM_WAIT() asm volatile("s_waitcnt vmcnt(0)" ::: "memory")
__device__ __forceinline__ unsigned f2bf(float f) { unsigned u = __builtin_bit_cast(unsigned, f); return (u + 0x7fffu + ((u >> 16) & 1u)) >> 16; }
__device__ __forceinline__ unsigned pk2(float lo, float hi) { return f2bf(lo) | (f2bf(hi) << 16); }
__device__ __forceinline__ f32x4 ld_bf16x4(const bf16* p) { const v2u w = *(const v2u*)p; f32x4 r; r.x = __uint_as_float(w.x << 16); r.y = __uint_as_float(w.x & 0xffff0000u); r.z = __uint_as_float(w.y << 16); r.w = __uint_as_float(w.y & 0xffff0000u); return r; }
__device__ __forceinline__ void st_bf16x4(bf16* p, f32x4 v) { v2u w; w.x = pg8::cvt_pk_bf16(v.x, v.y); w.y = pg8::cvt_pk_bf16(v.z, v.w); *(v2u*)p = w; }
__device__ __forceinline__ float fast_rcp(float x) { return __builtin_amdgcn_rcpf(x); }
__device__ __forceinline__ float fast_exp(float x) { return __builtin_amdgcn_exp2f(x * 1.44269504089f); }
__device__ __forceinline__ float sigmoidf_(float x) { return fast_rcp(1.0f + fast_exp(-x)); }
template <int S> __device__ __forceinline__ float dpp_shr(float v, float ident) {
    return __builtin_bit_cast(float, __builtin_amdgcn_update_dpp(__builtin_bit_cast(int, ident), __builtin_bit_cast(int, v), 0x110 + S, 0xf, 0xf, false));
}
#if MK_MODE == 2
#define XB_TMO      128
#define XB_XCNT(j)  (256  + 64 * (j))
#define XB_XSUB(j)  (1280 + 64 * (j))
#define XB_XGEN(j)  (2304 + 64 * (j))
#define XB_TOP      3328
#define XB_TOPGEN   3392
#define XCD_BAR_WORDS 3456
#define XB_SPIN_CAP (1u << 18)

__device__ __forceinline__ unsigned xb_ld(unsigned* p)              { return __hip_atomic_load(p, __ATOMIC_RELAXED, __HIP_MEMORY_SCOPE_AGENT); }
__device__ __forceinline__ unsigned xb_add(unsigned* p, unsigned v) { return __hip_atomic_fetch_add(p, v, __ATOMIC_RELAXED, __HIP_MEMORY_SCOPE_AGENT); }
__device__ __forceinline__ unsigned xb_xcc_id() { return (unsigned)__builtin_amdgcn_s_getreg((3 << 11) | 20) & 0xFu; }
#define XB_SPIN(cond, bar) do { unsigned _sp = 0; while (cond) { __builtin_amdgcn_s_sleep(1); \
    if ((++_sp & 255u) == 0u) { if (xb_ld(&(bar)[XB_TMO])) break; if (_sp > XB_SPIN_CAP) { atomicAdd(&(bar)[XB_TMO], 1u); break; } } } } while (0)

struct XcdBarrier {
    unsigned* bar; unsigned x;
    volatile LAS unsigned* st;
};

__device__ __forceinline__ XcdBarrier xcd_barrier_post(unsigned* bar, volatile LAS unsigned* st) {
    XcdBarrier b; b.bar = bar; b.x = xb_xcc_id(); b.st = st;
    if (threadIdx.x == 0) (void)xb_add(&bar[XB_XCNT(b.x)], 1u);
    return b;
}
__device__ __forceinline__ void xcd_barrier_complete(unsigned* bar, unsigned x, unsigned& nloc, unsigned& nx) {
    const unsigned G = gridDim.x * gridDim.y * gridDim.z;
    unsigned sum, cnt, mine, sp = 0u;
    for (;;) {
        sum = 0u; cnt = 0u; mine = 0u;
#pragma unroll
        for (unsigned j = 0; j < 16; ++j) { const unsigned c = xb_ld(&bar[XB_XCNT(j)]); sum += c; cnt += (c > 0u) ? 1u : 0u; mine = (j == x) ? c : mine; }
        if (sum == G) break;
        __builtin_amdgcn_s_sleep(1);
        if ((++sp & 255u) == 0u) { if (xb_ld(&bar[XB_TMO])) break; if (sp > XB_SPIN_CAP) { atomicAdd(&bar[XB_TMO], 1u); break; } }
    }
    nloc = mine > 0u ? mine : 1u; nx = cnt > 0u ? cnt : 1u;
}

__device__ __forceinline__ void xcd_barrier(const XcdBarrier& b) {
    asm volatile("s_waitcnt vmcnt(0)" ::: "memory");
    __syncthreads();
    if (threadIdx.x == 0) {
        unsigned* bar = b.bar;
        __builtin_amdgcn_s_waitcnt(0);
        unsigned nloc = b.st[0], nx = b.st[1];
        if (nloc == 0u) { xcd_barrier_complete(bar, b.x, nloc, nx); b.st[0] = nloc; b.st[1] = nx; }
        const unsigned old = xb_add(&bar[XB_XSUB(b.x)], 1u);
        const unsigned gen = old / nloc;
        if (old + 1u == (gen + 1u) * nloc) {
            __builtin_amdgcn_fence(__ATOMIC_RELEASE, "agent");
            asm volatile("s_waitcnt vmcnt(0)" ::: "memory");
            const unsigned og = xb_add(&bar[XB_TOP], 1u);
            const unsigned tg = og / nx;
            if (og + 1u == (tg + 1u) * nx) xb_add(&bar[XB_TOPGEN], 1u);
            else XB_SPIN(xb_ld(&bar[XB_TOPGEN]) == tg, bar);
            __builtin_amdgcn_fence(__ATOMIC_ACQUIRE, "agent");
            xb_add(&bar[XB_XGEN(b.x)], 1u);
            asm volatile("s_waitcnt vmcnt(0)" ::: "memory");
        } else {
            XB_SPIN(xb_ld(&bar[XB_XGEN(b.x)]) == gen, bar);
            __builtin_amdgcn_fence(__ATOMIC_ACQUIRE, "agent");
            asm volatile("s_waitcnt vmcnt(0)" ::: "memory");
        }
    }
    __syncthreads();
}
#endif
struct Args {
    const float* xp; const float* xs; const float* st_ca; const float* st_lc; const float* st_lh; const float* g1; const float* w_in; const float* conv_a_w; const float* lru_conv_w;
    const float* lru_conv_b; const float* lru_wa; const float* lru_ba; const float* lru_wx; const float* lru_bx; const float* lru_a_param; const float* w_out; const float* g2;
    const float* w_up; const float* w_down; const float* gf; float* out; unsigned char* ws; int ph_lo, ph_hi;
};
__device__ __forceinline__ float wave_sum(float v) {
#pragma unroll
    for (int o = 1; o < 64; o <<= 1) v += __shfl_xor(v, o);
    return v;
}
__device__ __forceinline__ void p0_transpose_item(const float* W, const float* g, int K, int N, bf16* WT, LAS float* scr, int item, int lane) {
    const int nblk = N / 32, kb = item / nblk, nb = item % nblk, k0 = 64 * kb, n0 = 32 * nb;
#pragma unroll 8
    for (int i = 0; i < 32; ++i) { const int kk = 2 * i + (lane >> 5); float v = W[(size_t)(k0 + kk) * N + n0 + (lane & 31)]; if (g) v *= g[k0 + kk]; scr[kk * 33 + (lane & 31)] = v; }
    LDS_WAIT(); asm volatile("" ::: "memory");
    const int c = lane & 7;
#pragma unroll
    for (int j = 0; j < 4; ++j) { const int n = (lane >> 3) + 8 * j; const LAS float* s = scr + (8 * c) * 33 + n;
        v4u o; o.x = pk2(s[0 * 33], s[1 * 33]); o.y = pk2(s[2 * 33], s[3 * 33]); o.z = pk2(s[4 * 33], s[5 * 33]); o.w = pk2(s[6 * 33], s[7 * 33]);
        *(GAS v4u*)(WT + (size_t)(n0 + n) * K + k0 + 8 * c) = o; }
    LDS_WAIT(); asm volatile("" ::: "memory");
}
__device__ __forceinline__ void rms_row_bf16(const float* xrow, const float* g, bf16* orow, int lane) {
    const GAS f32x4* xr = (const GAS f32x4*)xrow + lane; const GAS f32x4* gr = (const GAS f32x4*)g + lane;
    f32x4 v[4]; float s = 0.f;
#pragma unroll
    for (int j = 0; j < 4; ++j) { v[j] = xr[64 * j]; s += (v[j].x * v[j].x + v[j].y * v[j].y) + (v[j].z * v[j].z + v[j].w * v[j].w); }
    const float rs = 1.0f / sqrtf(wave_sum(s) * (1.f / D) + EPS);
    GAS v2u* o8 = (GAS v2u*)orow + lane;
#pragma unroll
    for (int j = 0; j < 4; ++j) { const f32x4 gg = gr[64 * j]; v2u w; w.x = pk2(v[j].x * rs * gg.x, v[j].y * rs * gg.y); w.y = pk2(v[j].z * rs * gg.z, v[j].w * rs * gg.w); o8[64 * j] = w; }
}
__device__ __forceinline__ void rms_row_f32_inplace(float* xrow, const float* g, int lane) {
    GAS f32x4* xr = (GAS f32x4*)xrow + lane; const GAS f32x4* gr = (const GAS f32x4*)g + lane;
    f32x4 v[4]; float s = 0.f;
#pragma unroll
    for (int j = 0; j < 4; ++j) { v[j] = xr[64 * j]; s += (v[j].x * v[j].x + v[j].y * v[j].y) + (v[j].z * v[j].z + v[j].w * v[j].w); }
    const float rs = 1.0f / sqrtf(wave_sum(s) * (1.f / D) + EPS);
#pragma unroll
    for (int j = 0; j < 4; ++j) { const f32x4 gg = gr[64 * j]; xr[64 * j] = v[j] * rs * gg; }
}
__device__ __forceinline__ void p0_prologue(const Args& A, LAS unsigned char* lds, int gw, int NGW, int wave, int lane) {
    LAS float* scr = (LAS float*)(lds + RING_OFF + wave * 16384);
    unsigned char* ws = A.ws;
    constexpr int I_IN = (D / 64) * (DIN / 32), I_OUT = (D / 64) * (D / 32), I_UP = (D / 64) * (FF / 32), I_DN = (FF / 64) * (D / 32);
    constexpr int NITEMS = I_IN + I_OUT + I_UP + I_DN;
    for (int it = gw; it < NITEMS; it += NGW) {
        int r = it;
        if (r < I_IN) { p0_transpose_item(A.w_in, nullptr, D, DIN, (bf16*)(ws + WS_WIN), scr, r, lane); continue; } r -= I_IN;
        if (r < I_OUT) { p0_transpose_item(A.w_out, nullptr, D, D, (bf16*)(ws + WS_WOUT), scr, r, lane); continue; } r -= I_OUT;
        if (r < I_UP) { p0_transpose_item(A.w_up, A.g2, D, FF, (bf16*)(ws + WS_WUP), scr, r, lane); continue; } r -= I_UP;
        p0_transpose_item(A.w_down, nullptr, FF, D, (bf16*)(ws + WS_WDN), scr, r, lane);
    }
    for (int idx = gw; idx < 128; idx += NGW) {
        const int hd = idx >> 4, gate = (idx >> 3) & 1, jt = (idx >> 1) & 3, ks = idx & 1, jj = lane & 15, q = lane >> 4;
        const float* W = (gate ? A.lru_wx : A.lru_wa) + hd * 4096 + 16 * jt + jj;
        float v[8];
#pragma unroll
        for (int e = 0; e < 8; ++e) v[e] = W[(32 * ks + 16 * (e >> 2) + 4 * q + (e & 3)) * 64];
        v4u o; o.x = pk2(v[0], v[1]); o.y = pk2(v[2], v[3]); o.z = pk2(v[4], v[5]); o.w = pk2(v[6], v[7]);
        *(GAS v4u*)((bf16*)(ws + WS_GW) + (size_t)idx * 512 + lane * 8) = o;
    }
    if (gw >= NGW - 8) {
        const int hd = NGW - 1 - gw, c = hd * 64 + lane; float* hc = (float*)(ws + WS_HC) + hd * 704 + lane;
#pragma unroll
        for (int k = 0; k < 4; ++k) hc[k * 64] = A.lru_conv_w[k * 512 + c];
        hc[256] = A.lru_conv_b[c]; hc[320] = A.lru_ba[c]; hc[384] = A.lru_bx[c];
        { const float x = A.lru_a_param[c]; hc[448] = x > 20.f ? x : log1pf(expf(x)); }
#pragma unroll
        for (int k = 0; k < 3; ++k) hc[512 + k * 64] = A.conv_a_w[k * 512 + c];
    }
    for (int m = gw; m < M; m += NGW) rms_row_bf16(m < MP ? A.xp + (size_t)m * D : A.xs + (size_t)(m - MP) * D, A.g1, (bf16*)(ws + WS_XN) + (size_t)m * D, lane);
}
typedef __amdgpu_buffer_rsrc_t rsrc_t;
__device__ __forceinline__ f32x4 bld_bf16x4(rsrc_t r, int voff, int soff) { const v2u w = __builtin_amdgcn_raw_buffer_load_b64(r, voff, soff, 0); f32x4 o; o.x = __uint_as_float(w.x << 16); o.y = __uint_as_float(w.x & 0xffff0000u); o.z = __uint_as_float(w.y << 16); o.w = __uint_as_float(w.y & 0xffff0000u); return o; }
__device__ __forceinline__ void bst_bf16x4(rsrc_t r, int voff, int soff, f32x4 v) { v2u w; w.x = pg8::cvt_pk_bf16(v.x, v.y); w.y = pg8::cvt_pk_bf16(v.z, v.w); __builtin_amdgcn_raw_buffer_store_b64(w, r, voff, soff, 0); }
#define MEMFENCE() asm volatile("" ::: "memory")
template <bool FINAL>
__device__ __forceinline__ void mix_item(const Args& A, rsrc_t rP, rsrc_t rM, rsrc_t rC, rsrc_t rS, int ck, int hd, int lane) {
    const int tl = lane & 15, q = lane >> 4;
    const int vg = hd * 16384 + lane * 16, vc = 131072 + hd * 2816 + q * 16, vs = hd * 256 + q * 16;
#define LDC(arr, n) __builtin_bit_cast(f32x4, __builtin_amdgcn_raw_buffer_load_b128(rC, vc, (arr) * 256 + (n) * 64, 0))
#define LDG(gate, jt, ks) __builtin_bit_cast(bf16x8, __builtin_amdgcn_raw_buffer_load_b128(rC, vg, (((gate) * 4 + (jt)) * 2 + (ks)) * 1024, 0))
    const bool is_sample = ck >= NPCHUNK, first = is_sample || ((ck & 63) == 0), lastc = is_sample || ((ck & 63) == 63);
    const int sb = is_sample ? ck - NPCHUNK : ck >> 6;
    const int row0 = ck * 64, cb = hd * 64 + 4 * q;
    const int vb0 = ((row0 + tl) * DIN + cb) * 2, mb0 = ((row0 + tl) * D + cb) * 2;
    f32x4 cl[4][4];
#pragma unroll
    for (int n = 0; n < 4; ++n) {
        const int c = cb + 16 * n;
        const f32x4 w0 = LDC(0, n), w1 = LDC(1, n), w2 = LDC(2, n), w3 = LDC(3, n), bb = LDC(4, n);
#pragma unroll
        for (int m = 0; m < 4; ++m) {
            f32x4 x[4];
#pragma unroll
            for (int k = 0; k < 4; ++k) {
                if (m > 0 || k == 3) x[k] = bld_bf16x4(rP, vb0, ((16 * m - 3 + k) * DIN + 1536 + 16 * n) * 2);
                else { const int tk = tl - 3 + k;
                    if (!first || tk >= 0) x[k] = bld_bf16x4(rP, vb0 - (3 - k) * DIN * 2, (1536 + 16 * n) * 2);
                    else if (is_sample) x[k] = *(const f32x4*)(A.st_lc + (size_t)(sb * 3 + 3 + tk) * 512 + c);
                    else x[k] = (f32x4){0.f, 0.f, 0.f, 0.f}; } }
            cl[m][n] = bb + w0 * x[0] + w1 * x[1] + w2 * x[2] + w3 * x[3];
            if (FINAL && m == 3) { if (lastc && tl >= 13) *(f32x4*)(A.out + (is_sample ? O_LCS : O_LCP) + (size_t)(sb * 3 + tl - 13) * 512 + c) = x[3]; }
        }
        if (n & 1) asm volatile("" : "+v"(cl[0][n - 1]), "+v"(cl[1][n - 1]), "+v"(cl[2][n - 1]), "+v"(cl[3][n - 1]), "+v"(cl[0][n]), "+v"(cl[1][n]), "+v"(cl[2][n]), "+v"(cl[3][n]) :: "memory");
    }
    bf16x8 bfr[4][2];
#pragma unroll
    for (int m = 0; m < 4; ++m)
#pragma unroll
        for (int ks = 0; ks < 2; ++ks) { v4u w; const f32x4 a = cl[m][2 * ks], b = cl[m][2 * ks + 1];
            w.x = pg8::cvt_pk_bf16(a.x, a.y); w.y = pg8::cvt_pk_bf16(a.z, a.w); w.z = pg8::cvt_pk_bf16(b.x, b.y); w.w = pg8::cvt_pk_bf16(b.z, b.w); bfr[m][ks] = __builtin_bit_cast(bf16x8, w); }
    const bool reset0 = !is_sample && ((ck & 63) == 0) && tl == 0;
#pragma unroll
    for (int jt = 0; jt < 4; ++jt) {
        const int c = cb + 16 * jt;
        const bf16x8 ar0 = LDG(0, jt, 0), ar1 = LDG(0, jt, 1), ai0 = LDG(1, jt, 0), ai1 = LDG(1, jt, 1);
        const f32x4 ba4 = LDC(5, jt), bx4 = LDC(6, jt), sp4 = LDC(7, jt);
        f32x4 hc = {0.f, 0.f, 0.f, 0.f}, ac = {1.f, 1.f, 1.f, 1.f};
        if (FINAL) {
            if (is_sample) hc = *(const f32x4*)(A.st_lh + (size_t)sb * 512 + c);
            else for (int i = ck & ~63; i < ck; ++i) { const f32x4 pv = __builtin_bit_cast(f32x4, __builtin_amdgcn_raw_buffer_load_b128(rS, vs, i * 4096 + jt * 64, 0)), sv = __builtin_bit_cast(f32x4, __builtin_amdgcn_raw_buffer_load_b128(rS, vs, i * 4096 + 2048 + jt * 64, 0)); hc = pv * hc + sv; }
        }
#pragma unroll
        for (int m = 0; m < 4; ++m) {
            f32x4 zr = {0.f, 0.f, 0.f, 0.f}, zi = {0.f, 0.f, 0.f, 0.f};
            zr = __builtin_amdgcn_mfma_f32_16x16x32_bf16(ar0, bfr[m][0], zr, 0, 0, 0); zr = __builtin_amdgcn_mfma_f32_16x16x32_bf16(ar1, bfr[m][1], zr, 0, 0, 0);
            zi = __builtin_amdgcn_mfma_f32_16x16x32_bf16(ai0, bfr[m][0], zi, 0, 0, 0); zi = __builtin_amdgcn_mfma_f32_16x16x32_bf16(ai1, bfr[m][1], zi, 0, 0, 0);
            f32x4 hv;
#pragma unroll
            for (int r = 0; r < 4; ++r) {
                const float rr = sigmoidf_(zr[r] + ba4[r]), ii = sigmoidf_(zi[r] + bx4[r]);
                const float la = -8.0f * rr * sp4[r], x2 = 2.0f * la;
                float a = fast_exp(la);
                float t = 1.0f - a * a; if (x2 > -0.02f) t = -x2 * (1.0f + x2 * (0.5f + x2 * (1.0f / 6.0f)));
                float mult = __builtin_amdgcn_sqrtf(t); if (m == 0 && reset0) mult = 1.0f;
                float b = mult * (ii * cl[m][jt][r]);
                { const float ap = dpp_shr<1>(a, 1.0f), bp = dpp_shr<1>(b, 0.0f); b = fmaf(a, bp, b); a = a * ap; }
                { const float ap = dpp_shr<2>(a, 1.0f), bp = dpp_shr<2>(b, 0.0f); b = fmaf(a, bp, b); a = a * ap; }
                { const float ap = dpp_shr<4>(a, 1.0f), bp = dpp_shr<4>(b, 0.0f); b = fmaf(a, bp, b); a = a * ap; }
                { const float ap = dpp_shr<8>(a, 1.0f), bp = dpp_shr<8>(b, 0.0f); b = fmaf(a, bp, b); a = a * ap; }
                const float h = fmaf(a, hc[r], b); hv[r] = h;
                hc[r] = __shfl(h, lane | 15);
                if (!FINAL) ac[r] = ac[r] * __shfl(a, lane | 15);
            }
            if (FINAL) {
                const f32x4 g = bld_bf16x4(rP, vb0, (16 * m * DIN + 2048 + 16 * jt) * 2); f32x4 o;
#pragma unroll
                for (int r = 0; r < 4; ++r) { const float gg = g[r]; o[r] = hv[r] * gg * sigmoidf_(1.5957691216f * (gg + 0.044715f * gg * gg * gg)); }
                bst_bf16x4(rM, mb0, (16 * m * D + 512 + 16 * jt) * 2, o);
            }
        }
        if (FINAL) { if (lastc && tl == 15) *(f32x4*)(A.out + (is_sample ? O_LHS : O_LHP) + (size_t)sb * 512 + c) = hc; }
        else if (tl == 0) { __builtin_amdgcn_raw_buffer_store_b128(__builtin_bit_cast(v4u, ac), rS, vs, ck * 4096 + jt * 64, 0); __builtin_amdgcn_raw_buffer_store_b128(__builtin_bit_cast(v4u, hc), rS, vs, ck * 4096 + 2048 + jt * 64, 0); }
        MEMFENCE();
    }
    if (FINAL) {
#pragma unroll
        for (int n = 0; n < 4; ++n) {
            const int c = cb + 16 * n;
            const f32x4 w0 = LDC(8, n), w1 = LDC(9, n), w2 = LDC(10, n);
#pragma unroll
            for (int m = 0; m < 4; ++m) {
                f32x4 u[3];
#pragma unroll
                for (int k = 0; k < 3; ++k) {
                    if (m > 0 || k == 2) { const int so = ((16 * m - 2 + k) * DIN + 16 * n) * 2; u[k] = bld_bf16x4(rP, vb0, so + 1024) * bld_bf16x4(rP, vb0, so + 2048); }
                    else { const int tk = tl - 2 + k;
                        if (!first || tk >= 0) { const int vo = vb0 - (2 - k) * DIN * 2; u[k] = bld_bf16x4(rP, vo, 16 * n * 2 + 1024) * bld_bf16x4(rP, vo, 16 * n * 2 + 2048); }
                        else if (is_sample) u[k] = *(const f32x4*)(A.st_ca + (size_t)(sb * 2 + 2 + tk) * 512 + c);
                        else u[k] = (f32x4){0.f, 0.f, 0.f, 0.f}; } }
                const f32x4 ca = w0 * u[0] + w1 * u[1] + w2 * u[2], gb = bld_bf16x4(rP, vb0, (16 * m * DIN + 16 * n) * 2);
                bst_bf16x4(rM, mb0, (16 * m * D + 16 * n) * 2, gb * ca);
                if (m == 3) { if (lastc && tl >= 14) *(f32x4*)(A.out + (is_sample ? O_CAS : O_CAP) + (size_t)(sb * 2 + tl - 14) * 512 + c) = u[2]; }
            }
            MEMFENCE();
        }
    }
#undef LDC
#undef LDG
}
constexpr int N_PHASES = 8;
__global__ void __launch_bounds__(NWAVES * 64, 2) fwd_kernel(Args args) {
    extern __shared__ __attribute__((aligned(16))) unsigned char lds_raw[];
    LAS unsigned char* lds = (LAS unsigned char*)lds_raw;
    const int tid = threadIdx.x, lane = tid & 63, wave = __builtin_amdgcn_readfirstlane(tid >> 6);
    const int G = gridDim.x, bx = blockIdx.x, vcu = (G % 8 == 0) ? (bx % 8) * (G / 8) + bx / 8 : bx;
    const int gw = vcu * NWAVES + wave, NGW = G * NWAVES;
    unsigned char* ws = args.ws;
#if MK_MODE == 2
    volatile LAS unsigned* MISC = (volatile LAS unsigned*)(lds + MISC_OFF);
    for (int u = tid; u < (LDS_BYTES - LDSCTL_OFF) / 4; u += NWAVES * 64) ((LAS unsigned*)(lds + LDSCTL_OFF))[u] = 0u;
    __syncthreads();
    XcdBarrier bar = xcd_barrier_post((unsigned*)(ws + WS_CTL) + CW_BAR, MISC + 8);
#define GRID_BAR() xcd_barrier(bar)
#elif MK_MODE == 0
    cg::grid_group grid = cg::this_grid();
#define GRID_BAR() grid.sync()
#else
#define GRID_BAR() do {} while (0)
#endif
    const int lo = args.ph_lo, hi = args.ph_hi;
#ifndef PH_MASK
#define PH_MASK 0xff
#endif
#define IN(k) (((PH_MASK >> (k)) & 1) && lo <= (k) && (k) < hi)
#define SEAM(k) do { if (IN(k) && IN((k) + 1)) GRID_BAR(); } while (0)

    if (IN(0)) { p0_prologue(args, lds, gw, NGW, wave, lane); } SEAM(0);
    if (IN(1)) {
        pg8::Gemm g{(const bf16*)(ws + WS_XN), (const bf16*)(ws + WS_WIN), M, DIN, D}; pg8::StaticOrder S; S.init(M, DIN, G, bx);
        pg8::EpiProj E{(bf16*)(ws + WS_PROJ), DIN};
        pg8::gemm_phase<pg8::EpiProj, pg8::StaticOrder, PG8_ALIGN, PG8_SP2>(lds + RING_OFF, g, S, E);
    } SEAM(1);
    const rsrc_t rP = __builtin_amdgcn_make_buffer_rsrc((void*)(ws + WS_PROJ), 0, (int)((size_t)M * DIN * 2), 0x00020000), rM = __builtin_amdgcn_make_buffer_rsrc((void*)(ws + WS_MIX), 0, (int)((size_t)M * D * 2), 0x00020000),
        rC = __builtin_amdgcn_make_buffer_rsrc((void*)(ws + WS_GW), 0, 131072 + 8 * 2816, 0x00020000), rS = __builtin_amdgcn_make_buffer_rsrc((void*)(ws + WS_SUM), 0, NPCHUNK * 4096, 0x00020000);
    if (IN(2)) { for (int it = gw; it < NPCHUNK * 8; it += NGW) mix_item<false>(args, rP, rM, rC, rS, it >> 3, it & 7, lane); } SEAM(2);
    if (IN(3)) { for (int it = gw; it < NCHUNK * 8; it += NGW) mix_item<true>(args, rP, rM, rC, rS, it >> 3, it & 7, lane); } SEAM(3);
    if (IN(4)) {
        pg8::Gemm g{(const bf16*)(ws + WS_MIX), (const bf16*)(ws + WS_WOUT), M, D, D}; pg8::StaticOrder S; S.init(M, D, G, bx);
        pg8::EpiX1 E{args.xp, args.xs, args.out, (bf16*)(ws + WS_XN), (float*)(ws + WS_SS)};
        pg8::gemm_phase<pg8::EpiX1, pg8::StaticOrder, PG8_ALIGN, PG8_SP2>(lds + RING_OFF, g, S, E);
    } SEAM(4);
    if (IN(5)) {
        pg8::Gemm g{(const bf16*)(ws + WS_XN), (const bf16*)(ws + WS_WUP), M, FF, D}; pg8::StaticOrder S; S.init(M, FF, G, bx);
        pg8::EpiUp E{(bf16*)(ws + WS_H), (const float*)(ws + WS_SS), EPS};
        pg8::gemm_phase<pg8::EpiUp, pg8::StaticOrder, PG8_ALIGN, PG8_SP2>(lds + RING_OFF, g, S, E);
    } SEAM(5);
    if (IN(6)) {
        pg8::Gemm g{(const bf16*)(ws + WS_H), (const bf16*)(ws + WS_WDN), M, D, FF}; pg8::StaticOrder S; S.init(M, D, G, bx);
        pg8::EpiDown E{args.out};
        pg8::gemm_phase<pg8::EpiDown, pg8::StaticOrder, PG8_ALIGN, PG8_SP2>(lds + RING_OFF, g, S, E);
    } SEAM(6);
    if (IN(7)) { for (int m = gw; m < M; m += NGW) rms_row_f32_inplace(args.out + (size_t)m * D, args.gf, lane); }
#undef IN
#undef SEAM
}

extern "C" void kernel_launch(void* const* d_in, const int* in_sizes, int n_in, void* d_out, int out_size, void* d_ws, size_t ws_size, hipStream_t stream) {
    static int grid = 0;
    if (grid == 0) {
        if (n_in != 20 || out_size != (int)O_END || ws_size < WS_END) { fprintf(stderr, "kernel_launch: unexpected shapes (n_in %d out %d ws %zu)\n", n_in, out_size, ws_size); grid = -1; return; }
        int dev = 0, cus = 0, per_cu = 0;
        if (hipGetDevice(&dev) != hipSuccess || hipDeviceGetAttribute(&cus, hipDeviceAttributeMultiprocessorCount, dev) != hipSuccess) { grid = -1; return; }
        if (hipFuncSetAttribute((const void*)fwd_kernel, hipFuncAttributeMaxDynamicSharedMemorySize, LDS_BYTES) != hipSuccess) { fprintf(stderr, "kernel_launch: hipFuncSetAttribute failed\n"); grid = -1; return; }
        if (hipOccupancyMaxActiveBlocksPerMultiprocessor(&per_cu, (const void*)fwd_kernel, NWAVES * 64, LDS_BYTES) != hipSuccess || per_cu < 1) { fprintf(stderr, "kernel_launch: occupancy query says %d blocks per CU\n", per_cu); per_cu = 1; }
        (void)hipGetLastError();
        grid = cus;
    }
    if (grid < 0) return;
    Args a{};
    a.xp = (const float*)d_in[0]; a.xs = (const float*)d_in[1]; a.st_ca = (const float*)d_in[2]; a.st_lc = (const float*)d_in[3]; a.st_lh = (const float*)d_in[4]; a.g1 = (const float*)d_in[5];
    a.w_in = (const float*)d_in[6]; a.conv_a_w = (const float*)d_in[7]; a.lru_conv_w = (const float*)d_in[8]; a.lru_conv_b = (const float*)d_in[9]; a.lru_wa = (const float*)d_in[10];
    a.lru_ba = (const float*)d_in[11]; a.lru_wx = (const float*)d_in[12]; a.lru_bx = (const float*)d_in[13]; a.lru_a_param = (const float*)d_in[14]; a.w_out = (const float*)d_in[15];
    a.g2 = (const float*)d_in[16]; a.w_up = (const float*)d_in[17]; a.w_down = (const float*)d_in[18]; a.gf = (const float*)d_in[19]; a.out = (float*)d_out; a.ws = (unsigned char*)d_ws;
#if MK_MODE == 1
    for (int p = 0; p < N_PHASES; ++p) { a.ph_lo = p; a.ph_hi = p + 1; hipLaunchKernelGGL(fwd_kernel, dim3(grid), dim3(NWAVES * 64), LDS_BYTES, stream, a); }
#elif MK_MODE == 0
    a.ph_lo = 0; a.ph_hi = N_PHASES;
    void* kargs[] = {&a};
    hipError_t e = hipLaunchCooperativeKernel((const void*)fwd_kernel, dim3(grid), dim3(NWAVES * 64), kargs, LDS_BYTES, stream);
    if (e != hipSuccess) fprintf(stderr, "kernel_launch: cooperative launch failed: %s (grid %d)\n", hipGetErrorString(e), grid);
#else
    if (hipMemsetAsync((char*)d_ws + WS_CTL, 0, CTL_ZERO_BYTES, stream) != hipSuccess) { fprintf(stderr, "kernel_launch: memset failed\n"); return; }
    a.ph_lo = 0; a.ph_hi = N_PHASES;
    hipLaunchKernelGGL(fwd_kernel, dim3(grid), dim3(NWAVES * 64), LDS_BYTES, stream, a);
#endif
    const hipError_t le = hipPeekAtLastError();
    if (le != hipSuccess) fprintf(stderr, "kernel_launch: launch failed: %s\n", hipGetErrorName(le));
}
```

```cpp
#include <hip/hip_runtime.h>
#include <hip/hip_cooperative_groups.h>
#include <cstdio>
#include <cstdint>
namespace cg = cooperative_groups;
#ifndef MK_MODE
#define MK_MODE 2
#endif
namespace pg8 {
#define PG8_LAS __attribute__((address_space(3)))
typedef unsigned short bf16_t;
typedef short bf16x8 __attribute__((ext_vector_type(8)));
typedef float f32x4 __attribute__((ext_vector_type(4)));
typedef unsigned u32x4 __attribute__((ext_vector_type(4)));
constexpr int BM = 256, BK = 64, HALF = 128, HTB = HALF * BK * 2  , STAGE_BYTES = 8 * HTB, NXCD = 8, WGM = 8;

__host__ __device__ __forceinline__ int lds_byte(int r, int c) { const int st = (r >> 4) * 2 + (c >> 5), rr = r & 15, cc = c & 31, ob = rr * 64 + cc * 2; return st * 1024 + (ob ^ (((ob >> 9) & 1) << 5)); }
__host__ __device__ __forceinline__ void stage_rc(int b, int& R, int& C) { const int st = b / 1024, sb = b % 1024, swz = sb ^ (((sb >> 9) & 1) << 5); R = (st >> 1) * 16 + swz / 64; C = (st & 1) * 32 + (swz % 64) / 2; }
__host__ __device__ __forceinline__ int perm32(int rho) { const int n = rho >> 4, i = rho & 15; return 8 * (i >> 2) + 4 * n + (i & 3); }

struct Unit { int pm, pn; };
struct Gemm { const bf16_t* A; const bf16_t* Bt; int M, N, K; };

struct StaticOrder {
    int nM, nN, nwg, G, c;
    __host__ __device__ void init(int M, int N, int G_, int c_) { nM = M / BM; nN = N / BM; nwg = nM * nN; G = G_; c = c_; }
    __host__ __device__ bool next(int i, Unit& u) const {
        const long L = (long)i * G + c; if (L >= nwg) return false;
        int wgid = (int)L; { const int q = nwg / NXCD, r = nwg % NXCD, xcd = wgid % NXCD, off = wgid / NXCD; wgid = (xcd < r ? xcd * (q + 1) : r * (q + 1) + (xcd - r) * q) + off; }
        const int nig = WGM * nN, gid = wgid / nig, fm = gid * WGM, gsz = (nM - fm) < WGM ? (nM - fm) : WGM;
        u.pm = fm + ((wgid % nig) % gsz); u.pn = (wgid % nig) / gsz; return true;
    }
    __device__ __forceinline__ void a_ready(const Unit&) const {}
    __device__ __forceinline__ void done(const Unit&) const {}
};

__device__ __forceinline__ unsigned cvt_pk_bf16(float lo, float hi) { unsigned r; asm volatile("v_cvt_pk_bf16_f32 %0, %1, %2" : "=v"(r) : "v"(lo), "v"(hi)); return r; }
typedef float f32x2 __attribute__((ext_vector_type(2)));
__device__ __forceinline__ f32x2 gelu_pk(f32x2 v) {
    const f32x2 av = __builtin_elementwise_abs(v), d = av * 0.2316418882f + 1.0f;
    f32x2 t; t.x = __builtin_amdgcn_rcpf(d.x); t.y = __builtin_amdgcn_rcpf(d.y);
    f32x2 q = t * 0.5307027145f + (-0.7265760135f); q = q * t + 0.7107068705f; q = q * t + (-0.142248368f); q = q * t + 0.127414796f; q = q * t;
    const f32x2 s = (v * v) * (-0.72134752044f);
    f32x2 e; e.x = __builtin_amdgcn_exp2f(s.x); e.y = __builtin_amdgcn_exp2f(s.y);
    const f32x2 m = v * (q * e), r = v - m;
    f32x2 o; o.x = v.x < 0.f ? m.x : r.x; o.y = v.y < 0.f ? m.y : r.y; return o;
}

typedef unsigned u32x2 __attribute__((ext_vector_type(2)));
struct EpiProj {
    static constexpr bool PERM = true, AFTER_DRAIN = false;
    bf16_t* O; int ldc;
    __device__ __forceinline__ void operator()(const f32x4 (&acc)[2][2][4][2], const Unit& u, int wr, int wc, int fr, int fq) const {
        const int row0 = u.pm * BM + wr * 64 + fr, col0 = u.pn * BM + wc * 32 + 8 * fq;
#pragma unroll
        for (int ai = 0; ai < 2; ++ai)
#pragma unroll
            for (int m = 0; m < 4; ++m) { bf16_t* rowp = O + (size_t)(row0 + ai * HALF + m * 16) * ldc + col0;
#pragma unroll
                for (int bj = 0; bj < 2; ++bj) { const f32x4 v0 = acc[ai][bj][m][0], v1 = acc[ai][bj][m][1];
                    u32x4 w; w.x = cvt_pk_bf16(v0[0], v0[1]); w.y = cvt_pk_bf16(v0[2], v0[3]); w.z = cvt_pk_bf16(v1[0], v1[1]); w.w = cvt_pk_bf16(v1[2], v1[3]);
                    *(u32x4*)(rowp + bj * HALF) = w; } }
    }
};
struct EpiX1 {
    static constexpr bool PERM = false, AFTER_DRAIN = false;
    const float* xp; const float* xs; float* out; bf16_t* x1b; float* ss;
    __device__ __forceinline__ void operator()(const f32x4 (&acc)[2][2][4][2], const Unit& u, int wr, int wc, int fr, int fq) const {
        const int row0 = u.pm * BM + wr * 64 + fr, col0 = u.pn * BM + wc * 32 + 4 * fq;
        const float* xin = (u.pm < 64) ? xp : xs - (size_t)16384 * 1024;
#pragma unroll
        for (int ai = 0; ai < 2; ++ai)
#pragma unroll
            for (int m = 0; m < 4; ++m) { const size_t off = (size_t)(row0 + ai * HALF + m * 16) * 1024 + col0; float s = 0.f;
#pragma unroll
                for (int bj = 0; bj < 2; ++bj)
#pragma unroll
                    for (int n = 0; n < 2; ++n) { const size_t o = off + bj * HALF + n * 16; const f32x4 v = *(const f32x4*)(xin + o) + acc[ai][bj][m][n];
                        *(f32x4*)(out + o) = v; u32x2 w; w.x = cvt_pk_bf16(v[0], v[1]); w.y = cvt_pk_bf16(v[2], v[3]); *(u32x2*)(x1b + o) = w;
                        s += (v[0] * v[0] + v[1] * v[1]) + (v[2] * v[2] + v[3] * v[3]); }
                s += __shfl_xor(s, 16); s += __shfl_xor(s, 32);
                if (fq == 0) ss[(size_t)(row0 + ai * HALF + m * 16) * 16 + u.pn * 4 + wc] = s; }
    }
};
struct EpiUp {
    static constexpr bool PERM = true, AFTER_DRAIN = false;
    bf16_t* H; const float* ss; float eps;
    __device__ __forceinline__ void operator()(const f32x4 (&acc)[2][2][4][2], const Unit& u, int wr, int wc, int fr, int fq) const {
        const int row0 = u.pm * BM + wr * 64 + fr, col0 = u.pn * BM + wc * 32 + 8 * fq;
#pragma unroll
        for (int ai = 0; ai < 2; ++ai)
#pragma unroll
            for (int m = 0; m < 4; ++m) { const int r = row0 + ai * HALF + m * 16; const f32x4* sp = (const f32x4*)(ss + (size_t)r * 16);
                const f32x4 t = (sp[0] + sp[1]) + (sp[2] + sp[3]); const float rs2 = 1.0f / (((t[0] + t[1]) + (t[2] + t[3])) * (1.0f / 1024.0f) + eps);
                bf16_t* rowp = H + (size_t)r * 4096 + col0;
#pragma unroll
                for (int bj = 0; bj < 2; ++bj) { f32x4 v0 = acc[ai][bj][m][0], v1 = acc[ai][bj][m][1];
#pragma unroll
                    for (int j = 0; j < 4; ++j) { const float a = fmaxf(v0[j], 0.f), b = fmaxf(v1[j], 0.f); v0[j] = a * a * rs2; v1[j] = b * b * rs2; }
                    u32x4 w; w.x = cvt_pk_bf16(v0[0], v0[1]); w.y = cvt_pk_bf16(v0[2], v0[3]); w.z = cvt_pk_bf16(v1[0], v1[1]); w.w = cvt_pk_bf16(v1[2], v1[3]);
                    *(u32x4*)(rowp + bj * HALF) = w; } }
    }
};
struct EpiDown {
    static constexpr bool PERM = false, AFTER_DRAIN = false;
    float* out;
    __device__ __forceinline__ void operator()(const f32x4 (&acc)[2][2][4][2], const Unit& u, int wr, int wc, int fr, int fq) const {
        const int row0 = u.pm * BM + wr * 64 + fr, col0 = u.pn * BM + wc * 32 + 4 * fq;
#pragma unroll
        for (int ai = 0; ai < 2; ++ai)
#pragma unroll
            for (int m = 0; m < 4; ++m) { float* rowp = out + (size_t)(row0 + ai * HALF + m * 16) * 1024 + col0;
#pragma unroll
                for (int bj = 0; bj < 2; ++bj)
#pragma unroll
                    for (int n = 0; n < 2; ++n) { f32x4* p = (f32x4*)(rowp + bj * HALF + n * 16); *p = *p + acc[ai][bj][m][n]; } }
    }
};

template <class Epi, class Sched, bool ALIGN_EPI = false, bool SP2 = false>
__device__ __forceinline__ void gemm_phase(PG8_LAS unsigned char* lds, const Gemm g, const Sched& S, const Epi& E) {
    const int tid = threadIdx.x, wid = __builtin_amdgcn_readfirstlane(tid >> 6), lane = tid & 63, wr = wid >> 2, wc = wid & 3, fr = lane & 15, fq = lane >> 4;
    const int K = g.K, nt = K / BK;
    unsigned voffA[2], voffB[2];
#pragma unroll
    for (int i = 0; i < 2; ++i) { int R, C; stage_rc(tid * 16 + i * 8192, R, C); const int Rb = Epi::PERM ? ((R & ~31) + perm32(R & 31)) : R;
        voffA[i] = (unsigned)(R * K + C) * 2u; voffB[i] = (unsigned)(Rb * K + C) * 2u; }
    const size_t kstep = (size_t)(BK * 2);
    const size_t hstep = (size_t)HALF * K * 2;
    const size_t tstep = 2 * hstep;
    const unsigned ldsw = (unsigned)wid * 1024u;
    const int aoff = lds_byte(wr * 64 + fr, fq * 8), boff = lds_byte(wc * 32 + fr, fq * 8);
#define PG8_SA(b, h) (((b) * 2 + (h)) * HTB)
#define PG8_SB(b, h) ((4 + (b) * 2 + (h)) * HTB)
#define PG8_STAGE(bufoff, gbase, voff) do { _Pragma("unroll") for (int _i = 0; _i < 2; ++_i) \
        __builtin_amdgcn_global_load_lds((const unsigned*)((const char*)(gbase) + (voff)[_i]), (PG8_LAS unsigned*)(lds + (bufoff) + ldsw + _i * 8192), 16, 0, 0); } while (0)
#define PG8_LDA(dst, b, h) do { _Pragma("unroll") for (int m = 0; m < 4; ++m) _Pragma("unroll") for (int k = 0; k < 2; ++k) dst[m][k] = *(const PG8_LAS bf16x8*)(lds + PG8_SA(b, h) + aoff + m * 2048 + k * 1024); } while (0)
#define PG8_LDB(dst, b, h) do { _Pragma("unroll") for (int n = 0; n < 2; ++n) _Pragma("unroll") for (int k = 0; k < 2; ++k) dst[n][k] = *(const PG8_LAS bf16x8*)(lds + PG8_SB(b, h) + boff + n * 2048 + k * 1024); } while (0)
#define PG8_MMA(ai, bj, At, Bt) do { __builtin_amdgcn_s_setprio(1); _Pragma("unroll") for (int m = 0; m < 4; ++m) _Pragma("unroll") for (int n = 0; n < 2; ++n) _Pragma("unroll") for (int k = 0; k < 2; ++k) \
        acc[ai][bj][m][n] = __builtin_amdgcn_mfma_f32_16x16x32_bf16(Bt[n][k], At[m][k], acc[ai][bj][m][n], 0, 0, 0); __builtin_amdgcn_s_setprio(0); } while (0)
#define PG8_WAIT_V(n) asm volatile("s_waitcnt vmcnt(" #n ")" ::: "memory")
#define PG8_WAIT_L(n) asm volatile("s_waitcnt lgkmcnt(" #n ")" ::: "memory")
#define PG8_BAR __builtin_amdgcn_s_barrier()
#define PG8_SCHED __builtin_amdgcn_sched_barrier(0)
    Unit cur, nxt; int ui = 0;
    if (!S.next(0, cur)) return;
    f32x4 acc[2][2][4][2];
#pragma unroll
    for (int a = 0; a < 2; ++a)
#pragma unroll
        for (int b = 0; b < 2; ++b)
#pragma unroll
            for (int m = 0; m < 4; ++m)
#pragma unroll
                for (int n = 0; n < 2; ++n) acc[a][b][m][n] = (f32x4){0.f, 0.f, 0.f, 0.f};
    bf16x8 At[4][2], B0[2][2], B1[2][2];
    const char* cA = (const char*)g.A + (size_t)cur.pm * tstep; const char* cB = (const char*)g.Bt + (size_t)cur.pn * tstep;
    S.a_ready(cur);
    if constexpr (SP2) {
        PG8_STAGE(PG8_SB(0, 0), cB, voffB); PG8_STAGE(PG8_SB(0, 1), cB + hstep, voffB); PG8_STAGE(PG8_SA(0, 0), cA, voffA); PG8_STAGE(PG8_SA(0, 1), cA + hstep, voffA);
        if (wr == 1) PG8_BAR;
        PG8_WAIT_V(2); PG8_BAR;
        PG8_STAGE(PG8_SB(1, 0), cB + kstep, voffB); PG8_STAGE(PG8_SA(1, 0), cA + kstep, voffA); PG8_STAGE(PG8_SB(1, 1), cB + hstep + kstep, voffB);
        PG8_WAIT_V(6); PG8_BAR;
    } else {
        PG8_STAGE(PG8_SB(0, 0), cB, voffB); PG8_STAGE(PG8_SA(0, 0), cA, voffA); PG8_STAGE(PG8_SB(0, 1), cB + hstep, voffB); PG8_STAGE(PG8_SA(0, 1), cA + hstep, voffA);
        if (wr == 1) PG8_BAR;
        PG8_WAIT_V(4); PG8_BAR;
        PG8_STAGE(PG8_SB(1, 0), cB + kstep, voffB); PG8_STAGE(PG8_SA(1, 0), cA + kstep, voffA); PG8_STAGE(PG8_SB(1, 1), cB + hstep + kstep, voffB);
        PG8_WAIT_V(6); PG8_BAR;
    }
    for (;;) {
        const bool has_next = S.next(ui + 1, nxt);
        const char* nA = has_next ? (const char*)g.A + (size_t)nxt.pm * tstep : cA; const char* nB = has_next ? (const char*)g.Bt + (size_t)nxt.pn * tstep : cB;
        for (int t = 0; t < nt; t += 2) {
            const bool last = (t == nt - 2);
            const char* a1 = cA + (size_t)(t + 1) * kstep;
            const char* a2 = last ? nA : cA + (size_t)(t + 2) * kstep; const char* b2 = last ? nB : cB + (size_t)(t + 2) * kstep;
            const char* a3 = a2 + kstep; const char* b3 = b2 + kstep;
            if (last && has_next) S.a_ready(nxt);
            if constexpr (SP2) {
            PG8_LDB(B0, 0, 0); PG8_LDB(B1, 0, 1); PG8_SCHED; PG8_LDA(At, 0, 0); PG8_STAGE(PG8_SA(1, 1), a1 + hstep, voffA);
            PG8_WAIT_V(8); PG8_WAIT_L(0); PG8_BAR; PG8_MMA(0, 0, At, B0); PG8_MMA(0, 1, At, B1); PG8_BAR; PG8_SCHED;
            PG8_LDA(At, 0, 1); PG8_STAGE(PG8_SB(0, 0), b2, voffB); PG8_STAGE(PG8_SB(0, 1), b2 + hstep, voffB); PG8_STAGE(PG8_SA(0, 0), a2, voffA);
            PG8_WAIT_V(8); PG8_WAIT_L(0); PG8_BAR; PG8_MMA(1, 0, At, B0); PG8_MMA(1, 1, At, B1); PG8_BAR; PG8_SCHED;
            PG8_LDB(B0, 1, 0); PG8_LDB(B1, 1, 1); PG8_SCHED; PG8_LDA(At, 1, 0); PG8_STAGE(PG8_SA(0, 1), a2 + hstep, voffA);
            PG8_WAIT_V(8); PG8_WAIT_L(0); PG8_BAR; PG8_MMA(0, 0, At, B0); PG8_MMA(0, 1, At, B1); PG8_BAR; PG8_SCHED;
            PG8_LDA(At, 1, 1); PG8_STAGE(PG8_SB(1, 0), b3, voffB); PG8_STAGE(PG8_SB(1, 1), b3 + hstep, voffB); PG8_STAGE(PG8_SA(1, 0), a3, voffA);
            PG8_WAIT_V(8); PG8_WAIT_L(0); PG8_BAR; PG8_MMA(1, 0, At, B0); PG8_MMA(1, 1, At, B1); PG8_BAR; PG8_SCHED;
            } else {
            PG8_LDB(B0, 0, 0); PG8_SCHED; PG8_LDA(At, 0, 0); PG8_STAGE(PG8_SA(1, 1), a1 + hstep, voffA);
            PG8_WAIT_L(8); PG8_BAR; PG8_WAIT_L(0); PG8_MMA(0, 0, At, B0); PG8_BAR; PG8_SCHED;
            PG8_LDB(B1, 0, 1); PG8_STAGE(PG8_SB(0, 0), b2, voffB);
            PG8_BAR; PG8_WAIT_L(0); PG8_MMA(0, 1, At, B1); PG8_BAR;
            PG8_LDA(At, 0, 1); PG8_STAGE(PG8_SA(0, 0), a2, voffA);
            PG8_BAR; PG8_WAIT_L(0); PG8_MMA(1, 0, At, B0); PG8_BAR; PG8_SCHED;
            PG8_STAGE(PG8_SB(0, 1), b2 + hstep, voffB);
            PG8_WAIT_V(6); PG8_BAR; PG8_MMA(1, 1, At, B1); PG8_BAR;
            PG8_LDB(B0, 1, 0); PG8_SCHED; PG8_LDA(At, 1, 0); PG8_STAGE(PG8_SA(0, 1), a2 + hstep, voffA);
            PG8_WAIT_L(8); PG8_BAR; PG8_WAIT_L(0); PG8_MMA(0, 0, At, B0); PG8_BAR; PG8_SCHED;
            PG8_LDB(B1, 1, 1); PG8_STAGE(PG8_SB(1, 0), b3, voffB);
            PG8_BAR; PG8_WAIT_L(0); PG8_MMA(0, 1, At, B1); PG8_BAR;
            PG8_LDA(At, 1, 1); PG8_STAGE(PG8_SA(1, 0), a3, voffA);
            PG8_BAR; PG8_WAIT_L(0); PG8_MMA(1, 0, At, B0); PG8_BAR; PG8_SCHED;
            PG8_STAGE(PG8_SB(1, 1), b3 + hstep, voffB);
            PG8_WAIT_V(6); PG8_BAR; PG8_MMA(1, 1, At, B1); PG8_BAR;
            }
        }
        if constexpr (ALIGN_EPI) { if (wr == 0) PG8_BAR; }
        if constexpr (!Epi::AFTER_DRAIN) { E(acc, cur, wr, wc, fr, fq); S.done(cur); }
        if (!has_next) break;
#pragma unroll
        for (int a = 0; a < 2; ++a)
#pragma unroll
            for (int b = 0; b < 2; ++b)
#pragma unroll
                for (int m = 0; m < 4; ++m)
#pragma unroll
                    for (int n = 0; n < 2; ++n) acc[a][b][m][n] = (f32x4){0.f, 0.f, 0.f, 0.f};
        cur = nxt; cA = nA; cB = nB; ++ui;
        if constexpr (ALIGN_EPI) { if (wr == 1) PG8_BAR; }
    }
    PG8_WAIT_V(0);
    if constexpr (!ALIGN_EPI) { if (wr == 0) PG8_BAR; }
    PG8_BAR;
    if constexpr (Epi::AFTER_DRAIN) { E.fused(acc, cur, wr, wc, fr, fq, lds, wid, lane); S.done(cur); }
#undef PG8_SA
#undef PG8_SB
#undef PG8_STAGE
#undef PG8_LDA
#undef PG8_LDB
#undef PG8_MMA
#undef PG8_WAIT_V
#undef PG8_WAIT_L
#undef PG8_BAR
#undef PG8_SCHED
}
}
#ifndef PG8_SP2
#define PG8_SP2 true
#endif
#ifndef PG8_ALIGN
#define PG8_ALIGN true
#endif
constexpr int NWAVES = 8;
constexpr int D = 1024, DIN = 2560, FF = 4096, DC = 512, DL = 512;
constexpr int MP = 4 * 4096, MS = 32 * 64, M = MP + MS;
constexpr int NCHUNK = M / 64, NPCHUNK = MP / 64;
constexpr float EPS = 1e-6f;
constexpr size_t O_YP = 0, O_YS = (size_t)MP * D, O_CAP = (size_t)M * D, O_LCP = O_CAP + 4 * 2 * 512, O_LHP = O_LCP + 4 * 3 * 512, O_CAS = O_LHP + 4 * 512, O_LCS = O_CAS + 32 * 2 * 512, O_LHS = O_LCS + 32 * 3 * 512, O_END = O_LHS + 32 * 512;
constexpr size_t MiB = 1u << 20;
constexpr size_t WS_CTL = 0, CTL_ZERO_BYTES = 1 * MiB;
constexpr size_t WS_WIN = 2 * MiB, WS_WOUT = 8 * MiB, WS_WUP = 10 * MiB, WS_WDN = 18 * MiB;
constexpr size_t WS_GW = 26 * MiB;
constexpr size_t WS_HC = WS_GW + 131072;
constexpr size_t WS_SS = 27 * MiB;
constexpr size_t WS_SUM = 29 * MiB;
constexpr size_t WS_XN = 32 * MiB;
constexpr size_t WS_H = 68 * MiB;
constexpr size_t WS_PROJ = 68 * MiB;
constexpr size_t WS_MIX = 160 * MiB;
constexpr size_t WS_END = 212 * MiB;
static_assert(WS_XN + (size_t)M * D * 2 <= WS_H && WS_PROJ + (size_t)M * DIN * 2 <= WS_MIX && WS_MIX + (size_t)M * D * 2 <= WS_END && WS_H + (size_t)M * FF * 2 <= WS_END, "d_ws map");
static_assert(WS_SS + (size_t)M * 16 * 4 <= WS_SUM && WS_SUM + (size_t)NPCHUNK * 2 * 512 * 4 <= WS_XN, "d_ws map (small)");
constexpr int CW_BAR = 4096;
constexpr int RING_OFF = 0, RING_BYTES = 131072;
constexpr int LDSCTL_OFF = RING_BYTES, MISC_OFF = LDSCTL_OFF + 320;
constexpr int LDS_BYTES = 147456;
#define GAS __attribute__((address_space(1)))
#define LAS __attribute__((address_space(3)))
typedef unsigned short bf16;
typedef unsigned v4u __attribute__((ext_vector_type(4)));
typedef unsigned v2u __attribute__((ext_vector_type(2)));
typedef float f32x4 __attribute__((ext_vector_type(4)));
typedef short bf16x8 __attribute__((ext_vector_type(8)));
typedef GAS unsigned gu32;
#define RLX_AGENT __ATOMIC_RELAXED, __HIP_MEMORY_SCOPE_AGENT
#define LDS_WAIT() asm volatile("s_waitcnt lgkmcnt(0)" ::: "memory")
#define VM_WAIT() asm volatile("s_waitcnt vmcnt(0)" ::: "memory")
__device__ __forceinline__ unsigned f2bf(float f) { unsigned u = __builtin_bit_cast(unsigned, f); return (u + 0x7fffu + ((u >> 16) & 1u)) >> 16; }
__device__ __forceinline__ unsigned pk2(float lo, float hi) { return f2bf(lo) | (f2bf(hi) << 16); }
__device__ __forceinline__ f32x4 ld_bf16x4(const bf16* p) { const v2u w = *(const v2u*)p; f32x4 r; r.x = __uint_as_float(w.x << 16); r.y = __uint_as_float(w.x & 0xffff0000u); r.z = __uint_as_float(w.y << 16); r.w = __uint_as_float(w.y & 0xffff0000u); return r; }
__device__ __forceinline__ void st_bf16x4(bf16* p, f32x4 v) { v2u w; w.x = pg8::cvt_pk_bf16(v.x, v.y); w.y = pg8::cvt_pk_bf16(v.z, v.w); *(v2u*)p = w; }
__device__ __forceinline__ float fast_rcp(float x) { return __builtin_amdgcn_rcpf(x); }
__device__ __forceinline__ float fast_exp(float x) { return __builtin_amdgcn_exp2f(x * 1.44269504089f); }
__device__ __forceinline__ float sigmoidf_(float x) { return fast_rcp(1.0f + fast_exp(-x)); }
template <int S> __device__ __forceinline__ float dpp_shr(float v, float ident) {
    return __builtin_bit_cast(float, __builtin_amdgcn_update_dpp(__builtin_bit_cast(int, ident), __builtin_bit_cast(int, v), 0x110 + S, 0xf, 0xf, false));
}
#if MK_MODE == 2
#define XB_TMO      128
#define XB_XCNT(j)  (256  + 64 * (j))
#define XB_XSUB(j)  (1280 + 64 * (j))
#define XB_XGEN(j)  (2304 + 64 * (j))
#define XB_TOP      3328
#define XB_TOPGEN   3392
#define XCD_BAR_WORDS 3456
#define XB_SPIN_CAP (1u << 18)

__device__ __forceinline__ unsigned xb_ld(unsigned* p)              { return __hip_atomic_load(p, __ATOMIC_RELAXED, __HIP_MEMORY_SCOPE_AGENT); }
__device__ __forceinline__ unsigned xb_add(unsigned* p, unsigned v) { return __hip_atomic_fetch_add(p, v, __ATOMIC_RELAXED, __HIP_MEMORY_SCOPE_AGENT); }
__device__ __forceinline__ unsigned xb_xcc_id() { return (unsigned)__builtin_amdgcn_s_getreg((3 << 11) | 20) & 0xFu; }
#define XB_SPIN(cond, bar) do { unsigned _sp = 0; while (cond) { __builtin_amdgcn_s_sleep(1); \
    if ((++_sp & 255u) == 0u) { if (xb_ld(&(bar)[XB_TMO])) break; if (_sp > XB_SPIN_CAP) { atomicAdd(&(bar)[XB_TMO], 1u); break; } } } } while (0)

struct XcdBarrier {
    unsigned* bar; unsigned x;
    volatile LAS unsigned* st;
};

__device__ __forceinline__ XcdBarrier xcd_barrier_post(unsigned* bar, volatile LAS unsigned* st) {
    XcdBarrier b; b.bar = bar; b.x = xb_xcc_id(); b.st = st;
    if (threadIdx.x == 0) (void)xb_add(&bar[XB_XCNT(b.x)], 1u);
    return b;
}
__device__ __forceinline__ void xcd_barrier_complete(unsigned* bar, unsigned x, unsigned& nloc, unsigned& nx) {
    const unsigned G = gridDim.x * gridDim.y * gridDim.z;
    unsigned sum, cnt, mine, sp = 0u;
    for (;;) {
        sum = 0u; cnt = 0u; mine = 0u;
#pragma unroll
        for (unsigned j = 0; j < 16; ++j) { const unsigned c = xb_ld(&bar[XB_XCNT(j)]); sum += c; cnt += (c > 0u) ? 1u : 0u; mine = (j == x) ? c : mine; }
        if (sum == G) break;
        __builtin_amdgcn_s_sleep(1);
        if ((++sp & 255u) == 0u) { if (xb_ld(&bar[XB_TMO])) break; if (sp > XB_SPIN_CAP) { atomicAdd(&bar[XB_TMO], 1u); break; } }
    }
    nloc = mine > 0u ? mine : 1u; nx = cnt > 0u ? cnt : 1u;
}

__device__ __forceinline__ void xcd_barrier(const XcdBarrier& b) {
    asm volatile("s_waitcnt vmcnt(0)" ::: "memory");
    __syncthreads();
    if (threadIdx.x == 0) {
        unsigned* bar = b.bar;
        __builtin_amdgcn_s_waitcnt(0);
        unsigned nloc = b.st[0], nx = b.st[1];
        if (nloc == 0u) { xcd_barrier_complete(bar, b.x, nloc, nx); b.st[0] = nloc; b.st[1] = nx; }
        const unsigned old = xb_add(&bar[XB_XSUB(b.x)], 1u);
        const unsigned gen = old / nloc;
        if (old + 1u == (gen + 1u) * nloc) {
            __builtin_amdgcn_fence(__ATOMIC_RELEASE, "agent");
            asm volatile("s_waitcnt vmcnt(0)" ::: "memory");
            const unsigned og = xb_add(&bar[XB_TOP], 1u);
            const unsigned tg = og / nx;
            if (og + 1u == (tg + 1u) * nx) xb_add(&bar[XB_TOPGEN], 1u);
            else XB_SPIN(xb_ld(&bar[XB_TOPGEN]) == tg, bar);
            __builtin_amdgcn_fence(__ATOMIC_ACQUIRE, "agent");
            xb_add(&bar[XB_XGEN(b.x)], 1u);
            asm volatile("s_waitcnt vmcnt(0)" ::: "memory");
        } else {
            XB_SPIN(xb_ld(&bar[XB_XGEN(b.x)]) == gen, bar);
            __builtin_amdgcn_fence(__ATOMIC_ACQUIRE, "agent");
            asm volatile("s_waitcnt vmcnt(0)" ::: "memory");
        }
    }
    __syncthreads();
}
#endif
struct Args {
    const float* xp; const float* xs; const float* st_ca; const float* st_lc; const float* st_lh; const float* g1; const float* w_in; const float* conv_a_w; const float* lru_conv_w;
    const float* lru_conv_b; const float* lru_wa; const float* lru_ba; const float* lru_wx; const float* lru_bx; const float* lru_a_param; const float* w_out; const float* g2;
    const float* w_up; const float* w_down; const float* gf; float* out; unsigned char* ws; int ph_lo, ph_hi;
};
__device__ __forceinline__ float wave_sum(float v) {
#pragma unroll
    for (int o = 1; o < 64; o <<= 1) v += __shfl_xor(v, o);
    return v;
}
__device__ __forceinline__ void p0_transpose_item(const float* W, const float* g, int K, int N, bf16* WT, LAS float* scr, int item, int lane) {
    const int nblk = N / 32, kb = item / nblk, nb = item % nblk, k0 = 64 * kb, n0 = 32 * nb;
#pragma unroll 8
    for (int i = 0; i < 32; ++i) { const int kk = 2 * i + (lane >> 5); float v = W[(size_t)(k0 + kk) * N + n0 + (lane & 31)]; if (g) v *= g[k0 + kk]; scr[kk * 33 + (lane & 31)] = v; }
    LDS_WAIT(); asm volatile("" ::: "memory");
    const int c = lane & 7;
#pragma unroll
    for (int j = 0; j < 4; ++j) { const int n = (lane >> 3) + 8 * j; const LAS float* s = scr + (8 * c) * 33 + n;
        v4u o; o.x = pk2(s[0 * 33], s[1 * 33]); o.y = pk2(s[2 * 33], s[3 * 33]); o.z = pk2(s[4 * 33], s[5 * 33]); o.w = pk2(s[6 * 33], s[7 * 33]);
        *(GAS v4u*)(WT + (size_t)(n0 + n) * K + k0 + 8 * c) = o; }
    LDS_WAIT(); asm volatile("" ::: "memory");
}
__device__ __forceinline__ void rms_row_bf16(const float* xrow, const float* g, bf16* orow, int lane) {
    const GAS f32x4* xr = (const GAS f32x4*)xrow + lane; const GAS f32x4* gr = (const GAS f32x4*)g + lane;
    f32x4 v[4]; float s = 0.f;
#pragma unroll
    for (int j = 0; j < 4; ++j) { v[j] = xr[64 * j]; s += (v[j].x * v[j].x + v[j].y * v[j].y) + (v[j].z * v[j].z + v[j].w * v[j].w); }
    const float rs = 1.0f / sqrtf(wave_sum(s) * (1.f / D) + EPS);
    GAS v2u* o8 = (GAS v2u*)orow + lane;
#pragma unroll
    for (int j = 0; j < 4; ++j) { const f32x4 gg = gr[64 * j]; v2u w; w.x = pk2(v[j].x * rs * gg.x, v[j].y * rs * gg.y); w.y = pk2(v[j].z * rs * gg.z, v[j].w * rs * gg.w); o8[64 * j] = w; }
}
__device__ __forceinline__ void rms_row_f32_inplace(float* xrow, const float* g, int lane) {
    GAS f32x4* xr = (GAS f32x4*)xrow + lane; const GAS f32x4* gr = (const GAS f32x4*)g + lane;
    f32x4 v[4]; float s = 0.f;
#pragma unroll
    for (int j = 0; j < 4; ++j) { v[j] = xr[64 * j]; s += (v[j].x * v[j].x + v[j].y * v[j].y) + (v[j].z * v[j].z + v[j].w * v[j].w); }
    const float rs = 1.0f / sqrtf(wave_sum(s) * (1.f / D) + EPS);
#pragma unroll
    for (int j = 0; j < 4; ++j) { const f32x4 gg = gr[64 * j]; xr[64 * j] = v[j] * rs * gg; }
}
__device__ __forceinline__ void p0_prologue(const Args& A, LAS unsigned char* lds, int gw, int NGW, int wave, int lane) {
    LAS float* scr = (LAS float*)(lds + RING_OFF + wave * 16384);
    unsigned char* ws = A.ws;
    constexpr int I_IN = (D / 64) * (DIN / 32), I_OUT = (D / 64) * (D / 32), I_UP = (D / 64) * (FF / 32), I_DN = (FF / 64) * (D / 32);
    constexpr int NITEMS = I_IN + I_OUT + I_UP + I_DN;
    for (int it = gw; it < NITEMS; it += NGW) {
        int r = it;
        if (r < I_IN) { p0_transpose_item(A.w_in, nullptr, D, DIN, (bf16*)(ws + WS_WIN), scr, r, lane); continue; } r -= I_IN;
        if (r < I_OUT) { p0_transpose_item(A.w_out, nullptr, D, D, (bf16*)(ws + WS_WOUT), scr, r, lane); continue; } r -= I_OUT;
        if (r < I_UP) { p0_transpose_item(A.w_up, A.g2, D, FF, (bf16*)(ws + WS_WUP), scr, r, lane); continue; } r -= I_UP;
        p0_transpose_item(A.w_down, nullptr, FF, D, (bf16*)(ws + WS_WDN), scr, r, lane);
    }
    for (int idx = gw; idx < 128; idx += NGW) {
        const int hd = idx >> 4, gate = (idx >> 3) & 1, jt = (idx >> 1) & 3, ks = idx & 1, jj = lane & 15, qa = lane >> 4;
        const float* W = (gate ? A.lru_wx : A.lru_wa) + hd * 4096 + 32 * (jt >> 1) + 8 * (jj >> 2) + 4 * (jt & 1) + (jj & 3);
        float v[8];
#pragma unroll
        for (int e = 0; e < 8; ++e) v[e] = W[(32 * ks + 8 * qa + e) * 64];
        v4u o; o.x = pk2(v[0], v[1]); o.y = pk2(v[2], v[3]); o.z = pk2(v[4], v[5]); o.w = pk2(v[6], v[7]);
        *(GAS v4u*)((bf16*)(ws + WS_GW) + (size_t)idx * 512 + lane * 8) = o;
    }
    if (gw >= NGW - 8) {
        const int hd = NGW - 1 - gw, c = hd * 64 + lane; float* hc = (float*)(ws + WS_HC) + hd * 704 + lane;
#pragma unroll
        for (int k = 0; k < 4; ++k) hc[k * 64] = A.lru_conv_w[k * 512 + c];
        hc[256] = A.lru_conv_b[c]; hc[320] = A.lru_ba[c]; hc[384] = A.lru_bx[c];
        { const float x = A.lru_a_param[c]; hc[448] = x > 20.f ? x : log1pf(expf(x)); }
#pragma unroll
        for (int k = 0; k < 3; ++k) hc[512 + k * 64] = A.conv_a_w[k * 512 + c];
    }
    for (int m = gw; m < M; m += NGW) rms_row_bf16(m < MP ? A.xp + (size_t)m * D : A.xs + (size_t)(m - MP) * D, A.g1, (bf16*)(ws + WS_XN) + (size_t)m * D, lane);
}
typedef __amdgpu_buffer_rsrc_t rsrc_t;
struct f32x8 { f32x4 lo, hi; };
__device__ __forceinline__ f32x8 bld_bf16x8(rsrc_t r, int voff, int soff) { const v4u w = __builtin_amdgcn_raw_buffer_load_b128(r, voff, soff, 0); f32x8 o;
    o.lo.x = __uint_as_float(w.x << 16); o.lo.y = __uint_as_float(w.x & 0xffff0000u); o.lo.z = __uint_as_float(w.y << 16); o.lo.w = __uint_as_float(w.y & 0xffff0000u);
    o.hi.x = __uint_as_float(w.z << 16); o.hi.y = __uint_as_float(w.z & 0xffff0000u); o.hi.z = __uint_as_float(w.w << 16); o.hi.w = __uint_as_float(w.w & 0xffff0000u); return o; }
__device__ __forceinline__ v4u pack_bf16x8(f32x4 lo, f32x4 hi) { v4u w; w.x = pg8::cvt_pk_bf16(lo.x, lo.y); w.y = pg8::cvt_pk_bf16(lo.z, lo.w); w.z = pg8::cvt_pk_bf16(hi.x, hi.y); w.w = pg8::cvt_pk_bf16(hi.z, hi.w); return w; }
__device__ __forceinline__ f32x4 bld_f32x4(rsrc_t r, int voff, int soff) { return __builtin_bit_cast(f32x4, __builtin_amdgcn_raw_buffer_load_b128(r, voff, soff, 0)); }
#define MEMFENCE() asm volatile("" ::: "memory")
#define KS_STEP(S, a, b) { const float ap_ = dpp_shr<S>(a, 1.0f), bp_ = dpp_shr<S>(b, 0.0f); b = fmaf(a, bp_, b); a = a * ap_; }
__device__ __forceinline__ void mix_item(const Args& A, rsrc_t rP, rsrc_t rM, rsrc_t rC, rsrc_t rS, int ck, int hd, int lane, bool fin) {
    const int tl = lane & 15, q = lane >> 4;
    const int vg = hd * 16384 + lane * 16, vc = 131072 + hd * 2816 + q * 32;
#define LDC(arr, off) bld_f32x4(rC, vc, (arr) * 256 + (off))
#define LDG(gate, jt, ks) __builtin_bit_cast(bf16x8, __builtin_amdgcn_raw_buffer_load_b128(rC, vg, (((gate) * 4 + (jt)) * 2 + (ks)) * 1024, 0))
    const bool is_sample = ck >= NPCHUNK, first = is_sample || ((ck & 63) == 0), lastc = is_sample || ((ck & 63) == 63);
    const int sb = is_sample ? ck - NPCHUNK : ck >> 6;
    const int row0 = ck * 64, cb = hd * 64 + 8 * q;
    const int vb0 = ((row0 + tl) * DIN + cb) * 2, mb0 = ((row0 + tl) * D + cb) * 2;
    const int vs = cb * 4 + ((ck & ~63) + 4 * tl) * 4096;
    f32x8 cl[4][2];
#pragma unroll
    for (int ks = 0; ks < 2; ++ks) {
        const int c = cb + 32 * ks;
        f32x4 wl[4], wh[4];
#pragma unroll
        for (int k = 0; k < 4; ++k) { wl[k] = LDC(k, ks * 128); wh[k] = LDC(k, ks * 128 + 16); }
        const f32x4 bl = LDC(4, ks * 128), bh = LDC(4, ks * 128 + 16);
#pragma unroll
        for (int m = 0; m < 4; ++m) {
            f32x8 x[4];
#pragma unroll
            for (int k = 0; k < 4; ++k) {
                if (m > 0 || k == 3) x[k] = bld_bf16x8(rP, vb0, ((16 * m - 3 + k) * DIN + 1536 + 32 * ks) * 2);
                else { const int tk = tl - 3 + k;
                    if (!first || tk >= 0) x[k] = bld_bf16x8(rP, vb0 - (3 - k) * DIN * 2, (1536 + 32 * ks) * 2);
                    else if (is_sample) { const float* p = A.st_lc + (size_t)(sb * 3 + 3 + tk) * 512 + c; x[k].lo = *(const f32x4*)p; x[k].hi = *(const f32x4*)(p + 4); }
                    else { x[k].lo = (f32x4){0.f, 0.f, 0.f, 0.f}; x[k].hi = x[k].lo; } } }
            cl[m][ks].lo = bl + wl[0] * x[0].lo + wl[1] * x[1].lo + wl[2] * x[2].lo + wl[3] * x[3].lo;
            cl[m][ks].hi = bh + wh[0] * x[0].hi + wh[1] * x[1].hi + wh[2] * x[2].hi + wh[3] * x[3].hi;
            if (m == 3) { if (fin && lastc && tl >= 13) { float* p = A.out + (is_sample ? O_LCS : O_LCP) + (size_t)(sb * 3 + tl - 13) * 512 + c; *(f32x4*)p = x[3].lo; *(f32x4*)(p + 4) = x[3].hi; } }
        }
        asm volatile("" : "+v"(cl[0][ks].lo), "+v"(cl[0][ks].hi), "+v"(cl[1][ks].lo), "+v"(cl[1][ks].hi), "+v"(cl[2][ks].lo), "+v"(cl[2][ks].hi), "+v"(cl[3][ks].lo), "+v"(cl[3][ks].hi) :: "memory");
    }
    bf16x8 bfr[4][2];
#pragma unroll
    for (int m = 0; m < 4; ++m)
#pragma unroll
        for (int ks = 0; ks < 2; ++ks) bfr[m][ks] = __builtin_bit_cast(bf16x8, pack_bf16x8(cl[m][ks].lo, cl[m][ks].hi));
    const bool reset0 = !is_sample && ((ck & 63) == 0) && tl == 0;
#pragma unroll
    for (int ks = 0; ks < 2; ++ks) {
        f32x4 hv[4][2];
#pragma unroll
        for (int jj = 0; jj < 2; ++jj) {
            const int jt = 2 * ks + jj, c = cb + 32 * ks + 4 * jj;
            const bf16x8 ar0 = LDG(0, jt, 0), ar1 = LDG(0, jt, 1), ai0 = LDG(1, jt, 0), ai1 = LDG(1, jt, 1);
            const f32x4 ba4 = LDC(5, ks * 128 + jj * 16), bx4 = LDC(6, ks * 128 + jj * 16), sp4 = LDC(7, ks * 128 + jj * 16);
            f32x4 hc = {0.f, 0.f, 0.f, 0.f}, ac = {1.f, 1.f, 1.f, 1.f};
            if (fin) {
                if (is_sample) hc = *(const f32x4*)(A.st_lh + (size_t)sb * 512 + c);
                else {
                    f32x4 pa = {1.f, 1.f, 1.f, 1.f}, sa = {0.f, 0.f, 0.f, 0.f};
#pragma unroll
                    for (int u = 0; u < 4; ++u) { f32x4 pv = bld_f32x4(rS, vs, u * 4096 + (32 * ks + 4 * jj) * 4), sv = bld_f32x4(rS, vs, u * 4096 + 2048 + (32 * ks + 4 * jj) * 4);
                        if ((ck & ~63) + 4 * tl + u >= ck) { pv = (f32x4){1.f, 1.f, 1.f, 1.f}; sv = (f32x4){0.f, 0.f, 0.f, 0.f}; }
                        sa = pv * sa + sv; pa = pv * pa; }
#pragma unroll
                    for (int r = 0; r < 4; ++r) { float a = pa[r], b = sa[r]; KS_STEP(1, a, b) KS_STEP(2, a, b) KS_STEP(4, a, b) KS_STEP(8, a, b) hc[r] = __shfl(b, lane | 15); }
                }
            }
#pragma unroll
            for (int m = 0; m < 4; ++m) {
                f32x4 zr = {0.f, 0.f, 0.f, 0.f}, zi = {0.f, 0.f, 0.f, 0.f};
                zr = __builtin_amdgcn_mfma_f32_16x16x32_bf16(ar0, bfr[m][0], zr, 0, 0, 0); zr = __builtin_amdgcn_mfma_f32_16x16x32_bf16(ar1, bfr[m][1], zr, 0, 0, 0);
                zi = __builtin_amdgcn_mfma_f32_16x16x32_bf16(ai0, bfr[m][0], zi, 0, 0, 0); zi = __builtin_amdgcn_mfma_f32_16x16x32_bf16(ai1, bfr[m][1], zi, 0, 0, 0);
                const f32x4 clv = jj ? cl[m][ks].hi : cl[m][ks].lo;
#pragma unroll
                for (int r = 0; r < 4; ++r) {
                    const float rr = sigmoidf_(zr[r] + ba4[r]), ii = sigmoidf_(zi[r] + bx4[r]);
                    const float la = -8.0f * rr * sp4[r], x2 = 2.0f * la;
                    float a = fast_exp(la);
                    float t = 1.0f - a * a; if (x2 > -0.02f) t = -x2 * (1.0f + x2 * (0.5f + x2 * (1.0f / 6.0f)));
                    float mult = __builtin_amdgcn_sqrtf(t); if (m == 0 && reset0) mult = 1.0f;
                    float b = mult * (ii * clv[r]);
                    KS_STEP(1, a, b) KS_STEP(2, a, b) KS_STEP(4, a, b) KS_STEP(8, a, b)
                    const float h = fmaf(a, hc[r], b); hv[m][jj][r] = h;
                    hc[r] = __shfl(h, lane | 15);
                    if (!fin) ac[r] = ac[r] * __shfl(a, lane | 15);
                }
            }
            if (fin) { if (lastc && tl == 15) *(f32x4*)(A.out + (is_sample ? O_LHS : O_LHP) + (size_t)sb * 512 + c) = hc; }
            else if (tl == 0) { __builtin_amdgcn_raw_buffer_store_b128(__builtin_bit_cast(v4u, ac), rS, cb * 4, ck * 4096 + (32 * ks + 4 * jj) * 4, 0); __builtin_amdgcn_raw_buffer_store_b128(__builtin_bit_cast(v4u, hc), rS, cb * 4, ck * 4096 + 2048 + (32 * ks + 4 * jj) * 4, 0); }
        }
        if (fin) {
#pragma unroll
            for (int m = 0; m < 4; ++m) {
                const f32x8 g = bld_bf16x8(rP, vb0, (16 * m * DIN + 2048 + 32 * ks) * 2); f32x4 ol, oh;
#pragma unroll
                for (int r = 0; r < 4; ++r) { const float g0 = g.lo[r], g1 = g.hi[r];
                    ol[r] = hv[m][0][r] * g0 * sigmoidf_(1.5957691216f * (g0 + 0.044715f * g0 * g0 * g0)); oh[r] = hv[m][1][r] * g1 * sigmoidf_(1.5957691216f * (g1 + 0.044715f * g1 * g1 * g1)); }
                __builtin_amdgcn_raw_buffer_store_b128(pack_bf16x8(ol, oh), rM, mb0, (16 * m * D + 512 + 32 * ks) * 2, 0);
            }
        }
        MEMFENCE();
    }
    if (fin) {
#pragma unroll
        for (int ks = 0; ks < 2; ++ks) {
            const int c = cb + 32 * ks;
            f32x4 wl[3], wh[3];
#pragma unroll
            for (int k = 0; k < 3; ++k) { wl[k] = LDC(8 + k, ks * 128); wh[k] = LDC(8 + k, ks * 128 + 16); }
            v4u ow[4];
#pragma unroll
            for (int m = 0; m < 4; ++m) {
                f32x8 u[3];
#pragma unroll
                for (int k = 0; k < 3; ++k) {
                    if (m > 0 || k == 2) { const int so = ((16 * m - 2 + k) * DIN + 32 * ks) * 2; const f32x8 gc = bld_bf16x8(rP, vb0, so + 1024), xa = bld_bf16x8(rP, vb0, so + 2048); u[k].lo = gc.lo * xa.lo; u[k].hi = gc.hi * xa.hi; }
                    else { const int tk = tl - 2 + k;
                        if (!first || tk >= 0) { const int vo = vb0 - (2 - k) * DIN * 2; const f32x8 gc = bld_bf16x8(rP, vo, 32 * ks * 2 + 1024), xa = bld_bf16x8(rP, vo, 32 * ks * 2 + 2048); u[k].lo = gc.lo * xa.lo; u[k].hi = gc.hi * xa.hi; }
                        else if (is_sample) { const float* p = A.st_ca + (size_t)(sb * 2 + 2 + tk) * 512 + c; u[k].lo = *(const f32x4*)p; u[k].hi = *(const f32x4*)(p + 4); }
                        else { u[k].lo = (f32x4){0.f, 0.f, 0.f, 0.f}; u[k].hi = u[k].lo; } } }
                const f32x8 gb = bld_bf16x8(rP, vb0, (16 * m * DIN + 32 * ks) * 2);
                ow[m] = pack_bf16x8(gb.lo * (wl[0] * u[0].lo + wl[1] * u[1].lo + wl[2] * u[2].lo), gb.hi * (wh[0] * u[0].hi + wh[1] * u[1].hi + wh[2] * u[2].hi));
                if (m == 3) { if (lastc && tl >= 14) { float* p = A.out + (is_sample ? O_CAS : O_CAP) + (size_t)(sb * 2 + tl - 14) * 512 + c; *(f32x4*)p = u[2].lo; *(f32x4*)(p + 4) = u[2].hi; } }
            }
#pragma unroll
            for (int m = 0; m < 4; ++m) __builtin_amdgcn_raw_buffer_store_b128(ow[m], rM, mb0, (16 * m * D + 32 * ks) * 2, 0);
            MEMFENCE();
        }
    }
#undef LDC
#undef LDG
}
constexpr int N_PHASES = 8;
__global__ void __launch_bounds__(NWAVES * 64, 2) fwd_kernel(Args args) {
    extern __shared__ __attribute__((aligned(16))) unsigned char lds_raw[];
    LAS unsigned char* lds = (LAS unsigned char*)lds_raw;
    const int tid = threadIdx.x, lane = tid & 63, wave = __builtin_amdgcn_readfirstlane(tid >> 6);
    const int G = gridDim.x, bx = blockIdx.x, vcu = (G % 8 == 0) ? (bx % 8) * (G / 8) + bx / 8 : bx;
    const int gw = vcu * NWAVES + wave, NGW = G * NWAVES;
    unsigned char* ws = args.ws;
#if MK_MODE == 2
    volatile LAS unsigned* MISC = (volatile LAS unsigned*)(lds + MISC_OFF);
    for (int u = tid; u < (LDS_BYTES - LDSCTL_OFF) / 4; u += NWAVES * 64) ((LAS unsigned*)(lds + LDSCTL_OFF))[u] = 0u;
    __syncthreads();
    XcdBarrier bar = xcd_barrier_post((unsigned*)(ws + WS_CTL) + CW_BAR, MISC + 8);
#define GRID_BAR() xcd_barrier(bar)
#elif MK_MODE == 0
    cg::grid_group grid = cg::this_grid();
#define GRID_BAR() grid.sync()
#else
#define GRID_BAR() do {} while (0)
#endif
    const int lo = args.ph_lo, hi = args.ph_hi;
#ifndef PH_MASK
#define PH_MASK 0xff
#endif
#define IN(k) (((PH_MASK >> (k)) & 1) && lo <= (k) && (k) < hi)
#define SEAM(k) do { if (IN(k) && IN((k) + 1)) GRID_BAR(); } while (0)

#ifndef PH_REP
#define PH_REP 0
#endif
#define REPS(k) (1 + ((PH_REP >> (k)) & 1))
    if (IN(0)) for (int rep = 0; rep < REPS(0); ++rep) { if (rep) GRID_BAR(); p0_prologue(args, lds, gw, NGW, wave, lane); }
    SEAM(0);
    if (IN(1)) for (int rep = 0; rep < REPS(1); ++rep) {
        if (rep) GRID_BAR();
        pg8::Gemm g{(const bf16*)(ws + WS_XN), (const bf16*)(ws + WS_WIN), M, DIN, D}; pg8::StaticOrder S; S.init(M, DIN, G, bx);
        pg8::EpiProj E{(bf16*)(ws + WS_PROJ), DIN};
        pg8::gemm_phase<pg8::EpiProj, pg8::StaticOrder, PG8_ALIGN, PG8_SP2>(lds + RING_OFF, g, S, E);
    }
    SEAM(1);
    const rsrc_t rP = __builtin_amdgcn_make_buffer_rsrc((void*)(ws + WS_PROJ), 0, (int)((size_t)M * DIN * 2), 0x00020000), rM = __builtin_amdgcn_make_buffer_rsrc((void*)(ws + WS_MIX), 0, (int)((size_t)M * D * 2), 0x00020000),
        rC = __builtin_amdgcn_make_buffer_rsrc((void*)(ws + WS_GW), 0, 131072 + 8 * 2816, 0x00020000), rS = __builtin_amdgcn_make_buffer_rsrc((void*)(ws + WS_SUM), 0, NPCHUNK * 4096, 0x00020000);
    for (int pass = 0; pass < 2; ++pass) {
        if (IN(2 + pass)) for (int rep = 0; rep < REPS(2 + pass); ++rep) { if (rep) GRID_BAR();
            const int nit = pass ? NCHUNK * 8 : NPCHUNK * 8;
            for (int it = gw; it < nit; it += NGW) mix_item(args, rP, rM, rC, rS, it >> 3, it & 7, lane, pass != 0); }
        SEAM(2 + pass);
    }
    if (IN(4)) for (int rep = 0; rep < REPS(4); ++rep) {
        if (rep) GRID_BAR();
        pg8::Gemm g{(const bf16*)(ws + WS_MIX), (const bf16*)(ws + WS_WOUT), M, D, D}; pg8::StaticOrder S; S.init(M, D, G, bx);
        pg8::EpiX1 E{args.xp, args.xs, args.out, (bf16*)(ws + WS_XN), (float*)(ws + WS_SS)};
        pg8::gemm_phase<pg8::EpiX1, pg8::StaticOrder, PG8_ALIGN, PG8_SP2>(lds + RING_OFF, g, S, E);
    }
    SEAM(4);
    if (IN(5)) for (int rep = 0; rep < REPS(5); ++rep) {
        if (rep) GRID_BAR();
        pg8::Gemm g{(const bf16*)(ws + WS_XN), (const bf16*)(ws + WS_WUP), M, FF, D}; pg8::StaticOrder S; S.init(M, FF, G, bx);
        pg8::EpiUp E{(bf16*)(ws + WS_H), (const float*)(ws + WS_SS), EPS};
        pg8::gemm_phase<pg8::EpiUp, pg8::StaticOrder, PG8_ALIGN, PG8_SP2>(lds + RING_OFF, g, S, E);
    }
    SEAM(5);
    if (IN(6)) {
        pg8::Gemm g{(const bf16*)(ws + WS_H), (const bf16*)(ws + WS_WDN), M, D, FF}; pg8::StaticOrder S; S.init(M, D, G, bx);
        pg8::EpiDown E{args.out};
        pg8::gemm_phase<pg8::EpiDown, pg8::StaticOrder, PG8_ALIGN, PG8_SP2>(lds + RING_OFF, g, S, E);
    }
    SEAM(6);
    if (IN(7)) { for (int m = gw; m < M; m += NGW) rms_row_f32_inplace(args.out + (size_t)m * D, args.gf, lane); }
#undef IN
#undef SEAM
}

extern "C" void kernel_launch(void* const* d_in, const int* in_sizes, int n_in, void* d_out, int out_size, void* d_ws, size_t ws_size, hipStream_t stream) {
    static int grid = 0;
    if (grid == 0) {
        if (n_in != 20 || out_size != (int)O_END || ws_size < WS_END) { fprintf(stderr, "kernel_launch: unexpected shapes (n_in %d out %d ws %zu)\n", n_in, out_size, ws_size); grid = -1; return; }
        int dev = 0, cus = 0, per_cu = 0;
        if (hipGetDevice(&dev) != hipSuccess || hipDeviceGetAttribute(&cus, hipDeviceAttributeMultiprocessorCount, dev) != hipSuccess) { grid = -1; return; }
        if (hipFuncSetAttribute((const void*)fwd_kernel, hipFuncAttributeMaxDynamicSharedMemorySize, LDS_BYTES) != hipSuccess) { fprintf(stderr, "kernel_launch: hipFuncSetAttribute failed\n"); grid = -1; return; }
        if (hipOccupancyMaxActiveBlocksPerMultiprocessor(&per_cu, (const void*)fwd_kernel, NWAVES * 64, LDS_BYTES) != hipSuccess || per_cu < 1) { fprintf(stderr, "kernel_launch: occupancy query says %d blocks per CU\n", per_cu); per_cu = 1; }
        (void)hipGetLastError();
        grid = cus;
    }
    if (grid < 0) return;
    Args a{};
    a.xp = (const float*)d_in[0]; a.xs = (const float*)d_in[1]; a.st_ca = (const float*)d_in[2]; a.st_lc = (const float*)d_in[3]; a.st_lh = (const float*)d_in[4]; a.g1 = (const float*)d_in[5];
    a.w_in = (const float*)d_in[6]; a.conv_a_w = (const float*)d_in[7]; a.lru_conv_w = (const float*)d_in[8]; a.lru_conv_b = (const float*)d_in[9]; a.lru_wa = (const float*)d_in[10];
    a.lru_ba = (const float*)d_in[11]; a.lru_wx = (const float*)d_in[12]; a.lru_bx = (const float*)d_in[13]; a.lru_a_param = (const float*)d_in[14]; a.w_out = (const float*)d_in[15];
    a.g2 = (const float*)d_in[16]; a.w_up = (const float*)d_in[17]; a.w_down = (const float*)d_in[18]; a.gf = (const float*)d_in[19]; a.out = (float*)d_out; a.ws = (unsigned char*)d_ws;
#if MK_MODE == 1
    for (int p = 0; p < N_PHASES; ++p) { a.ph_lo = p; a.ph_hi = p + 1; hipLaunchKernelGGL(fwd_kernel, dim3(grid), dim3(NWAVES * 64), LDS_BYTES, stream, a); }
#elif MK_MODE == 0
    a.ph_lo = 0; a.ph_hi = N_PHASES;
    void* kargs[] = {&a};
    hipError_t e = hipLaunchCooperativeKernel((const void*)fwd_kernel, dim3(grid), dim3(NWAVES * 64), kargs, LDS_BYTES, stream);
    if (e != hipSuccess) fprintf(stderr, "kernel_launch: cooperative launch failed: %s (grid %d)\n", hipGetErrorString(e), grid);
#else
    if (hipMemsetAsync((char*)d_ws + WS_CTL, 0, CTL_ZERO_BYTES, stream) != hipSuccess) { fprintf(stderr, "kernel_launch: memset failed\n"); return; }
    a.ph_lo = 0; a.ph_hi = N_PHASES;
    hipLaunchKernelGGL(fwd_kernel, dim3(grid), dim3(NWAVES * 64), LDS_BYTES, stream, a);
#endif
    const hipError_t le = hipPeekAtLastError();
    if (le != hipSuccess) fprintf(stderr, "kernel_launch: launch failed: %s\n", hipGetErrorName(le));
}
```

```cpp
#include <hip/hip_runtime.h>
#include <hip/hip_cooperative_groups.h>
#include <cstdio>
#include <cstdint>
namespace cg = cooperative_groups;
#ifndef MK_MODE
#define MK_MODE 2
#endif
namespace pg8 {
#define PG8_LAS __attribute__((address_space(3)))
typedef unsigned short bf16_t;
typedef short bf16x8 __attribute__((ext_vector_type(8)));
typedef float f32x4 __attribute__((ext_vector_type(4)));
typedef unsigned u32x4 __attribute__((ext_vector_type(4)));
constexpr int BM = 256, BK = 64, HALF = 128, HTB = HALF * BK * 2  , STAGE_BYTES = 8 * HTB, NXCD = 8, WGM = 8;

__host__ __device__ __forceinline__ int lds_byte(int r, int c) { const int st = (r >> 4) * 2 + (c >> 5), rr = r & 15, cc = c & 31, ob = rr * 64 + cc * 2; return st * 1024 + (ob ^ (((ob >> 9) & 1) << 5)); }
__host__ __device__ __forceinline__ void stage_rc(int b, int& R, int& C) { const int st = b / 1024, sb = b % 1024, swz = sb ^ (((sb >> 9) & 1) << 5); R = (st >> 1) * 16 + swz / 64; C = (st & 1) * 32 + (swz % 64) / 2; }
__host__ __device__ __forceinline__ int perm32(int rho) { const int n = rho >> 4, i = rho & 15; return 8 * (i >> 2) + 4 * n + (i & 3); }

struct Unit { int pm, pn, ks; };
struct Gemm { const bf16_t* A; const bf16_t* Bt; int M, N, K, ld, nsl; };

struct StaticOrder {
    int nM, nN, nwg, G, c, nNr;
    __host__ __device__ void init(int M, int N, int G_, int c_, int nsl = 1) { nM = M / BM; nNr = N / BM; nN = nNr * nsl; nwg = nM * nN; G = G_; c = c_; }
    __host__ __device__ bool next(int i, Unit& u) const {
        const long L = (long)i * G + c; if (L >= nwg) return false;
        int wgid = (int)L; { const int q = nwg / NXCD, r = nwg % NXCD, xcd = wgid % NXCD, off = wgid / NXCD; wgid = (xcd < r ? xcd * (q + 1) : r * (q + 1) + (xcd - r) * q) + off; }
        const int nig = WGM * nN, gid = wgid / nig, fm = gid * WGM, gsz = (nM - fm) < WGM ? (nM - fm) : WGM;
        u.pm = fm + ((wgid % nig) % gsz); const int pq = (wgid % nig) / gsz; u.ks = pq / nNr; u.pn = pq % nNr; return true;
    }
    __device__ __forceinline__ void a_ready(const Unit&) const {}
    __device__ __forceinline__ void done(const Unit&) const {}
};

__device__ __forceinline__ unsigned cvt_pk_bf16(float lo, float hi) { unsigned r; asm volatile("v_cvt_pk_bf16_f32 %0, %1, %2" : "=v"(r) : "v"(lo), "v"(hi)); return r; }
typedef float f32x2 __attribute__((ext_vector_type(2)));
__device__ __forceinline__ f32x2 gelu_pk(f32x2 v) {
    const f32x2 av = __builtin_elementwise_abs(v), d = av * 0.2316418882f + 1.0f;
    f32x2 t; t.x = __builtin_amdgcn_rcpf(d.x); t.y = __builtin_amdgcn_rcpf(d.y);
    f32x2 q = t * 0.5307027145f + (-0.7265760135f); q = q * t + 0.7107068705f; q = q * t + (-0.142248368f); q = q * t + 0.127414796f; q = q * t;
    const f32x2 s = (v * v) * (-0.72134752044f);
    f32x2 e; e.x = __builtin_amdgcn_exp2f(s.x); e.y = __builtin_amdgcn_exp2f(s.y);
    const f32x2 m = v * (q * e), r = v - m;
    f32x2 o; o.x = v.x < 0.f ? m.x : r.x; o.y = v.y < 0.f ? m.y : r.y; return o;
}

typedef unsigned u32x2 __attribute__((ext_vector_type(2)));
struct EpiProj {
    static constexpr bool PERM = true, AFTER_DRAIN = false;
    bf16_t* O; int ldc;
    __device__ __forceinline__ void operator()(const f32x4 (&acc)[2][2][4][2], const Unit& u, int wr, int wc, int fr, int fq) const {
        const int row0 = u.pm * BM + wr * 64 + fr, col0 = u.pn * BM + wc * 32 + 8 * fq;
#pragma unroll
        for (int ai = 0; ai < 2; ++ai)
#pragma unroll
            for (int m = 0; m < 4; ++m) { bf16_t* rowp = O + (size_t)(row0 + ai * HALF + m * 16) * ldc + col0;
#pragma unroll
                for (int bj = 0; bj < 2; ++bj) { const f32x4 v0 = acc[ai][bj][m][0], v1 = acc[ai][bj][m][1];
                    u32x4 w; w.x = cvt_pk_bf16(v0[0], v0[1]); w.y = cvt_pk_bf16(v0[2], v0[3]); w.z = cvt_pk_bf16(v1[0], v1[1]); w.w = cvt_pk_bf16(v1[2], v1[3]);
                    *(u32x4*)(rowp + bj * HALF) = w; } }
    }
};
struct EpiX1 {
    static constexpr bool PERM = false, AFTER_DRAIN = false;
    const float* xp; const float* xs; bf16_t* x1b; float* ss;
    __device__ __forceinline__ void operator()(const f32x4 (&acc)[2][2][4][2], const Unit& u, int wr, int wc, int fr, int fq) const {
        const int row0 = u.pm * BM + wr * 64 + fr, col0 = u.pn * BM + wc * 32 + 4 * fq;
        const float* xin = (u.pm < 64) ? xp : xs - (size_t)16384 * 1024;
#pragma unroll
        for (int ai = 0; ai < 2; ++ai)
#pragma unroll
            for (int m = 0; m < 4; ++m) { const size_t off = (size_t)(row0 + ai * HALF + m * 16) * 1024 + col0; float s = 0.f;
#pragma unroll
                for (int bj = 0; bj < 2; ++bj)
#pragma unroll
                    for (int n = 0; n < 2; ++n) { const size_t o = off + bj * HALF + n * 16; const f32x4 v = *(const f32x4*)(xin + o) + acc[ai][bj][m][n];
                        u32x2 w; w.x = cvt_pk_bf16(v[0], v[1]); w.y = cvt_pk_bf16(v[2], v[3]); *(u32x2*)(x1b + o) = w;
                        s += (v[0] * v[0] + v[1] * v[1]) + (v[2] * v[2] + v[3] * v[3]); }
                s += __shfl_xor(s, 16); s += __shfl_xor(s, 32);
                if (fq == 0) ss[(size_t)(row0 + ai * HALF + m * 16) * 16 + u.pn * 4 + wc] = s; }
    }
};
struct EpiUp {
    static constexpr bool PERM = true, AFTER_DRAIN = false;
    bf16_t* H; const float* ss; float eps;
    __device__ __forceinline__ void operator()(const f32x4 (&acc)[2][2][4][2], const Unit& u, int wr, int wc, int fr, int fq) const {
        const int row0 = u.pm * BM + wr * 64 + fr, col0 = u.pn * BM + wc * 32 + 8 * fq;
#pragma unroll
        for (int ai = 0; ai < 2; ++ai)
#pragma unroll
            for (int m = 0; m < 4; ++m) { const int r = row0 + ai * HALF + m * 16; const f32x4* sp = (const f32x4*)(ss + (size_t)r * 16);
                const f32x4 t = (sp[0] + sp[1]) + (sp[2] + sp[3]); const float rs2 = 1.0f / (((t[0] + t[1]) + (t[2] + t[3])) * (1.0f / 1024.0f) + eps);
                bf16_t* rowp = H + (size_t)r * 4096 + col0;
#pragma unroll
                for (int bj = 0; bj < 2; ++bj) { f32x4 v0 = acc[ai][bj][m][0], v1 = acc[ai][bj][m][1];
#pragma unroll
                    for (int j = 0; j < 4; ++j) { const float a = fmaxf(v0[j], 0.f), b = fmaxf(v1[j], 0.f); v0[j] = a * a * rs2; v1[j] = b * b * rs2; }
                    u32x4 w; w.x = cvt_pk_bf16(v0[0], v0[1]); w.y = cvt_pk_bf16(v0[2], v0[3]); w.z = cvt_pk_bf16(v1[0], v1[1]); w.w = cvt_pk_bf16(v1[2], v1[3]);
                    *(u32x4*)(rowp + bj * HALF) = w; } }
    }
};
struct EpiDown {
    static constexpr bool PERM = false, AFTER_DRAIN = false;
    float* out; const bf16_t* x1b;
    __device__ __forceinline__ void operator()(const f32x4 (&acc)[2][2][4][2], const Unit& u, int wr, int wc, int fr, int fq) const {
        const int row0 = u.pm * BM + wr * 64 + fr, col0 = u.pn * BM + wc * 32 + 4 * fq;
#pragma unroll
        for (int ai = 0; ai < 2; ++ai)
#pragma unroll
            for (int m = 0; m < 4; ++m) { const size_t off = (size_t)(row0 + ai * HALF + m * 16) * 1024 + col0;
#pragma unroll
                for (int bj = 0; bj < 2; ++bj)
#pragma unroll
                    for (int n = 0; n < 2; ++n) { const size_t o = off + bj * HALF + n * 16; const u32x2 w = *(const u32x2*)(x1b + o);
                        f32x4 v; v[0] = __uint_as_float(w.x << 16); v[1] = __uint_as_float(w.x & 0xffff0000u); v[2] = __uint_as_float(w.y << 16); v[3] = __uint_as_float(w.y & 0xffff0000u);
                        *(f32x4*)(out + o) = v + acc[ai][bj][m][n]; } }
    }
};
struct EpiSlab {
    static constexpr bool PERM = false, AFTER_DRAIN = false;
    float* slab; int rows;
    __device__ __forceinline__ void operator()(const f32x4 (&acc)[2][2][4][2], const Unit& u, int wr, int wc, int fr, int fq) const {
        const int row0 = u.pm * BM + wr * 64 + fr, col0 = u.pn * BM + wc * 32 + 4 * fq;
#pragma unroll
        for (int ai = 0; ai < 2; ++ai)
#pragma unroll
            for (int m = 0; m < 4; ++m) { float* rowp = slab + ((size_t)u.ks * rows + row0 + ai * HALF + m * 16) * 1024 + col0;
#pragma unroll
                for (int bj = 0; bj < 2; ++bj)
#pragma unroll
                    for (int n = 0; n < 2; ++n) *(f32x4*)(rowp + bj * HALF + n * 16) = acc[ai][bj][m][n]; }
    }
};

template <class Epi, class Sched, bool ALIGN_EPI = false, bool SP2 = false>
__device__ __forceinline__ void gemm_phase(PG8_LAS unsigned char* lds, const Gemm g, const Sched& S, const Epi& E) {
    const int tid = threadIdx.x, wid = __builtin_amdgcn_readfirstlane(tid >> 6), lane = tid & 63, wr = wid >> 2, wc = wid & 3, fr = lane & 15, fq = lane >> 4;
    const int K = g.K, nt = K / BK, LD = g.ld;
    unsigned voffA[2], voffB[2];
#pragma unroll
    for (int i = 0; i < 2; ++i) { int R, C; stage_rc(tid * 16 + i * 8192, R, C); const int Rb = Epi::PERM ? ((R & ~31) + perm32(R & 31)) : R;
        voffA[i] = (unsigned)(R * LD + C) * 2u; voffB[i] = (unsigned)(Rb * LD + C) * 2u; }
    const size_t kstep = (size_t)(BK * 2);
    const size_t hstep = (size_t)HALF * LD * 2, sstep = (size_t)K * 2;
    const size_t tstep = 2 * hstep;
    const unsigned ldsw = (unsigned)wid * 1024u;
    const int aoff = lds_byte(wr * 64 + fr, fq * 8), boff = lds_byte(wc * 32 + fr, fq * 8);
#define PG8_SA(b, h) (((b) * 2 + (h)) * HTB)
#define PG8_SB(b, h) ((4 + (b) * 2 + (h)) * HTB)
#define PG8_STAGE(bufoff, gbase, voff) do { _Pragma("unroll") for (int _i = 0; _i < 2; ++_i) \
        __builtin_amdgcn_global_load_lds((const unsigned*)((const char*)(gbase) + (voff)[_i]), (PG8_LAS unsigned*)(lds + (bufoff) + ldsw + _i * 8192), 16, 0, 0); } while (0)
#define PG8_LDA(dst, b, h) do { _Pragma("unroll") for (int m = 0; m < 4; ++m) _Pragma("unroll") for (int k = 0; k < 2; ++k) dst[m][k] = *(const PG8_LAS bf16x8*)(lds + PG8_SA(b, h) + aoff + m * 2048 + k * 1024); } while (0)
#define PG8_LDB(dst, b, h) do { _Pragma("unroll") for (int n = 0; n < 2; ++n) _Pragma("unroll") for (int k = 0; k < 2; ++k) dst[n][k] = *(const PG8_LAS bf16x8*)(lds + PG8_SB(b, h) + boff + n * 2048 + k * 1024); } while (0)
#define PG8_MMA(ai, bj, At, Bt) do { __builtin_amdgcn_s_setprio(1); _Pragma("unroll") for (int m = 0; m < 4; ++m) _Pragma("unroll") for (int n = 0; n < 2; ++n) _Pragma("unroll") for (int k = 0; k < 2; ++k) \
        acc[ai][bj][m][n] = __builtin_amdgcn_mfma_f32_16x16x32_bf16(Bt[n][k], At[m][k], acc[ai][bj][m][n], 0, 0, 0); __builtin_amdgcn_s_setprio(0); } while (0)
#define PG8_WAIT_V(n) asm volatile("s_waitcnt vmcnt(" #n ")" ::: "memory")
#define PG8_WAIT_L(n) asm volatile("s_waitcnt lgkmcnt(" #n ")" ::: "memory")
#define PG8_BAR __builtin_amdgcn_s_barrier()
#define PG8_SCHED __builtin_amdgcn_sched_barrier(0)
    Unit cur, nxt; int ui = 0;
    if (!S.next(0, cur)) return;
    f32x4 acc[2][2][4][2];
#pragma unroll
    for (int a = 0; a < 2; ++a)
#pragma unroll
        for (int b = 0; b < 2; ++b)
#pragma unroll
            for (int m = 0; m < 4; ++m)
#pragma unroll
                for (int n = 0; n < 2; ++n) acc[a][b][m][n] = (f32x4){0.f, 0.f, 0.f, 0.f};
    bf16x8 At[4][2], B0[2][2], B1[2][2];
    const char* cA = (const char*)g.A + (size_t)cur.pm * tstep + (size_t)cur.ks * sstep; const char* cB = (const char*)g.Bt + (size_t)cur.pn * tstep + (size_t)cur.ks * sstep;
    S.a_ready(cur);
    if constexpr (SP2) {
        PG8_STAGE(PG8_SB(0, 0), cB, voffB); PG8_STAGE(PG8_SB(0, 1), cB + hstep, voffB); PG8_STAGE(PG8_SA(0, 0), cA, voffA); PG8_STAGE(PG8_SA(0, 1), cA + hstep, voffA);
        if (wr == 1) PG8_BAR;
        PG8_WAIT_V(2); PG8_BAR;
        PG8_STAGE(PG8_SB(1, 0), cB + kstep, voffB); PG8_STAGE(PG8_SA(1, 0), cA + kstep, voffA); PG8_STAGE(PG8_SB(1, 1), cB + hstep + kstep, voffB);
        PG8_WAIT_V(6); PG8_BAR;
    } else {
        PG8_STAGE(PG8_SB(0, 0), cB, voffB); PG8_STAGE(PG8_SA(0, 0), cA, voffA); PG8_STAGE(PG8_SB(0, 1), cB + hstep, voffB); PG8_STAGE(PG8_SA(0, 1), cA + hstep, voffA);
        if (wr == 1) PG8_BAR;
        PG8_WAIT_V(4); PG8_BAR;
        PG8_STAGE(PG8_SB(1, 0), cB + kstep, voffB); PG8_STAGE(PG8_SA(1, 0), cA + kstep, voffA); PG8_STAGE(PG8_SB(1, 1), cB + hstep + kstep, voffB);
        PG8_WAIT_V(6); PG8_BAR;
    }
    for (;;) {
        const bool has_next = S.next(ui + 1, nxt);
        const char* nA = has_next ? (const char*)g.A + (size_t)nxt.pm * tstep + (size_t)nxt.ks * sstep : cA; const char* nB = has_next ? (const char*)g.Bt + (size_t)nxt.pn * tstep + (size_t)nxt.ks * sstep : cB;
        for (int t = 0; t < nt; t += 2) {
            const bool last = (t == nt - 2);
            const char* a1 = cA + (size_t)(t + 1) * kstep;
            const char* a2 = last ? nA : cA + (size_t)(t + 2) * kstep; const char* b2 = last ? nB : cB + (size_t)(t + 2) * kstep;
            const char* a3 = a2 + kstep; const char* b3 = b2 + kstep;
            if (last && has_next) S.a_ready(nxt);
            if constexpr (SP2) {
            PG8_LDB(B0, 0, 0); PG8_LDB(B1, 0, 1); PG8_SCHED; PG8_LDA(At, 0, 0); PG8_STAGE(PG8_SA(1, 1), a1 + hstep, voffA);
            PG8_WAIT_V(8); PG8_WAIT_L(0); PG8_BAR; PG8_MMA(0, 0, At, B0); PG8_MMA(0, 1, At, B1); PG8_BAR; PG8_SCHED;
            PG8_LDA(At, 0, 1); PG8_STAGE(PG8_SB(0, 0), b2, voffB); PG8_STAGE(PG8_SB(0, 1), b2 + hstep, voffB); PG8_STAGE(PG8_SA(0, 0), a2, voffA);
            PG8_WAIT_V(8); PG8_WAIT_L(0); PG8_BAR; PG8_MMA(1, 0, At, B0); PG8_MMA(1, 1, At, B1); PG8_BAR; PG8_SCHED;
            PG8_LDB(B0, 1, 0); PG8_LDB(B1, 1, 1); PG8_SCHED; PG8_LDA(At, 1, 0); PG8_STAGE(PG8_SA(0, 1), a2 + hstep, voffA);
            PG8_WAIT_V(8); PG8_WAIT_L(0); PG8_BAR; PG8_MMA(0, 0, At, B0); PG8_MMA(0, 1, At, B1); PG8_BAR; PG8_SCHED;
            PG8_LDA(At, 1, 1); PG8_STAGE(PG8_SB(1, 0), b3, voffB); PG8_STAGE(PG8_SB(1, 1), b3 + hstep, voffB); PG8_STAGE(PG8_SA(1, 0), a3, voffA);
            PG8_WAIT_V(8); PG8_WAIT_L(0); PG8_BAR; PG8_MMA(1, 0, At, B0); PG8_MMA(1, 1, At, B1); PG8_BAR; PG8_SCHED;
            } else {
            PG8_LDB(B0, 0, 0); PG8_SCHED; PG8_LDA(At, 0, 0); PG8_STAGE(PG8_SA(1, 1), a1 + hstep, voffA);
            PG8_WAIT_L(8); PG8_BAR; PG8_WAIT_L(0); PG8_MMA(0, 0, At, B0); PG8_BAR; PG8_SCHED;
            PG8_LDB(B1, 0, 1); PG8_STAGE(PG8_SB(0, 0), b2, voffB);
            PG8_BAR; PG8_WAIT_L(0); PG8_MMA(0, 1, At, B1); PG8_BAR;
            PG8_LDA(At, 0, 1); PG8_STAGE(PG8_SA(0, 0), a2, voffA);
            PG8_BAR; PG8_WAIT_L(0); PG8_MMA(1, 0, At, B0); PG8_BAR; PG8_SCHED;
            PG8_STAGE(PG8_SB(0, 1), b2 + hstep, voffB);
            PG8_WAIT_V(6); PG8_BAR; PG8_MMA(1, 1, At, B1); PG8_BAR;
            PG8_LDB(B0, 1, 0); PG8_SCHED; PG8_LDA(At, 1, 0); PG8_STAGE(PG8_SA(0, 1), a2 + hstep, voffA);
            PG8_WAIT_L(8); PG8_BAR; PG8_WAIT_L(0); PG8_MMA(0, 0, At, B0); PG8_BAR; PG8_SCHED;
            PG8_LDB(B1, 1, 1); PG8_STAGE(PG8_SB(1, 0), b3, voffB);
            PG8_BAR; PG8_WAIT_L(0); PG8_MMA(0, 1, At, B1); PG8_BAR;
            PG8_LDA(At, 1, 1); PG8_STAGE(PG8_SA(1, 0), a3, voffA);
            PG8_BAR; PG8_WAIT_L(0); PG8_MMA(1, 0, At, B0); PG8_BAR; PG8_SCHED;
            PG8_STAGE(PG8_SB(1, 1), b3 + hstep, voffB);
            PG8_WAIT_V(6); PG8_BAR; PG8_MMA(1, 1, At, B1); PG8_BAR;
            }
        }
        if constexpr (ALIGN_EPI) { if (wr == 0) PG8_BAR; }
        if constexpr (!Epi::AFTER_DRAIN) { E(acc, cur, wr, wc, fr, fq); S.done(cur); }
        if (!has_next) break;
#pragma unroll
        for (int a = 0; a < 2; ++a)
#pragma unroll
            for (int b = 0; b < 2; ++b)
#pragma unroll
                for (int m = 0; m < 4; ++m)
#pragma unroll
                    for (int n = 0; n < 2; ++n) acc[a][b][m][n] = (f32x4){0.f, 0.f, 0.f, 0.f};
        cur = nxt; cA = nA; cB = nB; ++ui;
        if constexpr (ALIGN_EPI) { if (wr == 1) PG8_BAR; }
    }
    PG8_WAIT_V(0);
    if constexpr (!ALIGN_EPI) { if (wr == 0) PG8_BAR; }
    PG8_BAR;
    if constexpr (Epi::AFTER_DRAIN) { E.fused(acc, cur, wr, wc, fr, fq, lds, wid, lane); S.done(cur); }
#undef PG8_SA
#undef PG8_SB
#undef PG8_STAGE
#undef PG8_LDA
#undef PG8_LDB
#undef PG8_MMA
#undef PG8_WAIT_V
#undef PG8_WAIT_L
#undef PG8_BAR
#undef PG8_SCHED
}
}
#ifndef PG8_SP2
#define PG8_SP2 true
#endif
#ifndef PG8_ALIGN
#define PG8_ALIGN true
#endif
constexpr int NWAVES = 8;
constexpr int D = 1024, DIN = 2560, FF = 4096, DC = 512, DL = 512;
constexpr int MP = 4 * 4096, MS = 32 * 64, M = MP + MS;
constexpr int NCHUNK = M / 64, NPCHUNK = MP / 64;
constexpr float EPS = 1e-6f;
constexpr size_t O_YP = 0, O_YS = (size_t)MP * D, O_CAP = (size_t)M * D, O_LCP = O_CAP + 4 * 2 * 512, O_LHP = O_LCP + 4 * 3 * 512, O_CAS = O_LHP + 4 * 512, O_LCS = O_CAS + 32 * 2 * 512, O_LHS = O_LCS + 32 * 3 * 512, O_END = O_LHS + 32 * 512;
constexpr size_t MiB = 1u << 20;
constexpr size_t WS_CTL = 0, CTL_ZERO_BYTES = 1 * MiB;
constexpr size_t WS_WIN = 2 * MiB, WS_WOUT = 8 * MiB, WS_WUP = 10 * MiB, WS_WDN = 18 * MiB;
constexpr size_t WS_GW = 26 * MiB;
constexpr size_t WS_HC = WS_GW + 131072;
constexpr size_t WS_SS = 27 * MiB;
constexpr size_t WS_SUM = 29 * MiB;
constexpr size_t WS_XN = 32 * MiB;
constexpr size_t WS_H = 68 * MiB;
constexpr size_t WS_PROJ = 68 * MiB;
constexpr size_t WS_MIX = 160 * MiB;
constexpr size_t WS_X1B = 212 * MiB;
constexpr int KSPLIT = 4;
constexpr size_t WS_SLAB = WS_XN;
constexpr size_t WS_END = 248 * MiB;
static_assert(WS_XN + (size_t)M * D * 2 <= WS_H && WS_PROJ + (size_t)M * DIN * 2 <= WS_MIX && WS_MIX + (size_t)M * D * 2 <= WS_X1B && WS_H + (size_t)M * FF * 2 <= WS_X1B && WS_X1B + (size_t)M * D * 2 <= WS_END && WS_SLAB + (size_t)KSPLIT * MS * D * 4 <= WS_H, "d_ws map");
static_assert(WS_SS + (size_t)M * 16 * 4 <= WS_SUM && WS_SUM + (size_t)NPCHUNK * 2 * 512 * 4 <= WS_XN, "d_ws map (small)");
constexpr int CW_BAR = 4096;
constexpr int RING_OFF = 0, RING_BYTES = 131072;
constexpr int LDSCTL_OFF = RING_BYTES, MISC_OFF = LDSCTL_OFF + 320;
constexpr int LDS_BYTES = 147456;
#define GAS __attribute__((address_space(1)))
#define LAS __attribute__((address_space(3)))
typedef unsigned short bf16;
typedef unsigned v4u __attribute__((ext_vector_type(4)));
typedef unsigned v2u __attribute__((ext_vector_type(2)));
typedef float f32x4 __attribute__((ext_vector_type(4)));
typedef short bf16x8 __attribute__((ext_vector_type(8)));
typedef GAS unsigned gu32;
#define RLX_AGENT __ATOMIC_RELAXED, __HIP_MEMORY_SCOPE_AGENT
#define LDS_WAIT() asm volatile("s_waitcnt lgkmcnt(0)" ::: "memory")
#define VM_WAIT() asm volatile("s_waitcnt vmcnt(0)" ::: "memory")
__device__ __forceinline__ unsigned f2bf(float f) { unsigned u = __builtin_bit_cast(unsigned, f); return (u + 0x7fffu + ((u >> 16) & 1u)) >> 16; }
__device__ __forceinline__ unsigned pk2(float lo, float hi) { return f2bf(lo) | (f2bf(hi) << 16); }
__device__ __forceinline__ f32x4 ld_bf16x4(const bf16* p) { const v2u w = *(const v2u*)p; f32x4 r; r.x = __uint_as_float(w.x << 16); r.y = __uint_as_float(w.x & 0xffff0000u); r.z = __uint_as_float(w.y << 16); r.w = __uint_as_float(w.y & 0xffff0000u); return r; }
__device__ __forceinline__ void st_bf16x4(bf16* p, f32x4 v) { v2u w; w.x = pg8::cvt_pk_bf16(v.x, v.y); w.y = pg8::cvt_pk_bf16(v.z, v.w); *(v2u*)p = w; }
__device__ __forceinline__ float fast_rcp(float x) { return __builtin_amdgcn_rcpf(x); }
__device__ __forceinline__ float fast_exp(float x) { return __builtin_amdgcn_exp2f(x * 1.44269504089f); }
__device__ __forceinline__ float sigmoidf_(float x) { return fast_rcp(1.0f + fast_exp(-x)); }
template <int S> __device__ __forceinline__ float dpp_shr(float v, float ident) {
    return __builtin_bit_cast(float, __builtin_amdgcn_update_dpp(__builtin_bit_cast(int, ident), __builtin_bit_cast(int, v), 0x110 + S, 0xf, 0xf, false));
}
#if MK_MODE == 2
#define XB_TMO      128
#define XB_XCNT(j)  (256  + 64 * (j))
#define XB_XSUB(j)  (1280 + 64 * (j))
#define XB_XGEN(j)  (2304 + 64 * (j))
#define XB_TOP      3328
#define XB_TOPGEN   3392
#define XCD_BAR_WORDS 3456
#define XB_SPIN_CAP (1u << 18)

__device__ __forceinline__ unsigned xb_ld(unsigned* p)              { return __hip_atomic_load(p, __ATOMIC_RELAXED, __HIP_MEMORY_SCOPE_AGENT); }
__device__ __forceinline__ unsigned xb_add(unsigned* p, unsigned v) { return __hip_atomic_fetch_add(p, v, __ATOMIC_RELAXED, __HIP_MEMORY_SCOPE_AGENT); }
__device__ __forceinline__ unsigned xb_xcc_id() { return (unsigned)__builtin_amdgcn_s_getreg((3 << 11) | 20) & 0xFu; }
#define XB_SPIN(cond, bar) do { unsigned _sp = 0; while (cond) { __builtin_amdgcn_s_sleep(1); \
    if ((++_sp & 255u) == 0u) { if (xb_ld(&(bar)[XB_TMO])) break; if (_sp > XB_SPIN_CAP) { atomicAdd(&(bar)[XB_TMO], 1u); break; } } } } while (0)

struct XcdBarrier {
    unsigned* bar; unsigned x;
    volatile LAS unsigned* st;
};

__device__ __forceinline__ XcdBarrier xcd_barrier_post(unsigned* bar, volatile LAS unsigned* st) {
    XcdBarrier b; b.bar = bar; b.x = xb_xcc_id(); b.st = st;
    if (threadIdx.x == 0) (void)xb_add(&bar[XB_XCNT(b.x)], 1u);
    return b;
}
__device__ __forceinline__ void xcd_barrier_complete(unsigned* bar, unsigned x, unsigned& nloc, unsigned& nx) {
    const unsigned G = gridDim.x * gridDim.y * gridDim.z;
    unsigned sum, cnt, mine, sp = 0u;
    for (;;) {
        sum = 0u; cnt = 0u; mine = 0u;
#pragma unroll
        for (unsigned j = 0; j < 16; ++j) { const unsigned c = xb_ld(&bar[XB_XCNT(j)]); sum += c; cnt += (c > 0u) ? 1u : 0u; mine = (j == x) ? c : mine; }
        if (sum == G) break;
        __builtin_amdgcn_s_sleep(1);
        if ((++sp & 255u) == 0u) { if (xb_ld(&bar[XB_TMO])) break; if (sp > XB_SPIN_CAP) { atomicAdd(&bar[XB_TMO], 1u); break; } }
    }
    nloc = mine > 0u ? mine : 1u; nx = cnt > 0u ? cnt : 1u;
}

__device__ __forceinline__ void xcd_barrier(const XcdBarrier& b) {
    asm volatile("s_waitcnt vmcnt(0)" ::: "memory");
    __syncthreads();
    if (threadIdx.x == 0) {
        unsigned* bar = b.bar;
        __builtin_amdgcn_s_waitcnt(0);
        unsigned nloc = b.st[0], nx = b.st[1];
        if (nloc == 0u) { xcd_barrier_complete(bar, b.x, nloc, nx); b.st[0] = nloc; b.st[1] = nx; }
        const unsigned old = xb_add(&bar[XB_XSUB(b.x)], 1u);
        const unsigned gen = old / nloc;
        if (old + 1u == (gen + 1u) * nloc) {
            __builtin_amdgcn_fence(__ATOMIC_RELEASE, "agent");
            asm volatile("s_waitcnt vmcnt(0)" ::: "memory");
            const unsigned og = xb_add(&bar[XB_TOP], 1u);
            const unsigned tg = og / nx;
            if (og + 1u == (tg + 1u) * nx) xb_add(&bar[XB_TOPGEN], 1u);
            else XB_SPIN(xb_ld(&bar[XB_TOPGEN]) == tg, bar);
            __builtin_amdgcn_fence(__ATOMIC_ACQUIRE, "agent");
            xb_add(&bar[XB_XGEN(b.x)], 1u);
            asm volatile("s_waitcnt vmcnt(0)" ::: "memory");
        } else {
            XB_SPIN(xb_ld(&bar[XB_XGEN(b.x)]) == gen, bar);
            __builtin_amdgcn_fence(__ATOMIC_ACQUIRE, "agent");
            asm volatile("s_waitcnt vmcnt(0)" ::: "memory");
        }
    }
    __syncthreads();
}
#endif
struct Args {
    const float* xp; const float* xs; const float* st_ca; const float* st_lc; const float* st_lh; const float* g1; const float* w_in; const float* conv_a_w; const float* lru_conv_w;
    const float* lru_conv_b; const float* lru_wa; const float* lru_ba; const float* lru_wx; const float* lru_bx; const float* lru_a_param; const float* w_out; const float* g2;
    const float* w_up; const float* w_down; const float* gf; float* out; unsigned char* ws; int ph_lo, ph_hi;
};
__device__ __forceinline__ float wave_sum(float v) {
#pragma unroll
    for (int o = 1; o < 64; o <<= 1) v += __shfl_xor(v, o);
    return v;
}
__device__ __forceinline__ void p0_transpose_item(const float* W, const float* g, int K, int N, bf16* WT, LAS float* scr, int item, int lane) {
    const int nblk = N / 32, kb = item / nblk, nb = item % nblk, k0 = 64 * kb, n0 = 32 * nb;
#pragma unroll 8
    for (int i = 0; i < 32; ++i) { const int kk = 2 * i + (lane >> 5); float v = W[(size_t)(k0 + kk) * N + n0 + (lane & 31)]; if (g) v *= g[k0 + kk]; scr[kk * 33 + (lane & 31)] = v; }
    LDS_WAIT(); asm volatile("" ::: "memory");
    const int c = lane & 7;
#pragma unroll
    for (int j = 0; j < 4; ++j) { const int n = (lane >> 3) + 8 * j; const LAS float* s = scr + (8 * c) * 33 + n;
        v4u o; o.x = pk2(s[0 * 33], s[1 * 33]); o.y = pk2(s[2 * 33], s[3 * 33]); o.z = pk2(s[4 * 33], s[5 * 33]); o.w = pk2(s[6 * 33], s[7 * 33]);
        *(GAS v4u*)(WT + (size_t)(n0 + n) * K + k0 + 8 * c) = o; }
    LDS_WAIT(); asm volatile("" ::: "memory");
}
__device__ __forceinline__ void rms_row_bf16(const float* xrow, const float* g, bf16* orow, int lane) {
    const GAS f32x4* xr = (const GAS f32x4*)xrow + lane; const GAS f32x4* gr = (const GAS f32x4*)g + lane;
    f32x4 v[4]; float s = 0.f;
#pragma unroll
    for (int j = 0; j < 4; ++j) { v[j] = xr[64 * j]; s += (v[j].x * v[j].x + v[j].y * v[j].y) + (v[j].z * v[j].z + v[j].w * v[j].w); }
    const float rs = 1.0f / sqrtf(wave_sum(s) * (1.f / D) + EPS);
    GAS v2u* o8 = (GAS v2u*)orow + lane;
#pragma unroll
    for (int j = 0; j < 4; ++j) { const f32x4 gg = gr[64 * j]; v2u w; w.x = pk2(v[j].x * rs * gg.x, v[j].y * rs * gg.y); w.y = pk2(v[j].z * rs * gg.z, v[j].w * rs * gg.w); o8[64 * j] = w; }
}
__device__ __forceinline__ void rms_row_final(float* xrow, const bf16* x1row, const float* slabrow, const float* g, int lane) {
    GAS f32x4* xr = (GAS f32x4*)xrow + lane; const GAS f32x4* gr = (const GAS f32x4*)g + lane;
    f32x4 v[4]; float s = 0.f;
    if (x1row == nullptr) {
#pragma unroll
        for (int j = 0; j < 4; ++j) v[j] = xr[64 * j];
    } else {
#pragma unroll
        for (int j = 0; j < 4; ++j) { v[j] = ld_bf16x4(x1row + 4 * lane + 256 * j);
#pragma unroll
            for (int sl = 0; sl < KSPLIT; ++sl) v[j] = v[j] + *((const GAS f32x4*)(slabrow + (size_t)sl * MS * D) + lane + 64 * j); }
    }
#pragma unroll
    for (int j = 0; j < 4; ++j) s += (v[j].x * v[j].x + v[j].y * v[j].y) + (v[j].z * v[j].z + v[j].w * v[j].w);
    const float rs = 1.0f / sqrtf(wave_sum(s) * (1.f / D) + EPS);
#pragma unroll
    for (int j = 0; j < 4; ++j) { const f32x4 gg = gr[64 * j]; xr[64 * j] = v[j] * rs * gg; }
}
__device__ __forceinline__ void p0_prologue(const Args& A, LAS unsigned char* lds, int gw, int NGW, int wave, int lane) {
    LAS float* scr = (LAS float*)(lds + RING_OFF + wave * 16384);
    unsigned char* ws = A.ws;
    constexpr int I_IN = (D / 64) * (DIN / 32), I_OUT = (D / 64) * (D / 32), I_UP = (D / 64) * (FF / 32), I_DN = (FF / 64) * (D / 32);
    constexpr int NITEMS = I_IN + I_OUT + I_UP + I_DN;
    for (int it = gw; it < NITEMS; it += NGW) {
        int r = it;
        if (r < I_IN) { p0_transpose_item(A.w_in, nullptr, D, DIN, (bf16*)(ws + WS_WIN), scr, r, lane); continue; } r -= I_IN;
        if (r < I_OUT) { p0_transpose_item(A.w_out, nullptr, D, D, (bf16*)(ws + WS_WOUT), scr, r, lane); continue; } r -= I_OUT;
        if (r < I_UP) { p0_transpose_item(A.w_up, A.g2, D, FF, (bf16*)(ws + WS_WUP), scr, r, lane); continue; } r -= I_UP;
        p0_transpose_item(A.w_down, nullptr, FF, D, (bf16*)(ws + WS_WDN), scr, r, lane);
    }
    for (int idx = gw; idx < 128; idx += NGW) {
        const int hd = idx >> 4, gate = (idx >> 3) & 1, jt = (idx >> 1) & 3, ks = idx & 1, jj = lane & 15, qa = lane >> 4;
        const float* W = (gate ? A.lru_wx : A.lru_wa) + hd * 4096 + 32 * (jt >> 1) + 8 * (jj >> 2) + 4 * (jt & 1) + (jj & 3);
        float v[8];
#pragma unroll
        for (int e = 0; e < 8; ++e) v[e] = W[(32 * ks + 8 * qa + e) * 64];
        v4u o; o.x = pk2(v[0], v[1]); o.y = pk2(v[2], v[3]); o.z = pk2(v[4], v[5]); o.w = pk2(v[6], v[7]);
        *(GAS v4u*)((bf16*)(ws + WS_GW) + (size_t)idx * 512 + lane * 8) = o;
    }
    if (gw >= NGW - 8) {
        const int hd = NGW - 1 - gw, c = hd * 64 + lane; float* hc = (float*)(ws + WS_HC) + hd * 704 + lane;
#pragma unroll
        for (int k = 0; k < 4; ++k) hc[k * 64] = A.lru_conv_w[k * 512 + c];
        hc[256] = A.lru_conv_b[c]; hc[320] = A.lru_ba[c]; hc[384] = A.lru_bx[c];
        { const float x = A.lru_a_param[c]; hc[448] = x > 20.f ? x : log1pf(expf(x)); }
#pragma unroll
        for (int k = 0; k < 3; ++k) hc[512 + k * 64] = A.conv_a_w[k * 512 + c];
    }
    for (int m = gw; m < M; m += NGW) rms_row_bf16(m < MP ? A.xp + (size_t)m * D : A.xs + (size_t)(m - MP) * D, A.g1, (bf16*)(ws + WS_XN) + (size_t)m * D, lane);
}
typedef __amdgpu_buffer_rsrc_t rsrc_t;
struct f32x8 { f32x4 lo, hi; };
__device__ __forceinline__ f32x8 bld_bf16x8(rsrc_t r, int voff, int soff) { const v4u w = __builtin_amdgcn_raw_buffer_load_b128(r, voff, soff, 0); f32x8 o;
    o.lo.x = __uint_as_float(w.x << 16); o.lo.y = __uint_as_float(w.x & 0xffff0000u); o.lo.z = __uint_as_float(w.y << 16); o.lo.w = __uint_as_float(w.y & 0xffff0000u);
    o.hi.x = __uint_as_float(w.z << 16); o.hi.y = __uint_as_float(w.z & 0xffff0000u); o.hi.z = __uint_as_float(w.w << 16); o.hi.w = __uint_as_float(w.w & 0xffff0000u); return o; }
__device__ __forceinline__ v4u pack_bf16x8(f32x4 lo, f32x4 hi) { v4u w; w.x = pg8::cvt_pk_bf16(lo.x, lo.y); w.y = pg8::cvt_pk_bf16(lo.z, lo.w); w.z = pg8::cvt_pk_bf16(hi.x, hi.y); w.w = pg8::cvt_pk_bf16(hi.z, hi.w); return w; }
__device__ __forceinline__ f32x4 bld_f32x4(rsrc_t r, int voff, int soff) { return __builtin_bit_cast(f32x4, __builtin_amdgcn_raw_buffer_load_b128(r, voff, soff, 0)); }
#define MEMFENCE() asm volatile("" ::: "memory")
__device__ __forceinline__ f32x4 exp2v(f32x4 x) { f32x4 r; r.x = __builtin_amdgcn_exp2f(x.x); r.y = __builtin_amdgcn_exp2f(x.y); r.z = __builtin_amdgcn_exp2f(x.z); r.w = __builtin_amdgcn_exp2f(x.w); return r; }
__device__ __forceinline__ f32x4 rcpv(f32x4 x) { f32x4 r; r.x = __builtin_amdgcn_rcpf(x.x); r.y = __builtin_amdgcn_rcpf(x.y); r.z = __builtin_amdgcn_rcpf(x.z); r.w = __builtin_amdgcn_rcpf(x.w); return r; }
__device__ __forceinline__ f32x4 sqrtv(f32x4 x) { f32x4 r; r.x = __builtin_amdgcn_sqrtf(x.x); r.y = __builtin_amdgcn_sqrtf(x.y); r.z = __builtin_amdgcn_sqrtf(x.z); r.w = __builtin_amdgcn_sqrtf(x.w); return r; }
__device__ __forceinline__ float bcast15(float v) { return __builtin_bit_cast(float, __builtin_amdgcn_update_dpp(0, __builtin_bit_cast(int, v), 0x15F, 0xf, 0xf, false)); }
#define KS4_STEP(S) \
    "v_fmac_f32_dpp %4, %4, %0 row_shr:" #S " row_mask:0xf bank_mask:0xf\n\tv_fmac_f32_dpp %5, %5, %1 row_shr:" #S " row_mask:0xf bank_mask:0xf\n\t" \
    "v_fmac_f32_dpp %6, %6, %2 row_shr:" #S " row_mask:0xf bank_mask:0xf\n\tv_fmac_f32_dpp %7, %7, %3 row_shr:" #S " row_mask:0xf bank_mask:0xf\n\t" \
    "v_mul_f32_dpp %0, %0, %0 row_shr:" #S " row_mask:0xf bank_mask:0xf\n\tv_mul_f32_dpp %1, %1, %1 row_shr:" #S " row_mask:0xf bank_mask:0xf\n\t" \
    "v_mul_f32_dpp %2, %2, %2 row_shr:" #S " row_mask:0xf bank_mask:0xf\n\tv_mul_f32_dpp %3, %3, %3 row_shr:" #S " row_mask:0xf bank_mask:0xf\n\t"
__device__ __forceinline__ void scan16x4(f32x4& a, f32x4& b) {
    float a0 = a.x, a1 = a.y, a2 = a.z, a3 = a.w, b0 = b.x, b1 = b.y, b2 = b.z, b3 = b.w;
    asm("s_nop 1\n\t" KS4_STEP(1) KS4_STEP(2) KS4_STEP(4) KS4_STEP(8) "s_nop 1" : "+v"(a0), "+v"(a1), "+v"(a2), "+v"(a3), "+v"(b0), "+v"(b1), "+v"(b2), "+v"(b3));
    a = (f32x4){a0, a1, a2, a3}; b = (f32x4){b0, b1, b2, b3};
}
#define KS_STEP(S, a, b) { const float ap_ = dpp_shr<S>(a, 1.0f), bp_ = dpp_shr<S>(b, 0.0f); b = fmaf(a, bp_, b); a = a * ap_; }
template <bool fin>
__device__ __forceinline__ void mix_item(const Args& A, rsrc_t rP, rsrc_t rM, rsrc_t rC, rsrc_t rS, int ck, int hd, int lane) {
    const int tl = lane & 15, q = lane >> 4;
    const int vg = hd * 16384 + lane * 16, vc = 131072 + hd * 2816 + q * 32;
#define LDC(arr, off) bld_f32x4(rC, vc, (arr) * 256 + (off))
#define LDG(gate, jt, ks) __builtin_bit_cast(bf16x8, __builtin_amdgcn_raw_buffer_load_b128(rC, vg, (((gate) * 4 + (jt)) * 2 + (ks)) * 1024, 0))
    const bool is_sample = ck >= NPCHUNK, first = is_sample || ((ck & 63) == 0), lastc = is_sample || ((ck & 63) == 63);
    const int sb = is_sample ? ck - NPCHUNK : ck >> 6;
    const int row0 = ck * 64, cb = hd * 64 + 8 * q;
    const int vb0 = ((row0 + tl) * DIN + cb) * 2, mb0 = ((row0 + tl) * D + cb) * 2;
    const int vs = cb * 4 + ((ck & ~63) + 4 * tl) * 4096;
    f32x8 cl[4][2];
#pragma unroll
    for (int ks = 0; ks < 2; ++ks) {
        const int c = cb + 32 * ks;
        f32x4 wl[4], wh[4];
#pragma unroll
        for (int k = 0; k < 4; ++k) { wl[k] = LDC(k, ks * 128); wh[k] = LDC(k, ks * 128 + 16); }
        const f32x4 bl = LDC(4, ks * 128), bh = LDC(4, ks * 128 + 16);
#pragma unroll
        for (int m = 0; m < 4; ++m) {
            f32x8 x[4];
#pragma unroll
            for (int k = 0; k < 4; ++k) {
                if (m > 0 || k == 3) x[k] = bld_bf16x8(rP, vb0, ((16 * m - 3 + k) * DIN + 1536 + 32 * ks) * 2);
                else { const int tk = tl - 3 + k;
                    if (!first || tk >= 0) x[k] = bld_bf16x8(rP, vb0 - (3 - k) * DIN * 2, (1536 + 32 * ks) * 2);
                    else if (is_sample) { const float* p = A.st_lc + (size_t)(sb * 3 + 3 + tk) * 512 + c; x[k].lo = *(const f32x4*)p; x[k].hi = *(const f32x4*)(p + 4); }
                    else { x[k].lo = (f32x4){0.f, 0.f, 0.f, 0.f}; x[k].hi = x[k].lo; } } }
            cl[m][ks].lo = bl + wl[0] * x[0].lo + wl[1] * x[1].lo + wl[2] * x[2].lo + wl[3] * x[3].lo;
            cl[m][ks].hi = bh + wh[0] * x[0].hi + wh[1] * x[1].hi + wh[2] * x[2].hi + wh[3] * x[3].hi;
            if (m == 3) { if (fin && lastc && tl >= 13) { float* p = A.out + (is_sample ? O_LCS : O_LCP) + (size_t)(sb * 3 + tl - 13) * 512 + c; *(f32x4*)p = x[3].lo; *(f32x4*)(p + 4) = x[3].hi; } }
        }
        asm volatile("" : "+v"(cl[0][ks].lo), "+v"(cl[0][ks].hi), "+v"(cl[1][ks].lo), "+v"(cl[1][ks].hi), "+v"(cl[2][ks].lo), "+v"(cl[2][ks].hi), "+v"(cl[3][ks].lo), "+v"(cl[3][ks].hi) :: "memory");
    }
    bf16x8 bfr[4][2];
#pragma unroll
    for (int m = 0; m < 4; ++m)
#pragma unroll
        for (int ks = 0; ks < 2; ++ks) bfr[m][ks] = __builtin_bit_cast(bf16x8, pack_bf16x8(cl[m][ks].lo, cl[m][ks].hi));
    const bool reset0 = !is_sample && ((ck & 63) == 0) && tl == 0;
#pragma unroll
    for (int ks = 0; ks < 2; ++ks) {
        f32x4 hv[4][2];
#pragma unroll
        for (int jj = 0; jj < 2; ++jj) {
            const int jt = 2 * ks + jj, c = cb + 32 * ks + 4 * jj;
            const bf16x8 ar0 = LDG(0, jt, 0), ar1 = LDG(0, jt, 1), ai0 = LDG(1, jt, 0), ai1 = LDG(1, jt, 1);
            const f32x4 ba4 = LDC(5, ks * 128 + jj * 16), bx4 = LDC(6, ks * 128 + jj * 16), sp4 = LDC(7, ks * 128 + jj * 16);
            f32x4 hc = {0.f, 0.f, 0.f, 0.f}, ac = {1.f, 1.f, 1.f, 1.f};
            if (fin) {
                if (is_sample) hc = *(const f32x4*)(A.st_lh + (size_t)sb * 512 + c);
                else {
                    f32x4 pa = {1.f, 1.f, 1.f, 1.f}, sa = {0.f, 0.f, 0.f, 0.f};
#pragma unroll
                    for (int u = 0; u < 4; ++u) { f32x4 pv = bld_f32x4(rS, vs, u * 4096 + (32 * ks + 4 * jj) * 4), sv = bld_f32x4(rS, vs, u * 4096 + 2048 + (32 * ks + 4 * jj) * 4);
                        if ((ck & ~63) + 4 * tl + u >= ck) { pv = (f32x4){1.f, 1.f, 1.f, 1.f}; sv = (f32x4){0.f, 0.f, 0.f, 0.f}; }
                        sa = pv * sa + sv; pa = pv * pa; }
                    scan16x4(pa, sa);
                    hc = (f32x4){bcast15(sa.x), bcast15(sa.y), bcast15(sa.z), bcast15(sa.w)};
                }
            }
            const f32x4 spl = sp4 * (-8.0f * 1.44269504089f), sp16 = sp4 * (-16.0f);
#pragma unroll
            for (int m = 0; m < 4; ++m) {
                f32x4 zr = {0.f, 0.f, 0.f, 0.f}, zi = {0.f, 0.f, 0.f, 0.f};
                zr = __builtin_amdgcn_mfma_f32_16x16x32_bf16(ar0, bfr[m][0], zr, 0, 0, 0); zr = __builtin_amdgcn_mfma_f32_16x16x32_bf16(ar1, bfr[m][1], zr, 0, 0, 0);
                zi = __builtin_amdgcn_mfma_f32_16x16x32_bf16(ai0, bfr[m][0], zi, 0, 0, 0); zi = __builtin_amdgcn_mfma_f32_16x16x32_bf16(ai1, bfr[m][1], zi, 0, 0, 0);
                const f32x4 clv = jj ? cl[m][ks].hi : cl[m][ks].lo;
                const f32x4 rr = rcpv(exp2v((zr + ba4) * (-1.44269504089f)) + 1.0f), ii = rcpv(exp2v((zi + bx4) * (-1.44269504089f)) + 1.0f);
                f32x4 a = exp2v(rr * spl); const f32x4 x2 = rr * sp16;
                f32x4 t = 1.0f - a * a; const f32x4 tp = -x2 * (1.0f + x2 * (0.5f + x2 * (1.0f / 6.0f)));
#pragma unroll
                for (int r = 0; r < 4; ++r) t[r] = x2[r] > -0.02f ? tp[r] : t[r];
                f32x4 mult = sqrtv(t);
                if (m == 0) { if (reset0) mult = (f32x4){1.f, 1.f, 1.f, 1.f}; }
                f32x4 b = mult * (ii * clv);
                scan16x4(a, b);
                const f32x4 h = a * hc + b; hv[m][jj] = h;
                hc = (f32x4){bcast15(h.x), bcast15(h.y), bcast15(h.z), bcast15(h.w)};
                if (!fin) ac = ac * (f32x4){bcast15(a.x), bcast15(a.y), bcast15(a.z), bcast15(a.w)};
            }
            if (fin) { if (lastc && tl == 15) *(f32x4*)(A.out + (is_sample ? O_LHS : O_LHP) + (size_t)sb * 512 + c) = hc; }
            else if (tl == 0) { __builtin_amdgcn_raw_buffer_store_b128(__builtin_bit_cast(v4u, ac), rS, cb * 4, ck * 4096 + (32 * ks + 4 * jj) * 4, 0); __builtin_amdgcn_raw_buffer_store_b128(__builtin_bit_cast(v4u, hc), rS, cb * 4, ck * 4096 + 2048 + (32 * ks + 4 * jj) * 4, 0); }
        }
        if (fin) {
#pragma unroll
            for (int m = 0; m < 4; ++m) {
                const f32x8 g = bld_bf16x8(rP, vb0, (16 * m * DIN + 2048 + 32 * ks) * 2);
                const f32x4 ol = hv[m][0] * g.lo * rcpv(exp2v((g.lo + 0.044715f * g.lo * g.lo * g.lo) * (-1.5957691216f * 1.44269504089f)) + 1.0f);
                const f32x4 oh = hv[m][1] * g.hi * rcpv(exp2v((g.hi + 0.044715f * g.hi * g.hi * g.hi) * (-1.5957691216f * 1.44269504089f)) + 1.0f);
                __builtin_amdgcn_raw_buffer_store_b128(pack_bf16x8(ol, oh), rM, mb0, (16 * m * D + 512 + 32 * ks) * 2, 0);
            }
        }
        MEMFENCE();
    }
    if (fin) {
#pragma unroll
        for (int ks = 0; ks < 2; ++ks) {
            const int c = cb + 32 * ks;
            f32x4 wl[3], wh[3];
#pragma unroll
            for (int k = 0; k < 3; ++k) { wl[k] = LDC(8 + k, ks * 128); wh[k] = LDC(8 + k, ks * 128 + 16); }
            v4u ow[4];
#pragma unroll
            for (int m = 0; m < 4; ++m) {
                f32x8 u[3];
#pragma unroll
                for (int k = 0; k < 3; ++k) {
                    if (m > 0 || k == 2) { const int so = ((16 * m - 2 + k) * DIN + 32 * ks) * 2; const f32x8 gc = bld_bf16x8(rP, vb0, so + 1024), xa = bld_bf16x8(rP, vb0, so + 2048); u[k].lo = gc.lo * xa.lo; u[k].hi = gc.hi * xa.hi; }
                    else { const int tk = tl - 2 + k;
                        if (!first || tk >= 0) { const int vo = vb0 - (2 - k) * DIN * 2; const f32x8 gc = bld_bf16x8(rP, vo, 32 * ks * 2 + 1024), xa = bld_bf16x8(rP, vo, 32 * ks * 2 + 2048); u[k].lo = gc.lo * xa.lo; u[k].hi = gc.hi * xa.hi; }
                        else if (is_sample) { const float* p = A.st_ca + (size_t)(sb * 2 + 2 + tk) * 512 + c; u[k].lo = *(const f32x4*)p; u[k].hi = *(const f32x4*)(p + 4); }
                        else { u[k].lo = (f32x4){0.f, 0.f, 0.f, 0.f}; u[k].hi = u[k].lo; } } }
                const f32x8 gb = bld_bf16x8(rP, vb0, (16 * m * DIN + 32 * ks) * 2);
                ow[m] = pack_bf16x8(gb.lo * (wl[0] * u[0].lo + wl[1] * u[1].lo + wl[2] * u[2].lo), gb.hi * (wh[0] * u[0].hi + wh[1] * u[1].hi + wh[2] * u[2].hi));
                if (m == 3) { if (lastc && tl >= 14) { float* p = A.out + (is_sample ? O_CAS : O_CAP) + (size_t)(sb * 2 + tl - 14) * 512 + c; *(f32x4*)p = u[2].lo; *(f32x4*)(p + 4) = u[2].hi; } }
            }
#pragma unroll
            for (int m = 0; m < 4; ++m) __builtin_amdgcn_raw_buffer_store_b128(ow[m], rM, mb0, (16 * m * D + 32 * ks) * 2, 0);
            MEMFENCE();
        }
    }
#undef LDC
#undef LDG
}
constexpr int N_PHASES = 8;
__global__ void __launch_bounds__(NWAVES * 64, 2) fwd_kernel(Args args) {
    extern __shared__ __attribute__((aligned(16))) unsigned char lds_raw[];
    LAS unsigned char* lds = (LAS unsigned char*)lds_raw;
    const int tid = threadIdx.x, lane = tid & 63, wave = __builtin_amdgcn_readfirstlane(tid >> 6);
    const int G = gridDim.x, bx = blockIdx.x, vcu = (G % 8 == 0) ? (bx % 8) * (G / 8) + bx / 8 : bx;
    const int gw = vcu * NWAVES + wave, NGW = G * NWAVES;
    unsigned char* ws = args.ws;
#if MK_MODE == 2
    volatile LAS unsigned* MISC = (volatile LAS unsigned*)(lds + MISC_OFF);
    for (int u = tid; u < (LDS_BYTES - LDSCTL_OFF) / 4; u += NWAVES * 64) ((LAS unsigned*)(lds + LDSCTL_OFF))[u] = 0u;
    __syncthreads();
    XcdBarrier bar = xcd_barrier_post((unsigned*)(ws + WS_CTL) + CW_BAR, MISC + 8);
#define GRID_BAR() xcd_barrier(bar)
#elif MK_MODE == 0
    cg::grid_group grid = cg::this_grid();
#define GRID_BAR() grid.sync()
#else
#define GRID_BAR() do {} while (0)
#endif
    const int lo = args.ph_lo, hi = args.ph_hi;
#ifndef PH_MASK
#define PH_MASK 0xff
#endif
#define IN(k) (((PH_MASK >> (k)) & 1) && lo <= (k) && (k) < hi)
#define SEAM(k) do { if (IN(k) && IN((k) + 1)) GRID_BAR(); } while (0)

#ifndef PH_REP
#define PH_REP 0
#endif
#define REPS(k) (1 + ((PH_REP >> (k)) & 1))
    if (IN(0)) for (int rep = 0; rep < REPS(0); ++rep) { if (rep) GRID_BAR(); p0_prologue(args, lds, gw, NGW, wave, lane); }
    SEAM(0);
    if (IN(1)) for (int rep = 0; rep < REPS(1); ++rep) {
        if (rep) GRID_BAR();
        pg8::Gemm g{(const bf16*)(ws + WS_XN), (const bf16*)(ws + WS_WIN), M, DIN, D, D, 1}; pg8::StaticOrder S; S.init(M, DIN, G, bx);
        pg8::EpiProj E{(bf16*)(ws + WS_PROJ), DIN};
        pg8::gemm_phase<pg8::EpiProj, pg8::StaticOrder, PG8_ALIGN, PG8_SP2>(lds + RING_OFF, g, S, E);
    }
    SEAM(1);
    const rsrc_t rP = __builtin_amdgcn_make_buffer_rsrc((void*)(ws + WS_PROJ), 0, (int)((size_t)M * DIN * 2), 0x00020000), rM = __builtin_amdgcn_make_buffer_rsrc((void*)(ws + WS_MIX), 0, (int)((size_t)M * D * 2), 0x00020000),
        rC = __builtin_amdgcn_make_buffer_rsrc((void*)(ws + WS_GW), 0, 131072 + 8 * 2816, 0x00020000), rS = __builtin_amdgcn_make_buffer_rsrc((void*)(ws + WS_SUM), 0, NPCHUNK * 4096, 0x00020000);
    if (IN(2)) for (int rep = 0; rep < REPS(2); ++rep) { if (rep) GRID_BAR(); for (int it = gw; it < NPCHUNK * 8; it += NGW) mix_item<false>(args, rP, rM, rC, rS, it >> 3, it & 7, lane); }
    SEAM(2);
    if (IN(3)) for (int rep = 0; rep < REPS(3); ++rep) { if (rep) GRID_BAR();
        const bool g256 = (G == 256); const int n3 = g256 ? ((wave == (bx & 7)) ? 2 : 1) : NCHUNK * 8;
        for (int k = 0; k < n3; ++k) { const int it = g256 ? (k == 0 ? gw : 2048 + vcu) : gw + k * NGW; if (it >= NCHUNK * 8) break; mix_item<true>(args, rP, rM, rC, rS, it >> 3, it & 7, lane); } }
    SEAM(3);
    if (IN(4)) for (int rep = 0; rep < REPS(4); ++rep) {
        if (rep) GRID_BAR();
        pg8::Gemm g{(const bf16*)(ws + WS_MIX), (const bf16*)(ws + WS_WOUT), M, D, D, D, 1}; pg8::StaticOrder S; S.init(M, D, G, bx);
        pg8::EpiX1 E{args.xp, args.xs, (bf16*)(ws + WS_X1B), (float*)(ws + WS_SS)};
        pg8::gemm_phase<pg8::EpiX1, pg8::StaticOrder, PG8_ALIGN, PG8_SP2>(lds + RING_OFF, g, S, E);
    }
    SEAM(4);
    if (IN(5)) for (int rep = 0; rep < REPS(5); ++rep) {
        if (rep) GRID_BAR();
        pg8::Gemm g{(const bf16*)(ws + WS_X1B), (const bf16*)(ws + WS_WUP), M, FF, D, D, 1}; pg8::StaticOrder S; S.init(M, FF, G, bx);
        pg8::EpiUp E{(bf16*)(ws + WS_H), (const float*)(ws + WS_SS), EPS};
        pg8::gemm_phase<pg8::EpiUp, pg8::StaticOrder, PG8_ALIGN, PG8_SP2>(lds + RING_OFF, g, S, E);
    }
    SEAM(5);
    if (IN(6)) {
        { pg8::Gemm g{(const bf16*)(ws + WS_H), (const bf16*)(ws + WS_WDN), MP, D, FF, FF, 1}; pg8::StaticOrder S; S.init(MP, D, G, bx);
          pg8::EpiDown E{args.out, (const bf16*)(ws + WS_X1B)};
          pg8::gemm_phase<pg8::EpiDown, pg8::StaticOrder, PG8_ALIGN, PG8_SP2>(lds + RING_OFF, g, S, E); }
        { pg8::Gemm g{(const bf16*)(ws + WS_H) + (size_t)MP * FF, (const bf16*)(ws + WS_WDN), MS, D, FF / KSPLIT, FF, KSPLIT}; pg8::StaticOrder S; S.init(MS, D, G, bx, KSPLIT);
          pg8::EpiSlab E{(float*)(ws + WS_SLAB), MS};
          pg8::gemm_phase<pg8::EpiSlab, pg8::StaticOrder, PG8_ALIGN, PG8_SP2>(lds + RING_OFF, g, S, E); }
    }
    SEAM(6);
    if (IN(7)) { for (int m = gw; m < M; m += NGW) rms_row_final(args.out + (size_t)m * D, m < MP ? nullptr : (const bf16*)(ws + WS_X1B) + (size_t)m * D, (const float*)(ws + WS_SLAB) + (size_t)(m < MP ? 0 : m - MP) * D, args.gf, lane); }
#undef IN
#undef SEAM
}

extern "C" void kernel_launch(void* const* d_in, const int* in_sizes, int n_in, void* d_out, int out_size, void* d_ws, size_t ws_size, hipStream_t stream) {
    static int grid = 0;
    if (grid == 0) {
        if (n_in != 20 || out_size != (int)O_END || ws_size < WS_END) { fprintf(stderr, "kernel_launch: unexpected shapes (n_in %d out %d ws %zu)\n", n_in, out_size, ws_size); grid = -1; return; }
        int dev = 0, cus = 0, per_cu = 0;
        if (hipGetDevice(&dev) != hipSuccess || hipDeviceGetAttribute(&cus, hipDeviceAttributeMultiprocessorCount, dev) != hipSuccess) { grid = -1; return; }
        if (hipFuncSetAttribute((const void*)fwd_kernel, hipFuncAttributeMaxDynamicSharedMemorySize, LDS_BYTES) != hipSuccess) { fprintf(stderr, "kernel_launch: hipFuncSetAttribute failed\n"); grid = -1; return; }
        if (hipOccupancyMaxActiveBlocksPerMultiprocessor(&per_cu, (const void*)fwd_kernel, NWAVES * 64, LDS_BYTES) != hipSuccess || per_cu < 1) { fprintf(stderr, "kernel_launch: occupancy query says %d blocks per CU\n", per_cu); per_cu = 1; }
        (void)hipGetLastError();
        grid = cus;
    }
    if (grid < 0) return;
    Args a{};
    a.xp = (const float*)d_in[0]; a.xs = (const float*)d_in[1]; a.st_ca = (const float*)d_in[2]; a.st_lc = (const float*)d_in[3]; a.st_lh = (const float*)d_in[4]; a.g1 = (const float*)d_in[5];
    a.w_in = (const float*)d_in[6]; a.conv_a_w = (const float*)d_in[7]; a.lru_conv_w = (const float*)d_in[8]; a.lru_conv_b = (const float*)d_in[9]; a.lru_wa = (const float*)d_in[10];
    a.lru_ba = (const float*)d_in[11]; a.lru_wx = (const float*)d_in[12]; a.lru_bx = (const float*)d_in[13]; a.lru_a_param = (const float*)d_in[14]; a.w_out = (const float*)d_in[15];
    a.g2 = (const float*)d_in[16]; a.w_up = (const float*)d_in[17]; a.w_down = (const float*)d_in[18]; a.gf = (const float*)d_in[19]; a.out = (float*)d_out; a.ws = (unsigned char*)d_ws;
#if MK_MODE == 1
    for (int p = 0; p < N_PHASES; ++p) { a.ph_lo = p; a.ph_hi = p + 1; hipLaunchKernelGGL(fwd_kernel, dim3(grid), dim3(NWAVES * 64), LDS_BYTES, stream, a); }
#elif MK_MODE == 0
    a.ph_lo = 0; a.ph_hi = N_PHASES;
    void* kargs[] = {&a};
    hipError_t e = hipLaunchCooperativeKernel((const void*)fwd_kernel, dim3(grid), dim3(NWAVES * 64), kargs, LDS_BYTES, stream);
    if (e != hipSuccess) fprintf(stderr, "kernel_launch: cooperative launch failed: %s (grid %d)\n", hipGetErrorString(e), grid);
#else
    if (hipMemsetAsync((char*)d_ws + WS_CTL, 0, CTL_ZERO_BYTES, stream) != hipSuccess) { fprintf(stderr, "kernel_launch: memset failed\n"); return; }
    a.ph_lo = 0; a.ph_hi = N_PHASES;
    hipLaunchKernelGGL(fwd_kernel, dim3(grid), dim3(NWAVES * 64), LDS_BYTES, stream, a);
#endif
    const hipError_t le = hipPeekAtLastError();
    if (le != hipSuccess) fprintf(stderr, "kernel_launch: launch failed: %s\n", hipGetErrorName(le));
}
```

```cpp
#include <hip/hip_runtime.h>
#include <hip/hip_cooperative_groups.h>
#include <cstdio>
#include <cstdint>
namespace cg = cooperative_groups;
#ifndef MK_MODE
#define MK_MODE 2
#endif
namespace pg8 {
#define PG8_LAS __attribute__((address_space(3)))
typedef unsigned short bf16_t;
typedef short bf16x8 __attribute__((ext_vector_type(8)));
typedef float f32x4 __attribute__((ext_vector_type(4)));
typedef unsigned u32x4 __attribute__((ext_vector_type(4)));
constexpr int BM = 256, BK = 64, HALF = 128, HTB = HALF * BK * 2  , STAGE_BYTES = 8 * HTB, NXCD = 8, WGM = 8;

__host__ __device__ __forceinline__ int lds_byte(int r, int c) { const int st = (r >> 4) * 2 + (c >> 5), rr = r & 15, cc = c & 31, ob = rr * 64 + cc * 2; return st * 1024 + (ob ^ (((ob >> 9) & 1) << 5)); }
__host__ __device__ __forceinline__ void stage_rc(int b, int& R, int& C) { const int st = b / 1024, sb = b % 1024, swz = sb ^ (((sb >> 9) & 1) << 5); R = (st >> 1) * 16 + swz / 64; C = (st & 1) * 32 + (swz % 64) / 2; }
__host__ __device__ __forceinline__ int perm32(int rho) { const int n = rho >> 4, i = rho & 15; return 8 * (i >> 2) + 4 * n + (i & 3); }

struct Unit { int pm, pn, ks; };
struct Gemm { const bf16_t* A; const bf16_t* Bt; int M, N, K, ld, nsl; };

struct StaticOrder {
    int nM, nN, nwg, G, c, nNr;
    __host__ __device__ void init(int M, int N, int G_, int c_, int nsl = 1) { nM = M / BM; nNr = N / BM; nN = nNr * nsl; nwg = nM * nN; G = G_; c = c_; }
    __host__ __device__ bool next(int i, Unit& u) const {
        const long L = (long)i * G + c; if (L >= nwg) return false;
        int wgid = (int)L; { const int q = nwg / NXCD, r = nwg % NXCD, xcd = wgid % NXCD, off = wgid / NXCD; wgid = (xcd < r ? xcd * (q + 1) : r * (q + 1) + (xcd - r) * q) + off; }
        const int nig = WGM * nN, gid = wgid / nig, fm = gid * WGM, gsz = (nM - fm) < WGM ? (nM - fm) : WGM;
        u.pm = fm + ((wgid % nig) % gsz); const int pq = (wgid % nig) / gsz; u.ks = pq / nNr; u.pn = pq % nNr; return true;
    }
    __device__ __forceinline__ void a_ready(const Unit&) const {}
    __device__ __forceinline__ void done(const Unit&) const {}
};

__device__ __forceinline__ unsigned cvt_pk_bf16(float lo, float hi) { unsigned r; asm volatile("v_cvt_pk_bf16_f32 %0, %1, %2" : "=v"(r) : "v"(lo), "v"(hi)); return r; }
typedef float f32x2 __attribute__((ext_vector_type(2)));
__device__ __forceinline__ f32x2 gelu_pk(f32x2 v) {
    const f32x2 av = __builtin_elementwise_abs(v), d = av * 0.2316418882f + 1.0f;
    f32x2 t; t.x = __builtin_amdgcn_rcpf(d.x); t.y = __builtin_amdgcn_rcpf(d.y);
    f32x2 q = t * 0.5307027145f + (-0.7265760135f); q = q * t + 0.7107068705f; q = q * t + (-0.142248368f); q = q * t + 0.127414796f; q = q * t;
    const f32x2 s = (v * v) * (-0.72134752044f);
    f32x2 e; e.x = __builtin_amdgcn_exp2f(s.x); e.y = __builtin_amdgcn_exp2f(s.y);
    const f32x2 m = v * (q * e), r = v - m;
    f32x2 o; o.x = v.x < 0.f ? m.x : r.x; o.y = v.y < 0.f ? m.y : r.y; return o;
}

typedef unsigned u32x2 __attribute__((ext_vector_type(2)));
struct EpiProj {
    static constexpr bool PERM = true, AFTER_DRAIN = false;
    bf16_t* O; int ldc;
    __device__ __forceinline__ void operator()(const f32x4 (&acc)[2][2][4][2], const Unit& u, int wr, int wc, int fr, int fq) const {
        const int row0 = u.pm * BM + wr * 64 + fr, col0 = u.pn * BM + wc * 32 + 8 * fq;
#pragma unroll
        for (int ai = 0; ai < 2; ++ai)
#pragma unroll
            for (int m = 0; m < 4; ++m) { bf16_t* rowp = O + (size_t)(row0 + ai * HALF + m * 16) * ldc + col0;
#pragma unroll
                for (int bj = 0; bj < 2; ++bj) { const f32x4 v0 = acc[ai][bj][m][0], v1 = acc[ai][bj][m][1];
                    u32x4 w; w.x = cvt_pk_bf16(v0[0], v0[1]); w.y = cvt_pk_bf16(v0[2], v0[3]); w.z = cvt_pk_bf16(v1[0], v1[1]); w.w = cvt_pk_bf16(v1[2], v1[3]);
                    *(u32x4*)(rowp + bj * HALF) = w; } }
    }
};
struct EpiX1 {
    static constexpr bool PERM = false, AFTER_DRAIN = false;
    const float* xp; const float* xs; bf16_t* x1b; float* ss;
    __device__ __forceinline__ void operator()(const f32x4 (&acc)[2][2][4][2], const Unit& u, int wr, int wc, int fr, int fq) const {
        const int row0 = u.pm * BM + wr * 64 + fr, col0 = u.pn * BM + wc * 32 + 4 * fq;
        const float* xin = (u.pm < 64) ? xp : xs - (size_t)16384 * 1024;
#pragma unroll
        for (int ai = 0; ai < 2; ++ai)
#pragma unroll
            for (int m = 0; m < 4; ++m) { const size_t off = (size_t)(row0 + ai * HALF + m * 16) * 1024 + col0; float s = 0.f;
#pragma unroll
                for (int bj = 0; bj < 2; ++bj)
#pragma unroll
                    for (int n = 0; n < 2; ++n) { const size_t o = off + bj * HALF + n * 16; const f32x4 v = *(const f32x4*)(xin + o) + acc[ai][bj][m][n];
                        u32x2 w; w.x = cvt_pk_bf16(v[0], v[1]); w.y = cvt_pk_bf16(v[2], v[3]); *(u32x2*)(x1b + o) = w;
                        s += (v[0] * v[0] + v[1] * v[1]) + (v[2] * v[2] + v[3] * v[3]); }
                s += __shfl_xor(s, 16); s += __shfl_xor(s, 32);
                if (fq == 0) ss[(size_t)(row0 + ai * HALF + m * 16) * 16 + u.pn * 4 + wc] = s; }
    }
};
struct EpiUp {
    static constexpr bool PERM = true, AFTER_DRAIN = false;
    bf16_t* H; const float* ss; float eps;
    __device__ __forceinline__ void operator()(const f32x4 (&acc)[2][2][4][2], const Unit& u, int wr, int wc, int fr, int fq) const {
        const int row0 = u.pm * BM + wr * 64 + fr, col0 = u.pn * BM + wc * 32 + 8 * fq;
#pragma unroll
        for (int ai = 0; ai < 2; ++ai)
#pragma unroll
            for (int m = 0; m < 4; ++m) { const int r = row0 + ai * HALF + m * 16; const f32x4* sp = (const f32x4*)(ss + (size_t)r * 16);
                const f32x4 t = (sp[0] + sp[1]) + (sp[2] + sp[3]); const float rs2 = 1.0f / (((t[0] + t[1]) + (t[2] + t[3])) * (1.0f / 1024.0f) + eps);
                bf16_t* rowp = H + (size_t)r * 4096 + col0;
#pragma unroll
                for (int bj = 0; bj < 2; ++bj) { f32x4 v0 = acc[ai][bj][m][0], v1 = acc[ai][bj][m][1];
#pragma unroll
                    for (int j = 0; j < 4; ++j) { const float a = fmaxf(v0[j], 0.f), b = fmaxf(v1[j], 0.f); v0[j] = a * a * rs2; v1[j] = b * b * rs2; }
                    u32x4 w; w.x = cvt_pk_bf16(v0[0], v0[1]); w.y = cvt_pk_bf16(v0[2], v0[3]); w.z = cvt_pk_bf16(v1[0], v1[1]); w.w = cvt_pk_bf16(v1[2], v1[3]);
                    *(u32x4*)(rowp + bj * HALF) = w; } }
    }
};
struct EpiDown {
    static constexpr bool PERM = false, AFTER_DRAIN = false;
    float* out; const bf16_t* x1b;
    __device__ __forceinline__ void operator()(const f32x4 (&acc)[2][2][4][2], const Unit& u, int wr, int wc, int fr, int fq) const {
        const int row0 = u.pm * BM + wr * 64 + fr, col0 = u.pn * BM + wc * 32 + 4 * fq;
#pragma unroll
        for (int ai = 0; ai < 2; ++ai)
#pragma unroll
            for (int m = 0; m < 4; ++m) { const size_t off = (size_t)(row0 + ai * HALF + m * 16) * 1024 + col0;
#pragma unroll
                for (int bj = 0; bj < 2; ++bj)
#pragma unroll
                    for (int n = 0; n < 2; ++n) { const size_t o = off + bj * HALF + n * 16; const u32x2 w = *(const u32x2*)(x1b + o);
                        f32x4 v; v[0] = __uint_as_float(w.x << 16); v[1] = __uint_as_float(w.x & 0xffff0000u); v[2] = __uint_as_float(w.y << 16); v[3] = __uint_as_float(w.y & 0xffff0000u);
                        *(f32x4*)(out + o) = v + acc[ai][bj][m][n]; } }
    }
};
struct EpiSlab {
    static constexpr bool PERM = false, AFTER_DRAIN = false;
    float* slab; int rows;
    __device__ __forceinline__ void operator()(const f32x4 (&acc)[2][2][4][2], const Unit& u, int wr, int wc, int fr, int fq) const {
        const int row0 = u.pm * BM + wr * 64 + fr, col0 = u.pn * BM + wc * 32 + 4 * fq;
#pragma unroll
        for (int ai = 0; ai < 2; ++ai)
#pragma unroll
            for (int m = 0; m < 4; ++m) { float* rowp = slab + ((size_t)u.ks * rows + row0 + ai * HALF + m * 16) * 1024 + col0;
#pragma unroll
                for (int bj = 0; bj < 2; ++bj)
#pragma unroll
                    for (int n = 0; n < 2; ++n) *(f32x4*)(rowp + bj * HALF + n * 16) = acc[ai][bj][m][n]; }
    }
};

template <class Epi, class Sched, bool ALIGN_EPI = false, bool SP2 = false>
__device__ __forceinline__ void gemm_phase(PG8_LAS unsigned char* lds, const Gemm g, const Sched& S, const Epi& E) {
    const int tid = threadIdx.x, wid = __builtin_amdgcn_readfirstlane(tid >> 6), lane = tid & 63, wr = wid >> 2, wc = wid & 3, fr = lane & 15, fq = lane >> 4;
    const int K = g.K, nt = K / BK, LD = g.ld;
    unsigned voffA[2], voffB[2];
#pragma unroll
    for (int i = 0; i < 2; ++i) { int R, C; stage_rc(tid * 16 + i * 8192, R, C); const int Rb = Epi::PERM ? ((R & ~31) + perm32(R & 31)) : R;
        voffA[i] = (unsigned)(R * LD + C) * 2u; voffB[i] = (unsigned)(Rb * LD + C) * 2u; }
    const size_t kstep = (size_t)(BK * 2);
    const size_t hstep = (size_t)HALF * LD * 2, sstep = (size_t)K * 2;
    const size_t tstep = 2 * hstep;
    const unsigned ldsw = (unsigned)wid * 1024u;
    const int aoff = lds_byte(wr * 64 + fr, fq * 8), boff = lds_byte(wc * 32 + fr, fq * 8);
#define PG8_SA(b, h) (((b) * 2 + (h)) * HTB)
#define PG8_SB(b, h) ((4 + (b) * 2 + (h)) * HTB)
#define PG8_STAGE(bufoff, gbase, voff) do { _Pragma("unroll") for (int _i = 0; _i < 2; ++_i) \
        __builtin_amdgcn_global_load_lds((const unsigned*)((const char*)(gbase) + (voff)[_i]), (PG8_LAS unsigned*)(lds + (bufoff) + ldsw + _i * 8192), 16, 0, 0); } while (0)
#define PG8_LDA(dst, b, h) do { _Pragma("unroll") for (int m = 0; m < 4; ++m) _Pragma("unroll") for (int k = 0; k < 2; ++k) dst[m][k] = *(const PG8_LAS bf16x8*)(lds + PG8_SA(b, h) + aoff + m * 2048 + k * 1024); } while (0)
#define PG8_LDB(dst, b, h) do { _Pragma("unroll") for (int n = 0; n < 2; ++n) _Pragma("unroll") for (int k = 0; k < 2; ++k) dst[n][k] = *(const PG8_LAS bf16x8*)(lds + PG8_SB(b, h) + boff + n * 2048 + k * 1024); } while (0)
#define PG8_MMA(ai, bj, At, Bt) do { __builtin_amdgcn_s_setprio(1); _Pragma("unroll") for (int m = 0; m < 4; ++m) _Pragma("unroll") for (int n = 0; n < 2; ++n) _Pragma("unroll") for (int k = 0; k < 2; ++k) \
        acc[ai][bj][m][n] = __builtin_amdgcn_mfma_f32_16x16x32_bf16(Bt[n][k], At[m][k], acc[ai][bj][m][n], 0, 0, 0); __builtin_amdgcn_s_setprio(0); } while (0)
#define PG8_WAIT_V(n) asm volatile("s_waitcnt vmcnt(" #n ")" ::: "memory")
#define PG8_WAIT_L(n) asm volatile("s_waitcnt lgkmcnt(" #n ")" ::: "memory")
#define PG8_BAR __builtin_amdgcn_s_barrier()
#define PG8_SCHED __builtin_amdgcn_sched_barrier(0)
    Unit cur, nxt; int ui = 0;
    if (!S.next(0, cur)) return;
    f32x4 acc[2][2][4][2];
#pragma unroll
    for (int a = 0; a < 2; ++a)
#pragma unroll
        for (int b = 0; b < 2; ++b)
#pragma unroll
            for (int m = 0; m < 4; ++m)
#pragma unroll
                for (int n = 0; n < 2; ++n) acc[a][b][m][n] = (f32x4){0.f, 0.f, 0.f, 0.f};
    bf16x8 At[4][2], B0[2][2], B1[2][2];
    const char* cA = (const char*)g.A + (size_t)cur.pm * tstep + (size_t)cur.ks * sstep; const char* cB = (const char*)g.Bt + (size_t)cur.pn * tstep + (size_t)cur.ks * sstep;
    S.a_ready(cur);
    if constexpr (SP2) {
        PG8_STAGE(PG8_SB(0, 0), cB, voffB); PG8_STAGE(PG8_SB(0, 1), cB + hstep, voffB); PG8_STAGE(PG8_SA(0, 0), cA, voffA); PG8_STAGE(PG8_SA(0, 1), cA + hstep, voffA);
        if (wr == 1) PG8_BAR;
        PG8_WAIT_V(2); PG8_BAR;
        PG8_STAGE(PG8_SB(1, 0), cB + kstep, voffB); PG8_STAGE(PG8_SA(1, 0), cA + kstep, voffA); PG8_STAGE(PG8_SB(1, 1), cB + hstep + kstep, voffB);
        PG8_WAIT_V(6); PG8_BAR;
    } else {
        PG8_STAGE(PG8_SB(0, 0), cB, voffB); PG8_STAGE(PG8_SA(0, 0), cA, voffA); PG8_STAGE(PG8_SB(0, 1), cB + hstep, voffB); PG8_STAGE(PG8_SA(0, 1), cA + hstep, voffA);
        if (wr == 1) PG8_BAR;
        PG8_WAIT_V(4); PG8_BAR;
        PG8_STAGE(PG8_SB(1, 0), cB + kstep, voffB); PG8_STAGE(PG8_SA(1, 0), cA + kstep, voffA); PG8_STAGE(PG8_SB(1, 1), cB + hstep + kstep, voffB);
        PG8_WAIT_V(6); PG8_BAR;
    }
    for (;;) {
        const bool has_next = S.next(ui + 1, nxt);
        const char* nA = has_next ? (const char*)g.A + (size_t)nxt.pm * tstep + (size_t)nxt.ks * sstep : cA; const char* nB = has_next ? (const char*)g.Bt + (size_t)nxt.pn * tstep + (size_t)nxt.ks * sstep : cB;
        for (int t = 0; t < nt; t += 2) {
            const bool last = (t == nt - 2);
            const char* a1 = cA + (size_t)(t + 1) * kstep;
            const char* a2 = last ? nA : cA + (size_t)(t + 2) * kstep; const char* b2 = last ? nB : cB + (size_t)(t + 2) * kstep;
            const char* a3 = a2 + kstep; const char* b3 = b2 + kstep;
            if (last && has_next) S.a_ready(nxt);
            if constexpr (SP2) {
            PG8_LDB(B0, 0, 0); PG8_LDB(B1, 0, 1); PG8_SCHED; PG8_LDA(At, 0, 0); PG8_STAGE(PG8_SA(1, 1), a1 + hstep, voffA);
            PG8_WAIT_V(8); PG8_WAIT_L(0); PG8_BAR; PG8_MMA(0, 0, At, B0); PG8_MMA(0, 1, At, B1); PG8_BAR; PG8_SCHED;
            PG8_LDA(At, 0, 1); PG8_STAGE(PG8_SB(0, 0), b2, voffB); PG8_STAGE(PG8_SB(0, 1), b2 + hstep, voffB); PG8_STAGE(PG8_SA(0, 0), a2, voffA);
            PG8_WAIT_V(8); PG8_WAIT_L(0); PG8_BAR; PG8_MMA(1, 0, At, B0); PG8_MMA(1, 1, At, B1); PG8_BAR; PG8_SCHED;
            PG8_LDB(B0, 1, 0); PG8_LDB(B1, 1, 1); PG8_SCHED; PG8_LDA(At, 1, 0); PG8_STAGE(PG8_SA(0, 1), a2 + hstep, voffA);
            PG8_WAIT_V(8); PG8_WAIT_L(0); PG8_BAR; PG8_MMA(0, 0, At, B0); PG8_MMA(0, 1, At, B1); PG8_BAR; PG8_SCHED;
            PG8_LDA(At, 1, 1); PG8_STAGE(PG8_SB(1, 0), b3, voffB); PG8_STAGE(PG8_SB(1, 1), b3 + hstep, voffB); PG8_STAGE(PG8_SA(1, 0), a3, voffA);
            PG8_WAIT_V(8); PG8_WAIT_L(0); PG8_BAR; PG8_MMA(1, 0, At, B0); PG8_MMA(1, 1, At, B1); PG8_BAR; PG8_SCHED;
            } else {
            PG8_LDB(B0, 0, 0); PG8_SCHED; PG8_LDA(At, 0, 0); PG8_STAGE(PG8_SA(1, 1), a1 + hstep, voffA);
            PG8_WAIT_L(8); PG8_BAR; PG8_WAIT_L(0); PG8_MMA(0, 0, At, B0); PG8_BAR; PG8_SCHED;
            PG8_LDB(B1, 0, 1); PG8_STAGE(PG8_SB(0, 0), b2, voffB);
            PG8_BAR; PG8_WAIT_L(0); PG8_MMA(0, 1, At, B1); PG8_BAR;
            PG8_LDA(At, 0, 1); PG8_STAGE(PG8_SA(0, 0), a2, voffA);
            PG8_BAR; PG8_WAIT_L(0); PG8_MMA(1, 0, At, B0); PG8_BAR; PG8_SCHED;
            PG8_STAGE(PG8_SB(0, 1), b2 + hstep, voffB);
            PG8_WAIT_V(6); PG8_BAR; PG8_MMA(1, 1, At, B1); PG8_BAR;
            PG8_LDB(B0, 1, 0); PG8_SCHED; PG8_LDA(At, 1, 0); PG8_STAGE(PG8_SA(0, 1), a2 + hstep, voffA);
            PG8_WAIT_L(8); PG8_BAR; PG8_WAIT_L(0); PG8_MMA(0, 0, At, B0); PG8_BAR; PG8_SCHED;
            PG8_LDB(B1, 1, 1); PG8_STAGE(PG8_SB(1, 0), b3, voffB);
            PG8_BAR; PG8_WAIT_L(0); PG8_MMA(0, 1, At, B1); PG8_BAR;
            PG8_LDA(At, 1, 1); PG8_STAGE(PG8_SA(1, 0), a3, voffA);
            PG8_BAR; PG8_WAIT_L(0); PG8_MMA(1, 0, At, B0); PG8_BAR; PG8_SCHED;
            PG8_STAGE(PG8_SB(1, 1), b3 + hstep, voffB);
            PG8_WAIT_V(6); PG8_BAR; PG8_MMA(1, 1, At, B1); PG8_BAR;
            }
        }
        if constexpr (ALIGN_EPI) { if (wr == 0) PG8_BAR; }
        if constexpr (!Epi::AFTER_DRAIN) { E(acc, cur, wr, wc, fr, fq); S.done(cur); }
        if (!has_next) break;
#pragma unroll
        for (int a = 0; a < 2; ++a)
#pragma unroll
            for (int b = 0; b < 2; ++b)
#pragma unroll
                for (int m = 0; m < 4; ++m)
#pragma unroll
                    for (int n = 0; n < 2; ++n) acc[a][b][m][n] = (f32x4){0.f, 0.f, 0.f, 0.f};
        cur = nxt; cA = nA; cB = nB; ++ui;
        if constexpr (ALIGN_EPI) { if (wr == 1) PG8_BAR; }
    }
    PG8_WAIT_V(0);
    if constexpr (!ALIGN_EPI) { if (wr == 0) PG8_BAR; }
    PG8_BAR;
    if constexpr (Epi::AFTER_DRAIN) { E.fused(acc, cur, wr, wc, fr, fq, lds, wid, lane); S.done(cur); }
#undef PG8_SA
#undef PG8_SB
#undef PG8_STAGE
#undef PG8_LDA
#undef PG8_LDB
#undef PG8_MMA
#undef PG8_WAIT_V
#undef PG8_WAIT_L
#undef PG8_BAR
#undef PG8_SCHED
}
}
#ifndef PG8_SP2
#define PG8_SP2 true
#endif
#ifndef PG8_ALIGN
#define PG8_ALIGN true
#endif
constexpr int NWAVES = 8;
constexpr int D = 1024, DIN = 2560, FF = 4096, DC = 512, DL = 512;
constexpr int MP = 4 * 4096, MS = 32 * 64, M = MP + MS;
constexpr int NCHUNK = M / 64, NPCHUNK = MP / 64;
constexpr float EPS = 1e-6f;
constexpr size_t O_YP = 0, O_YS = (size_t)MP * D, O_CAP = (size_t)M * D, O_LCP = O_CAP + 4 * 2 * 512, O_LHP = O_LCP + 4 * 3 * 512, O_CAS = O_LHP + 4 * 512, O_LCS = O_CAS + 32 * 2 * 512, O_LHS = O_LCS + 32 * 3 * 512, O_END = O_LHS + 32 * 512;
constexpr size_t MiB = 1u << 20;
constexpr size_t WS_CTL = 0, CTL_ZERO_BYTES = 1 * MiB;
constexpr size_t WS_WIN = 2 * MiB, WS_WOUT = 8 * MiB, WS_WUP = 10 * MiB, WS_WDN = 18 * MiB;
constexpr size_t WS_GW = 26 * MiB;
constexpr size_t WS_HC = WS_GW + 131072;
constexpr size_t WS_SS = 27 * MiB;
constexpr size_t WS_SUM = 29 * MiB;
constexpr size_t WS_XN = 32 * MiB;
constexpr size_t WS_H = 68 * MiB;
constexpr size_t WS_PROJ = 68 * MiB;
constexpr size_t WS_MIX = 160 * MiB;
constexpr size_t WS_X1B = 212 * MiB;
constexpr int KSPLIT = 4;
constexpr size_t WS_SLAB = WS_XN;
constexpr size_t WS_END = 248 * MiB;
static_assert(WS_XN + (size_t)M * D * 2 <= WS_H && WS_PROJ + (size_t)M * DIN * 2 <= WS_MIX && WS_MIX + (size_t)M * D * 2 <= WS_X1B && WS_H + (size_t)M * FF * 2 <= WS_X1B && WS_X1B + (size_t)M * D * 2 <= WS_END && WS_SLAB + (size_t)KSPLIT * MS * D * 4 <= WS_H, "d_ws map");
static_assert(WS_SS + (size_t)M * 16 * 4 <= WS_SUM && WS_SUM + (size_t)NPCHUNK * 2 * 512 * 4 <= WS_XN, "d_ws map (small)");
constexpr int CW_BAR = 4096;
constexpr int RING_OFF = 0, RING_BYTES = 131072;
constexpr int LDSCTL_OFF = RING_BYTES, MISC_OFF = LDSCTL_OFF + 320;
constexpr int LDS_BYTES = 147456;
#define GAS __attribute__((address_space(1)))
#define LAS __attribute__((address_space(3)))
typedef unsigned short bf16;
typedef unsigned v4u __attribute__((ext_vector_type(4)));
typedef unsigned v2u __attribute__((ext_vector_type(2)));
typedef float f32x4 __attribute__((ext_vector_type(4)));
typedef short bf16x8 __attribute__((ext_vector_type(8)));
typedef GAS unsigned gu32;
#define RLX_AGENT __ATOMIC_RELAXED, __HIP_MEMORY_SCOPE_AGENT
#define LDS_WAIT() asm volatile("s_waitcnt lgkmcnt(0)" ::: "memory")
#define VM_WAIT() asm volatile("s_waitcnt vmcnt(0)" ::: "memory")
__device__ __forceinline__ unsigned f2bf(float f) { unsigned u = __builtin_bit_cast(unsigned, f); return (u + 0x7fffu + ((u >> 16) & 1u)) >> 16; }
__device__ __forceinline__ unsigned pk2(float lo, float hi) { return f2bf(lo) | (f2bf(hi) << 16); }
__device__ __forceinline__ f32x4 ld_bf16x4(const bf16* p) { const v2u w = *(const v2u*)p; f32x4 r; r.x = __uint_as_float(w.x << 16); r.y = __uint_as_float(w.x & 0xffff0000u); r.z = __uint_as_float(w.y << 16); r.w = __uint_as_float(w.y & 0xffff0000u); return r; }
__device__ __forceinline__ void st_bf16x4(bf16* p, f32x4 v) { v2u w; w.x = pg8::cvt_pk_bf16(v.x, v.y); w.y = pg8::cvt_pk_bf16(v.z, v.w); *(v2u*)p = w; }
__device__ __forceinline__ float fast_rcp(float x) { return __builtin_amdgcn_rcpf(x); }
__device__ __forceinline__ float fast_exp(float x) { return __builtin_amdgcn_exp2f(x * 1.44269504089f); }
__device__ __forceinline__ float sigmoidf_(float x) { return fast_rcp(1.0f + fast_exp(-x)); }
template <int S> __device__ __forceinline__ float dpp_shr(float v, float ident) {
    return __builtin_bit_cast(float, __builtin_amdgcn_update_dpp(__builtin_bit_cast(int, ident), __builtin_bit_cast(int, v), 0x110 + S, 0xf, 0xf, false));
}
#if MK_MODE == 2
#define XB_TMO      128
#define XB_XCNT(j)  (256  + 64 * (j))
#define XB_XSUB(j)  (1280 + 64 * (j))
#define XB_XGEN(j)  (2304 + 64 * (j))
#define XB_TOP      3328
#define XB_TOPGEN   3392
#define XCD_BAR_WORDS 3456
#define XB_SPIN_CAP (1u << 18)

__device__ __forceinline__ unsigned xb_ld(unsigned* p)              { return __hip_atomic_load(p, __ATOMIC_RELAXED, __HIP_MEMORY_SCOPE_AGENT); }
__device__ __forceinline__ unsigned xb_add(unsigned* p, unsigned v) { return __hip_atomic_fetch_add(p, v, __ATOMIC_RELAXED, __HIP_MEMORY_SCOPE_AGENT); }
__device__ __forceinline__ unsigned xb_xcc_id() { return (unsigned)__builtin_amdgcn_s_getreg((3 << 11) | 20) & 0xFu; }
#define XB_SPIN(cond, bar) do { unsigned _sp = 0; while (cond) { __builtin_amdgcn_s_sleep(1); \
    if ((++_sp & 255u) == 0u) { if (xb_ld(&(bar)[XB_TMO])) break; if (_sp > XB_SPIN_CAP) { atomicAdd(&(bar)[XB_TMO], 1u); break; } } } } while (0)

struct XcdBarrier {
    unsigned* bar; unsigned x;
    volatile LAS unsigned* st;
};

__device__ __forceinline__ XcdBarrier xcd_barrier_post(unsigned* bar, volatile LAS unsigned* st) {
    XcdBarrier b; b.bar = bar; b.x = xb_xcc_id(); b.st = st;
    if (threadIdx.x == 0) (void)xb_add(&bar[XB_XCNT(b.x)], 1u);
    return b;
}
__device__ __forceinline__ void xcd_barrier_complete(unsigned* bar, unsigned x, unsigned& nloc, unsigned& nx) {
    const unsigned G = gridDim.x * gridDim.y * gridDim.z;
    unsigned sum, cnt, mine, sp = 0u;
    for (;;) {
        sum = 0u; cnt = 0u; mine = 0u;
#pragma unroll
        for (unsigned j = 0; j < 16; ++j) { const unsigned c = xb_ld(&bar[XB_XCNT(j)]); sum += c; cnt += (c > 0u) ? 1u : 0u; mine = (j == x) ? c : mine; }
        if (sum == G) break;
        __builtin_amdgcn_s_sleep(1);
        if ((++sp & 255u) == 0u) { if (xb_ld(&bar[XB_TMO])) break; if (sp > XB_SPIN_CAP) { atomicAdd(&bar[XB_TMO], 1u); break; } }
    }
    nloc = mine > 0u ? mine : 1u; nx = cnt > 0u ? cnt : 1u;
}

__device__ __forceinline__ void xcd_barrier(const XcdBarrier& b) {
    asm volatile("s_waitcnt vmcnt(0)" ::: "memory");
    __syncthreads();
    if (threadIdx.x == 0) {
        unsigned* bar = b.bar;
        __builtin_amdgcn_s_waitcnt(0);
        unsigned nloc = b.st[0], nx = b.st[1];
        if (nloc == 0u) { xcd_barrier_complete(bar, b.x, nloc, nx); b.st[0] = nloc; b.st[1] = nx; }
        const unsigned old = xb_add(&bar[XB_XSUB(b.x)], 1u);
        const unsigned gen = old / nloc;
        if (old + 1u == (gen + 1u) * nloc) {
            __builtin_amdgcn_fence(__ATOMIC_RELEASE, "agent");
            asm volatile("s_waitcnt vmcnt(0)" ::: "memory");
            const unsigned og = xb_add(&bar[XB_TOP], 1u);
            const unsigned tg = og / nx;
            if (og + 1u == (tg + 1u) * nx) xb_add(&bar[XB_TOPGEN], 1u);
            else XB_SPIN(xb_ld(&bar[XB_TOPGEN]) == tg, bar);
            __builtin_amdgcn_fence(__ATOMIC_ACQUIRE, "agent");
            xb_add(&bar[XB_XGEN(b.x)], 1u);
            asm volatile("s_waitcnt vmcnt(0)" ::: "memory");
        } else {
            XB_SPIN(xb_ld(&bar[XB_XGEN(b.x)]) == gen, bar);
            __builtin_amdgcn_fence(__ATOMIC_ACQUIRE, "agent");
            asm volatile("s_waitcnt vmcnt(0)" ::: "memory");
        }
    }
    __syncthreads();
}
#endif
struct Args {
    const float* xp; const float* xs; const float* st_ca; const float* st_lc; const float* st_lh; const float* g1; const float* w_in; const float* conv_a_w; const float* lru_conv_w;
    const float* lru_conv_b; const float* lru_wa; const float* lru_ba; const float* lru_wx; const float* lru_bx; const float* lru_a_param; const float* w_out; const float* g2;
    const float* w_up; const float* w_down; const float* gf; float* out; unsigned char* ws; int ph_lo, ph_hi;
};
__device__ __forceinline__ float wave_sum(float v) {
#pragma unroll
    for (int o = 1; o < 64; o <<= 1) v += __shfl_xor(v, o);
    return v;
}
__device__ __forceinline__ void p0_transpose_item(const float* W, const float* g, int K, int N, bf16* WT, LAS float* scr, int item, int lane) {
    const int nblk = N / 32, kb = item / nblk, nb = item % nblk, k0 = 64 * kb, n0 = 32 * nb;
#pragma unroll 8
    for (int i = 0; i < 32; ++i) { const int kk = 2 * i + (lane >> 5); float v = W[(size_t)(k0 + kk) * N + n0 + (lane & 31)]; if (g) v *= g[k0 + kk]; scr[kk * 33 + (lane & 31)] = v; }
    LDS_WAIT(); asm volatile("" ::: "memory");
    const int c = lane & 7;
#pragma unroll
    for (int j = 0; j < 4; ++j) { const int n = (lane >> 3) + 8 * j; const LAS float* s = scr + (8 * c) * 33 + n;
        v4u o; o.x = pk2(s[0 * 33], s[1 * 33]); o.y = pk2(s[2 * 33], s[3 * 33]); o.z = pk2(s[4 * 33], s[5 * 33]); o.w = pk2(s[6 * 33], s[7 * 33]);
        *(GAS v4u*)(WT + (size_t)(n0 + n) * K + k0 + 8 * c) = o; }
    LDS_WAIT(); asm volatile("" ::: "memory");
}
__device__ __forceinline__ void rms_row_bf16(const float* xrow, const float* g, bf16* orow, int lane) {
    const GAS f32x4* xr = (const GAS f32x4*)xrow + lane; const GAS f32x4* gr = (const GAS f32x4*)g + lane;
    f32x4 v[4]; float s = 0.f;
#pragma unroll
    for (int j = 0; j < 4; ++j) { v[j] = xr[64 * j]; s += (v[j].x * v[j].x + v[j].y * v[j].y) + (v[j].z * v[j].z + v[j].w * v[j].w); }
    const float rs = 1.0f / sqrtf(wave_sum(s) * (1.f / D) + EPS);
    GAS v2u* o8 = (GAS v2u*)orow + lane;
#pragma unroll
    for (int j = 0; j < 4; ++j) { const f32x4 gg = gr[64 * j]; v2u w; w.x = pk2(v[j].x * rs * gg.x, v[j].y * rs * gg.y); w.y = pk2(v[j].z * rs * gg.z, v[j].w * rs * gg.w); o8[64 * j] = w; }
}
__device__ __forceinline__ void rms_row_final(float* xrow, const bf16* x1row, const float* slabrow, const float* g, int lane) {
    GAS f32x4* xr = (GAS f32x4*)xrow + lane; const GAS f32x4* gr = (const GAS f32x4*)g + lane;
    f32x4 v[4]; float s = 0.f;
    if (x1row == nullptr) {
#pragma unroll
        for (int j = 0; j < 4; ++j) v[j] = xr[64 * j];
    } else {
#pragma unroll
        for (int j = 0; j < 4; ++j) { v[j] = ld_bf16x4(x1row + 4 * lane + 256 * j);
#pragma unroll
            for (int sl = 0; sl < KSPLIT; ++sl) v[j] = v[j] + *((const GAS f32x4*)(slabrow + (size_t)sl * MS * D) + lane + 64 * j); }
    }
#pragma unroll
    for (int j = 0; j < 4; ++j) s += (v[j].x * v[j].x + v[j].y * v[j].y) + (v[j].z * v[j].z + v[j].w * v[j].w);
    const float rs = 1.0f / sqrtf(wave_sum(s) * (1.f / D) + EPS);
#pragma unroll
    for (int j = 0; j < 4; ++j) { const f32x4 gg = gr[64 * j]; xr[64 * j] = v[j] * rs * gg; }
}
__device__ __forceinline__ void p0_prologue(const Args& A, LAS unsigned char* lds, int gw, int NGW, int wave, int lane) {
    LAS float* scr = (LAS float*)(lds + RING_OFF + wave * 16384);
    unsigned char* ws = A.ws;
    constexpr int I_IN = (D / 64) * (DIN / 32), I_OUT = (D / 64) * (D / 32), I_UP = (D / 64) * (FF / 32), I_DN = (FF / 64) * (D / 32);
    constexpr int NITEMS = I_IN + I_OUT + I_UP + I_DN;
    for (int it = gw; it < NITEMS; it += NGW) {
        int r = it;
        if (r < I_IN) { p0_transpose_item(A.w_in, nullptr, D, DIN, (bf16*)(ws + WS_WIN), scr, r, lane); continue; } r -= I_IN;
        if (r < I_OUT) { p0_transpose_item(A.w_out, nullptr, D, D, (bf16*)(ws + WS_WOUT), scr, r, lane); continue; } r -= I_OUT;
        if (r < I_UP) { p0_transpose_item(A.w_up, A.g2, D, FF, (bf16*)(ws + WS_WUP), scr, r, lane); continue; } r -= I_UP;
        p0_transpose_item(A.w_down, nullptr, FF, D, (bf16*)(ws + WS_WDN), scr, r, lane);
    }
    for (int idx = gw; idx < 128; idx += NGW) {
        const int hd = idx >> 4, gate = (idx >> 3) & 1, jt = (idx >> 1) & 3, ks = idx & 1, jj = lane & 15, qa = lane >> 4;
        const float* W = (gate ? A.lru_wx : A.lru_wa) + hd * 4096 + 32 * (jt >> 1) + 8 * (jj >> 2) + 4 * (jt & 1) + (jj & 3);
        float v[8];
#pragma unroll
        for (int e = 0; e < 8; ++e) v[e] = W[(32 * ks + 8 * qa + e) * 64];
        v4u o; o.x = pk2(v[0], v[1]); o.y = pk2(v[2], v[3]); o.z = pk2(v[4], v[5]); o.w = pk2(v[6], v[7]);
        *(GAS v4u*)((bf16*)(ws + WS_GW) + (size_t)idx * 512 + lane * 8) = o;
    }
    if (gw >= NGW - 8) {
        const int hd = NGW - 1 - gw, c = hd * 64 + lane; float* hc = (float*)(ws + WS_HC) + hd * 704 + lane;
#pragma unroll
        for (int k = 0; k < 4; ++k) hc[k * 64] = A.lru_conv_w[k * 512 + c];
        hc[256] = A.lru_conv_b[c]; hc[320] = A.lru_ba[c]; hc[384] = A.lru_bx[c];
        { const float x = A.lru_a_param[c]; hc[448] = x > 20.f ? x : log1pf(expf(x)); }
#pragma unroll
        for (int k = 0; k < 3; ++k) hc[512 + k * 64] = A.conv_a_w[k * 512 + c];
    }
    for (int m = gw; m < M; m += NGW) rms_row_bf16(m < MP ? A.xp + (size_t)m * D : A.xs + (size_t)(m - MP) * D, A.g1, (bf16*)(ws + WS_XN) + (size_t)m * D, lane);
}
typedef __amdgpu_buffer_rsrc_t rsrc_t;
struct f32x8 { f32x4 lo, hi; };
__device__ __forceinline__ f32x8 bld_bf16x8(rsrc_t r, int voff, int soff) { const v4u w = __builtin_amdgcn_raw_buffer_load_b128(r, voff, soff, 0); f32x8 o;
    o.lo.x = __uint_as_float(w.x << 16); o.lo.y = __uint_as_float(w.x & 0xffff0000u); o.lo.z = __uint_as_float(w.y << 16); o.lo.w = __uint_as_float(w.y & 0xffff0000u);
    o.hi.x = __uint_as_float(w.z << 16); o.hi.y = __uint_as_float(w.z & 0xffff0000u); o.hi.z = __uint_as_float(w.w << 16); o.hi.w = __uint_as_float(w.w & 0xffff0000u); return o; }
__device__ __forceinline__ v4u pack_bf16x8(f32x4 lo, f32x4 hi) { v4u w; w.x = pg8::cvt_pk_bf16(lo.x, lo.y); w.y = pg8::cvt_pk_bf16(lo.z, lo.w); w.z = pg8::cvt_pk_bf16(hi.x, hi.y); w.w = pg8::cvt_pk_bf16(hi.z, hi.w); return w; }
__device__ __forceinline__ f32x4 ld_bf16x4_buf(rsrc_t r, int voff, int soff) { const v2u w = __builtin_amdgcn_raw_buffer_load_b64(r, voff, soff, 0); f32x4 o; o.x = __uint_as_float(w.x << 16); o.y = __uint_as_float(w.x & 0xffff0000u); o.z = __uint_as_float(w.y << 16); o.w = __uint_as_float(w.y & 0xffff0000u); return o; }
__device__ __forceinline__ void st_bf16x4_buf(rsrc_t r, int voff, int soff, f32x4 v) { v2u w; w.x = pg8::cvt_pk_bf16(v.x, v.y); w.y = pg8::cvt_pk_bf16(v.z, v.w); __builtin_amdgcn_raw_buffer_store_b64(w, r, voff, soff, 0); }
__device__ __forceinline__ f32x4 bld_f32x4(rsrc_t r, int voff, int soff) { return __builtin_bit_cast(f32x4, __builtin_amdgcn_raw_buffer_load_b128(r, voff, soff, 0)); }
#define MEMFENCE() asm volatile("" ::: "memory")
__device__ __forceinline__ f32x4 exp2v(f32x4 x) { f32x4 r; r.x = __builtin_amdgcn_exp2f(x.x); r.y = __builtin_amdgcn_exp2f(x.y); r.z = __builtin_amdgcn_exp2f(x.z); r.w = __builtin_amdgcn_exp2f(x.w); return r; }
__device__ __forceinline__ f32x4 rcpv(f32x4 x) { f32x4 r; r.x = __builtin_amdgcn_rcpf(x.x); r.y = __builtin_amdgcn_rcpf(x.y); r.z = __builtin_amdgcn_rcpf(x.z); r.w = __builtin_amdgcn_rcpf(x.w); return r; }
__device__ __forceinline__ f32x4 sqrtv(f32x4 x) { f32x4 r; r.x = __builtin_amdgcn_sqrtf(x.x); r.y = __builtin_amdgcn_sqrtf(x.y); r.z = __builtin_amdgcn_sqrtf(x.z); r.w = __builtin_amdgcn_sqrtf(x.w); return r; }
__device__ __forceinline__ float bcast15(float v) { return __builtin_bit_cast(float, __builtin_amdgcn_update_dpp(0, __builtin_bit_cast(int, v), 0x15F, 0xf, 0xf, false)); }
#define KS4_STEP(S) \
    "v_fmac_f32_dpp %4, %4, %0 row_shr:" #S " row_mask:0xf bank_mask:0xf\n\tv_fmac_f32_dpp %5, %5, %1 row_shr:" #S " row_mask:0xf bank_mask:0xf\n\t" \
    "v_fmac_f32_dpp %6, %6, %2 row_shr:" #S " row_mask:0xf bank_mask:0xf\n\tv_fmac_f32_dpp %7, %7, %3 row_shr:" #S " row_mask:0xf bank_mask:0xf\n\t" \
    "v_mul_f32_dpp %0, %0, %0 row_shr:" #S " row_mask:0xf bank_mask:0xf\n\tv_mul_f32_dpp %1, %1, %1 row_shr:" #S " row_mask:0xf bank_mask:0xf\n\t" \
    "v_mul_f32_dpp %2, %2, %2 row_shr:" #S " row_mask:0xf bank_mask:0xf\n\tv_mul_f32_dpp %3, %3, %3 row_shr:" #S " row_mask:0xf bank_mask:0xf\n\t"
__device__ __forceinline__ void scan16x4(f32x4& a, f32x4& b) {
    float a0 = a.x, a1 = a.y, a2 = a.z, a3 = a.w, b0 = b.x, b1 = b.y, b2 = b.z, b3 = b.w;
    asm("s_nop 1\n\t" KS4_STEP(1) KS4_STEP(2) KS4_STEP(4) KS4_STEP(8) "s_nop 1" : "+v"(a0), "+v"(a1), "+v"(a2), "+v"(a3), "+v"(b0), "+v"(b1), "+v"(b2), "+v"(b3));
    a = (f32x4){a0, a1, a2, a3}; b = (f32x4){b0, b1, b2, b3};
}
#define KS_STEP(S, a, b) { const float ap_ = dpp_shr<S>(a, 1.0f), bp_ = dpp_shr<S>(b, 0.0f); b = fmaf(a, bp_, b); a = a * ap_; }
struct LruState { f32x4 hl[2][2][4], acp[2][2][4]; };
#define LDC(arr, off) bld_f32x4(rC, vc, (arr) * 256 + (off))
#define LDG(gate, jt, ks) __builtin_bit_cast(bf16x8, __builtin_amdgcn_raw_buffer_load_b128(rC, vg, (((gate) * 4 + (jt)) * 2 + (ks)) * 1024, 0))
template <bool SAMPLE>
__device__ __forceinline__ void conv_front(const Args& A, rsrc_t rP, rsrc_t rC, int ck, int hd, int lane, bool write_lc, f32x8 (&cl)[4][2], bf16x8 (&bfr)[4][2]) {
    const int tl = lane & 15, q = lane >> 4, vc = 131072 + hd * 2816 + q * 32;
    const bool first = SAMPLE || ((ck & 63) == 0), lastc = SAMPLE || ((ck & 63) == 63);
    const int sb = SAMPLE ? ck - NPCHUNK : ck >> 6, row0 = ck * 64, cb = hd * 64 + 8 * q, vb0 = ((row0 + tl) * DIN + cb) * 2;
#pragma unroll
    for (int ks = 0; ks < 2; ++ks) {
        const int c = cb + 32 * ks;
        f32x4 wl[4], wh[4];
#pragma unroll
        for (int k = 0; k < 4; ++k) { wl[k] = LDC(k, ks * 128); wh[k] = LDC(k, ks * 128 + 16); }
        const f32x4 bl = LDC(4, ks * 128), bh = LDC(4, ks * 128 + 16);
#pragma unroll
        for (int m = 0; m < 4; ++m) {
            f32x8 x[4];
#pragma unroll
            for (int k = 0; k < 4; ++k) {
                if (m > 0 || k == 3) x[k] = bld_bf16x8(rP, vb0, ((16 * m - 3 + k) * DIN + 1536 + 32 * ks) * 2);
                else { const int tk = tl - 3 + k;
                    if (!first || tk >= 0) x[k] = bld_bf16x8(rP, vb0 - (3 - k) * DIN * 2, (1536 + 32 * ks) * 2);
                    else if (SAMPLE) { const float* p = A.st_lc + (size_t)(sb * 3 + 3 + tk) * 512 + c; x[k].lo = *(const f32x4*)p; x[k].hi = *(const f32x4*)(p + 4); }
                    else { x[k].lo = (f32x4){0.f, 0.f, 0.f, 0.f}; x[k].hi = x[k].lo; } } }
            cl[m][ks].lo = bl + wl[0] * x[0].lo + wl[1] * x[1].lo + wl[2] * x[2].lo + wl[3] * x[3].lo;
            cl[m][ks].hi = bh + wh[0] * x[0].hi + wh[1] * x[1].hi + wh[2] * x[2].hi + wh[3] * x[3].hi;
            if (m == 3) { if (write_lc && lastc && tl >= 13) { float* p = A.out + (SAMPLE ? O_LCS : O_LCP) + (size_t)(sb * 3 + tl - 13) * 512 + c; *(f32x4*)p = x[3].lo; *(f32x4*)(p + 4) = x[3].hi; } }
        }
        asm volatile("" : "+v"(cl[0][ks].lo), "+v"(cl[0][ks].hi), "+v"(cl[1][ks].lo), "+v"(cl[1][ks].hi), "+v"(cl[2][ks].lo), "+v"(cl[2][ks].hi), "+v"(cl[3][ks].lo), "+v"(cl[3][ks].hi) :: "memory");
    }
#pragma unroll
    for (int m = 0; m < 4; ++m)
#pragma unroll
        for (int ks = 0; ks < 2; ++ks) bfr[m][ks] = __builtin_bit_cast(bf16x8, pack_bf16x8(cl[m][ks].lo, cl[m][ks].hi));
}
__device__ __forceinline__ void gate_tile(const bf16x8 (&bm)[2], bf16x8 ar0, bf16x8 ar1, bf16x8 ai0, bf16x8 ai1, f32x4 ba4, f32x4 bx4, f32x4 spl, f32x4 sp16, f32x4 clv, bool reset, f32x4& a, f32x4& b) {
    f32x4 zr = {0.f, 0.f, 0.f, 0.f}, zi = {0.f, 0.f, 0.f, 0.f};
    zr = __builtin_amdgcn_mfma_f32_16x16x32_bf16(ar0, bm[0], zr, 0, 0, 0); zr = __builtin_amdgcn_mfma_f32_16x16x32_bf16(ar1, bm[1], zr, 0, 0, 0);
    zi = __builtin_amdgcn_mfma_f32_16x16x32_bf16(ai0, bm[0], zi, 0, 0, 0); zi = __builtin_amdgcn_mfma_f32_16x16x32_bf16(ai1, bm[1], zi, 0, 0, 0);
    const f32x4 rr = rcpv(exp2v((zr + ba4) * (-1.44269504089f)) + 1.0f), ii = rcpv(exp2v((zi + bx4) * (-1.44269504089f)) + 1.0f);
    a = exp2v(rr * spl); const f32x4 x2 = rr * sp16;
    f32x4 t = 1.0f - a * a; const f32x4 tp = -x2 * (1.0f + x2 * (0.5f + x2 * (1.0f / 6.0f)));
#pragma unroll
    for (int r = 0; r < 4; ++r) t[r] = x2[r] > -0.02f ? tp[r] : t[r];
    f32x4 mult = sqrtv(t);
    if (reset) mult = (f32x4){1.f, 1.f, 1.f, 1.f};
    b = mult * (ii * clv);
    scan16x4(a, b);
}
__device__ __forceinline__ f32x4 bcast15v(f32x4 v) { return (f32x4){bcast15(v.x), bcast15(v.y), bcast15(v.z), bcast15(v.w)}; }
__device__ __forceinline__ f32x4 gelu_gate(f32x4 g) { return g * rcpv(exp2v((g + 0.044715f * g * g * g) * (-1.5957691216f * 1.44269504089f)) + 1.0f); }

__device__ __forceinline__ void mix_pre(const Args& A, rsrc_t rP, rsrc_t rC, rsrc_t rS, int ck, int hd, int lane, LruState& st) {
    const int tl = lane & 15, q = lane >> 4, vg = hd * 16384 + lane * 16, vc = 131072 + hd * 2816 + q * 32, cb = hd * 64 + 8 * q;
    f32x8 cl[4][2]; bf16x8 bfr[4][2];
    conv_front<false>(A, rP, rC, ck, hd, lane, true, cl, bfr);
    const bool reset0 = ((ck & 63) == 0) && tl == 0;
#pragma unroll
    for (int ks = 0; ks < 2; ++ks)
#pragma unroll
        for (int jj = 0; jj < 2; ++jj) {
            const int jt = 2 * ks + jj;
            const bf16x8 ar0 = LDG(0, jt, 0), ar1 = LDG(0, jt, 1), ai0 = LDG(1, jt, 0), ai1 = LDG(1, jt, 1);
            const f32x4 ba4 = LDC(5, ks * 128 + jj * 16), bx4 = LDC(6, ks * 128 + jj * 16), sp4 = LDC(7, ks * 128 + jj * 16);
            const f32x4 spl = sp4 * (-8.0f * 1.44269504089f), sp16 = sp4 * (-16.0f);
            f32x4 hc = {0.f, 0.f, 0.f, 0.f}, ac = {1.f, 1.f, 1.f, 1.f};
#pragma unroll
            for (int m = 0; m < 4; ++m) {
                f32x4 a, b; gate_tile(bfr[m], ar0, ar1, ai0, ai1, ba4, bx4, spl, sp16, jj ? cl[m][ks].hi : cl[m][ks].lo, m == 0 && reset0, a, b);
                const f32x4 h = a * hc + b, ap = a * ac;
                st.hl[ks][jj][m] = h; st.acp[ks][jj][m] = ap;
                hc = bcast15v(h); ac = bcast15v(ap);
            }
            if (tl == 0) { __builtin_amdgcn_raw_buffer_store_b128(__builtin_bit_cast(v4u, ac), rS, cb * 4, ck * 4096 + (32 * ks + 4 * jj) * 4, 0); __builtin_amdgcn_raw_buffer_store_b128(__builtin_bit_cast(v4u, hc), rS, cb * 4, ck * 4096 + 2048 + (32 * ks + 4 * jj) * 4, 0); }
            MEMFENCE();
        }
}
template <bool SAMPLE>
__device__ __forceinline__ void mixa_half(const Args& A, rsrc_t rP, rsrc_t rM, rsrc_t rC, int ck, int hd, int lane, int ks) {
    const int tl = lane & 15, q = lane >> 4, vc = 131072 + hd * 2816 + q * 32;
    const bool first = SAMPLE || ((ck & 63) == 0), lastc = SAMPLE || ((ck & 63) == 63);
    const int sb = SAMPLE ? ck - NPCHUNK : ck >> 6, row0 = ck * 64, cb = hd * 64 + 8 * q, vb0 = ((row0 + tl) * DIN + cb) * 2 + 64 * ks, mb0 = ((row0 + tl) * D + cb) * 2 + 64 * ks, c = cb + 32 * ks;
    f32x4 wl[3], wh[3];
#pragma unroll
    for (int k = 0; k < 3; ++k) { wl[k] = bld_f32x4(rC, vc + ks * 128, (8 + k) * 256); wh[k] = bld_f32x4(rC, vc + ks * 128, (8 + k) * 256 + 16); }
    v4u ow[4];
#pragma unroll
    for (int m = 0; m < 4; ++m) {
        f32x8 u[3];
#pragma unroll
        for (int k = 0; k < 3; ++k) {
            if (m > 0 || k == 2) { const int so = ((16 * m - 2 + k) * DIN) * 2; const f32x8 gc = bld_bf16x8(rP, vb0, so + 1024), xa = bld_bf16x8(rP, vb0, so + 2048); u[k].lo = gc.lo * xa.lo; u[k].hi = gc.hi * xa.hi; }
            else { const int tk = tl - 2 + k;
                if (!first || tk >= 0) { const int vo = vb0 - (2 - k) * DIN * 2; const f32x8 gc = bld_bf16x8(rP, vo, 1024), xa = bld_bf16x8(rP, vo, 2048); u[k].lo = gc.lo * xa.lo; u[k].hi = gc.hi * xa.hi; }
                else if (SAMPLE) { const float* p = A.st_ca + (size_t)(sb * 2 + 2 + tk) * 512 + c; u[k].lo = *(const f32x4*)p; u[k].hi = *(const f32x4*)(p + 4); }
                else { u[k].lo = (f32x4){0.f, 0.f, 0.f, 0.f}; u[k].hi = u[k].lo; } } }
        const f32x8 gb = bld_bf16x8(rP, vb0, (16 * m * DIN) * 2);
        ow[m] = pack_bf16x8(gb.lo * (wl[0] * u[0].lo + wl[1] * u[1].lo + wl[2] * u[2].lo), gb.hi * (wh[0] * u[0].hi + wh[1] * u[1].hi + wh[2] * u[2].hi));
        if (m == 3) { if (lastc && tl >= 14) { float* p = A.out + (SAMPLE ? O_CAS : O_CAP) + (size_t)(sb * 2 + tl - 14) * 512 + c; *(f32x4*)p = u[2].lo; *(f32x4*)(p + 4) = u[2].hi; } }
    }
#pragma unroll
    for (int m = 0; m < 4; ++m) __builtin_amdgcn_raw_buffer_store_b128(ow[m], rM, mb0, (16 * m * D) * 2, 0);
    MEMFENCE();
}
__device__ __forceinline__ void mix_post(const Args& A, rsrc_t rP, rsrc_t rM, rsrc_t rC, rsrc_t rS, int ck, int hd, int lane, const LruState& st) {
    const int tl = lane & 15, q = lane >> 4, cb = hd * 64 + 8 * q, row0 = ck * 64;
    const bool lastc = (ck & 63) == 63; const int sb = ck >> 6;
    const int vb0 = ((row0 + tl) * DIN + cb) * 2, mb0 = ((row0 + tl) * D + cb) * 2;
    const int vs = cb * 4 + ((ck & ~63) + 4 * tl) * 4096;
#pragma unroll
    for (int ks = 0; ks < 2; ++ks) {
        f32x4 hv[4][2];
#pragma unroll
        for (int jj = 0; jj < 2; ++jj) {
            f32x4 pa = {1.f, 1.f, 1.f, 1.f}, sa = {0.f, 0.f, 0.f, 0.f};
#pragma unroll
            for (int u = 0; u < 4; ++u) { f32x4 pv = bld_f32x4(rS, vs, u * 4096 + (32 * ks + 4 * jj) * 4), sv = bld_f32x4(rS, vs, u * 4096 + 2048 + (32 * ks + 4 * jj) * 4);
                if ((ck & ~63) + 4 * tl + u >= ck) { pv = (f32x4){1.f, 1.f, 1.f, 1.f}; sv = (f32x4){0.f, 0.f, 0.f, 0.f}; }
                sa = pv * sa + sv; pa = pv * pa; }
            scan16x4(pa, sa);
            const f32x4 hc = bcast15v(sa);
#pragma unroll
            for (int m = 0; m < 4; ++m) hv[m][jj] = st.hl[ks][jj][m] + st.acp[ks][jj][m] * hc;
            if (lastc && tl == 15) *(f32x4*)(A.out + O_LHP + (size_t)sb * 512 + cb + 32 * ks + 4 * jj) = hv[3][jj];
        }
#pragma unroll
        for (int m = 0; m < 4; ++m) {
            const f32x8 g = bld_bf16x8(rP, vb0, (16 * m * DIN + 2048 + 32 * ks) * 2);
            __builtin_amdgcn_raw_buffer_store_b128(pack_bf16x8(hv[m][0] * gelu_gate(g.lo), hv[m][1] * gelu_gate(g.hi)), rM, mb0, (16 * m * D + 512 + 32 * ks) * 2, 0);
        }
        MEMFENCE();
    }
    mixa_half<false>(A, rP, rM, rC, ck, hd, lane, 0);
    mixa_half<false>(A, rP, rM, rC, ck, hd, lane, 1);
}
__device__ __forceinline__ void mix_sample_q(const Args& A, rsrc_t rP, rsrc_t rM, rsrc_t rC, int ck, int hd, int jsel, int lane) {
    const int tl = lane & 15, q = lane >> 4, vg = hd * 16384 + lane * 16, vc = 131072 + hd * 2816 + q * 32, cb = hd * 64 + 8 * q, row0 = ck * 64, sb = ck - NPCHUNK;
    f32x8 cl[4][2]; bf16x8 bfr[4][2];
    conv_front<true>(A, rP, rC, ck, hd, lane, jsel == 0, cl, bfr);
    const int ks = jsel >> 1, jj = jsel & 1, cq = cb + 32 * ks + 4 * jj;
    const int so = (jsel * 2) * 1024;
    const bf16x8 ar0 = __builtin_bit_cast(bf16x8, __builtin_amdgcn_raw_buffer_load_b128(rC, vg, so, 0)), ar1 = __builtin_bit_cast(bf16x8, __builtin_amdgcn_raw_buffer_load_b128(rC, vg, so + 1024, 0));
    const bf16x8 ai0 = __builtin_bit_cast(bf16x8, __builtin_amdgcn_raw_buffer_load_b128(rC, vg, so + 8192, 0)), ai1 = __builtin_bit_cast(bf16x8, __builtin_amdgcn_raw_buffer_load_b128(rC, vg, so + 8192 + 1024, 0));
    const int co = ks * 128 + jj * 16;
    const f32x4 ba4 = bld_f32x4(rC, vc, 5 * 256 + co), bx4 = bld_f32x4(rC, vc, 6 * 256 + co), sp4 = bld_f32x4(rC, vc, 7 * 256 + co);
    const f32x4 spl = sp4 * (-8.0f * 1.44269504089f), sp16 = sp4 * (-16.0f);
    f32x4 hc = *(const f32x4*)(A.st_lh + (size_t)sb * 512 + cq);
    const int vb0 = ((row0 + tl) * DIN + cq) * 2, mb0 = ((row0 + tl) * D + cq) * 2;
#pragma unroll
    for (int m = 0; m < 4; ++m) {
        f32x4 clv;
        { const f32x4 c00 = cl[m][0].lo, c01 = cl[m][0].hi, c10 = cl[m][1].lo, c11 = cl[m][1].hi; clv = ks ? (jj ? c11 : c10) : (jj ? c01 : c00); }
        f32x4 a, b; gate_tile(bfr[m], ar0, ar1, ai0, ai1, ba4, bx4, spl, sp16, clv, false, a, b);
        const f32x4 h = a * hc + b; hc = bcast15v(h);
        const f32x4 g = ld_bf16x4_buf(rP, vb0, (16 * m * DIN + 2048) * 2);
        st_bf16x4_buf(rM, mb0, (16 * m * D + 512) * 2, h * gelu_gate(g));
    }
    if (tl == 15) *(f32x4*)(A.out + O_LHS + (size_t)sb * 512 + cq) = hc;
    if (jsel < 2) mixa_half<true>(A, rP, rM, rC, ck, hd, lane, jsel);
}
#undef LDC
#undef LDG
constexpr int N_PHASES = 8;
__global__ void __launch_bounds__(NWAVES * 64, 2) fwd_kernel(Args args) {
    extern __shared__ __attribute__((aligned(16))) unsigned char lds_raw[];
    LAS unsigned char* lds = (LAS unsigned char*)lds_raw;
    const int tid = threadIdx.x, lane = tid & 63, wave = __builtin_amdgcn_readfirstlane(tid >> 6);
    const int G = gridDim.x, bx = blockIdx.x, vcu = (G % 8 == 0) ? (bx % 8) * (G / 8) + bx / 8 : bx;
    const int gw = vcu * NWAVES + wave, NGW = G * NWAVES;
    unsigned char* ws = args.ws;
#if MK_MODE == 2
    volatile LAS unsigned* MISC = (volatile LAS unsigned*)(lds + MISC_OFF);
    for (int u = tid; u < (LDS_BYTES - LDSCTL_OFF) / 4; u += NWAVES * 64) ((LAS unsigned*)(lds + LDSCTL_OFF))[u] = 0u;
    __syncthreads();
    XcdBarrier bar = xcd_barrier_post((unsigned*)(ws + WS_CTL) + CW_BAR, MISC + 8);
#define GRID_BAR() xcd_barrier(bar)
#elif MK_MODE == 0
    cg::grid_group grid = cg::this_grid();
#define GRID_BAR() grid.sync()
#else
#define GRID_BAR() do {} while (0)
#endif
    const int lo = args.ph_lo, hi = args.ph_hi;
#ifndef PH_MASK
#define PH_MASK 0xff
#endif
#define IN(k) (((PH_MASK >> (k)) & 1) && lo <= (k) && (k) < hi)
#define SEAM(k) do { if (IN(k) && IN((k) + 1)) GRID_BAR(); } while (0)

#ifndef PH_REP
#define PH_REP 0
#endif
#define REPS(k) (1 + ((PH_REP >> (k)) & 1))
    if (IN(0)) for (int rep = 0; rep < REPS(0); ++rep) { if (rep) GRID_BAR(); p0_prologue(args, lds, gw, NGW, wave, lane); }
    SEAM(0);
    if (IN(1)) for (int rep = 0; rep < REPS(1); ++rep) {
        if (rep) GRID_BAR();
        pg8::Gemm g{(const bf16*)(ws + WS_XN), (const bf16*)(ws + WS_WIN), M, DIN, D, D, 1}; pg8::StaticOrder S; S.init(M, DIN, G, bx);
        pg8::EpiProj E{(bf16*)(ws + WS_PROJ), DIN};
        pg8::gemm_phase<pg8::EpiProj, pg8::StaticOrder, PG8_ALIGN, PG8_SP2>(lds + RING_OFF, g, S, E);
    }
    SEAM(1);
    const rsrc_t rP = __builtin_amdgcn_make_buffer_rsrc((void*)(ws + WS_PROJ), 0, (int)((size_t)M * DIN * 2), 0x00020000), rM = __builtin_amdgcn_make_buffer_rsrc((void*)(ws + WS_MIX), 0, (int)((size_t)M * D * 2), 0x00020000),
        rC = __builtin_amdgcn_make_buffer_rsrc((void*)(ws + WS_GW), 0, 131072 + 8 * 2816, 0x00020000), rS = __builtin_amdgcn_make_buffer_rsrc((void*)(ws + WS_SUM), 0, NPCHUNK * 4096, 0x00020000);
    {
        LruState st;
        if (IN(2) && G == 256) mix_pre(args, rP, rC, rS, vcu, wave, lane, st);
        SEAM(2);
        if (IN(3) && G == 256) { mix_post(args, rP, rM, rC, rS, vcu, wave, lane, st); if (wave < 4) mix_sample_q(args, rP, rM, rC, NPCHUNK + (vcu >> 3), vcu & 7, wave, lane); }
        SEAM(3);
    }
    if (IN(4)) for (int rep = 0; rep < REPS(4); ++rep) {
        if (rep) GRID_BAR();
        pg8::Gemm g{(const bf16*)(ws + WS_MIX), (const bf16*)(ws + WS_WOUT), M, D, D, D, 1}; pg8::StaticOrder S; S.init(M, D, G, bx);
        pg8::EpiX1 E{args.xp, args.xs, (bf16*)(ws + WS_X1B), (float*)(ws + WS_SS)};
        pg8::gemm_phase<pg8::EpiX1, pg8::StaticOrder, PG8_ALIGN, PG8_SP2>(lds + RING_OFF, g, S, E);
    }
    SEAM(4);
    if (IN(5)) for (int rep = 0; rep < REPS(5); ++rep) {
        if (rep) GRID_BAR();
        pg8::Gemm g{(const bf16*)(ws + WS_X1B), (const bf16*)(ws + WS_WUP), M, FF, D, D, 1}; pg8::StaticOrder S; S.init(M, FF, G, bx);
        pg8::EpiUp E{(bf16*)(ws + WS_H), (const float*)(ws + WS_SS), EPS};
        pg8::gemm_phase<pg8::EpiUp, pg8::StaticOrder, PG8_ALIGN, PG8_SP2>(lds + RING_OFF, g, S, E);
    }
    SEAM(5);
    if (IN(6)) {
        { pg8::Gemm g{(const bf16*)(ws + WS_H), (const bf16*)(ws + WS_WDN), MP, D, FF, FF, 1}; pg8::StaticOrder S; S.init(MP, D, G, bx);
          pg8::EpiDown E{args.out, (const bf16*)(ws + WS_X1B)};
          pg8::gemm_phase<pg8::EpiDown, pg8::StaticOrder, PG8_ALIGN, PG8_SP2>(lds + RING_OFF, g, S, E); }
        { pg8::Gemm g{(const bf16*)(ws + WS_H) + (size_t)MP * FF, (const bf16*)(ws + WS_WDN), MS, D, FF / KSPLIT, FF, KSPLIT}; pg8::StaticOrder S; S.init(MS, D, G, bx, KSPLIT);
          pg8::EpiSlab E{(float*)(ws + WS_SLAB), MS};
          pg8::gemm_phase<pg8::EpiSlab, pg8::StaticOrder, PG8_ALIGN, PG8_SP2>(lds + RING_OFF, g, S, E); }
    }
    SEAM(6);
    if (IN(7)) { for (int m = gw; m < M; m += NGW) rms_row_final(args.out + (size_t)m * D, m < MP ? nullptr : (const bf16*)(ws + WS_X1B) + (size_t)m * D, (const float*)(ws + WS_SLAB) + (size_t)(m < MP ? 0 : m - MP) * D, args.gf, lane); }
#undef IN
#undef SEAM
}

extern "C" void kernel_launch(void* const* d_in, const int* in_sizes, int n_in, void* d_out, int out_size, void* d_ws, size_t ws_size, hipStream_t stream) {
    static int grid = 0;
    if (grid == 0) {
        if (n_in != 20 || out_size != (int)O_END || ws_size < WS_END) { fprintf(stderr, "kernel_launch: unexpected shapes (n_in %d out %d ws %zu)\n", n_in, out_size, ws_size); grid = -1; return; }
        int dev = 0, cus = 0, per_cu = 0;
        if (hipGetDevice(&dev) != hipSuccess || hipDeviceGetAttribute(&cus, hipDeviceAttributeMultiprocessorCount, dev) != hipSuccess) { grid = -1; return; }
        if (hipFuncSetAttribute((const void*)fwd_kernel, hipFuncAttributeMaxDynamicSharedMemorySize, LDS_BYTES) != hipSuccess) { fprintf(stderr, "kernel_launch: hipFuncSetAttribute failed\n"); grid = -1; return; }
        if (hipOccupancyMaxActiveBlocksPerMultiprocessor(&per_cu, (const void*)fwd_kernel, NWAVES * 64, LDS_BYTES) != hipSuccess || per_cu < 1) { fprintf(stderr, "kernel_launch: occupancy query says %d blocks per CU\n", per_cu); per_cu = 1; }
        (void)hipGetLastError();
        grid = cus;
    }
    if (grid < 0) return;
    Args a{};
    a.xp = (const float*)d_in[0]; a.xs = (const float*)d_in[1]; a.st_ca = (const float*)d_in[2]; a.st_lc = (const float*)d_in[3]; a.st_lh = (const float*)d_in[4]; a.g1 = (const float*)d_in[5];
    a.w_in = (const float*)d_in[6]; a.conv_a_w = (const float*)d_in[7]; a.lru_conv_w = (const float*)d_in[8]; a.lru_conv_b = (const float*)d_in[9]; a.lru_wa = (const float*)d_in[10];
    a.lru_ba = (const float*)d_in[11]; a.lru_wx = (const float*)d_in[12]; a.lru_bx = (const float*)d_in[13]; a.lru_a_param = (const float*)d_in[14]; a.w_out = (const float*)d_in[15];
    a.g2 = (const float*)d_in[16]; a.w_up = (const float*)d_in[17]; a.w_down = (const float*)d_in[18]; a.gf = (const float*)d_in[19]; a.out = (float*)d_out; a.ws = (unsigned char*)d_ws;
#if MK_MODE == 1
    for (int p = 0; p < N_PHASES; ++p) { a.ph_lo = p; a.ph_hi = p + 1; hipLaunchKernelGGL(fwd_kernel, dim3(grid), dim3(NWAVES * 64), LDS_BYTES, stream, a); }
#elif MK_MODE == 0
    a.ph_lo = 0; a.ph_hi = N_PHASES;
    void* kargs[] = {&a};
    hipError_t e = hipLaunchCooperativeKernel((const void*)fwd_kernel, dim3(grid), dim3(NWAVES * 64), kargs, LDS_BYTES, stream);
    if (e != hipSuccess) fprintf(stderr, "kernel_launch: cooperative launch failed: %s (grid %d)\n", hipGetErrorString(e), grid);
#else
    if (hipMemsetAsync((char*)d_ws + WS_CTL, 0, CTL_ZERO_BYTES, stream) != hipSuccess) { fprintf(stderr, "kernel_launch: memset failed\n"); return; }
    a.ph_lo = 0; a.ph_hi = N_PHASES;
    hipLaunchKernelGGL(fwd_kernel, dim3(grid), dim3(NWAVES * 64), LDS_BYTES, stream, a);
#endif
    const hipError_t le = hipPeekAtLastError();
    if (le != hipSuccess) fprintf(stderr, "kernel_launch: launch failed: %s\n", hipGetErrorName(le));
}
```

```cpp
#include <hip/hip_runtime.h>
#include <hip/hip_cooperative_groups.h>
#include <cstdio>
#include <cstdint>
namespace cg = cooperative_groups;
#ifndef MK_MODE
#define MK_MODE 2
#endif
namespace pg8 {
#define PG8_LAS __attribute__((address_space(3)))
typedef unsigned short bf16_t;
typedef short bf16x8 __attribute__((ext_vector_type(8)));
typedef float f32x4 __attribute__((ext_vector_type(4)));
typedef unsigned u32x4 __attribute__((ext_vector_type(4)));
constexpr int BM = 256, BK = 64, HALF = 128, HTB = HALF * BK * 2  , STAGE_BYTES = 8 * HTB, NXCD = 8, WGM = 8;

__host__ __device__ __forceinline__ int lds_byte(int r, int c) { const int st = (r >> 4) * 2 + (c >> 5), rr = r & 15, cc = c & 31, ob = rr * 64 + cc * 2; return st * 1024 + (ob ^ (((ob >> 9) & 1) << 5)); }
__host__ __device__ __forceinline__ void stage_rc(int b, int& R, int& C) { const int st = b / 1024, sb = b % 1024, swz = sb ^ (((sb >> 9) & 1) << 5); R = (st >> 1) * 16 + swz / 64; C = (st & 1) * 32 + (swz % 64) / 2; }
__host__ __device__ __forceinline__ int perm32(int rho) { const int n = rho >> 4, i = rho & 15; return 8 * (i >> 2) + 4 * n + (i & 3); }

struct Unit { int pm, pn, ks; };
struct Gemm { const bf16_t* A; const bf16_t* Bt; int M, N, K, ld, nsl; };

struct StaticOrder {
    int nM, nN, nwg, G, c, nNr;
    __host__ __device__ void init(int M, int N, int G_, int c_, int nsl = 1) { nM = M / BM; nNr = N / BM; nN = nNr * nsl; nwg = nM * nN; G = G_; c = c_; }
    __host__ __device__ bool next(int i, Unit& u) const {
        const long L = (long)i * G + c; if (L >= nwg) return false;
        int wgid = (int)L; { const int q = nwg / NXCD, r = nwg % NXCD, xcd = wgid % NXCD, off = wgid / NXCD; wgid = (xcd < r ? xcd * (q + 1) : r * (q + 1) + (xcd - r) * q) + off; }
        const int nig = WGM * nN, gid = wgid / nig, fm = gid * WGM, gsz = (nM - fm) < WGM ? (nM - fm) : WGM;
        u.pm = fm + ((wgid % nig) % gsz); const int pq = (wgid % nig) / gsz; u.ks = pq / nNr; u.pn = pq % nNr; return true;
    }
    __device__ __forceinline__ void a_ready(const Unit&) const {}
    __device__ __forceinline__ void done(const Unit&) const {}
};

__device__ __forceinline__ unsigned cvt_pk_bf16(float lo, float hi) { unsigned r; asm volatile("v_cvt_pk_bf16_f32 %0, %1, %2" : "=v"(r) : "v"(lo), "v"(hi)); return r; }
typedef float f32x2 __attribute__((ext_vector_type(2)));
__device__ __forceinline__ f32x2 gelu_pk(f32x2 v) {
    const f32x2 av = __builtin_elementwise_abs(v), d = av * 0.2316418882f + 1.0f;
    f32x2 t; t.x = __builtin_amdgcn_rcpf(d.x); t.y = __builtin_amdgcn_rcpf(d.y);
    f32x2 q = t * 0.5307027145f + (-0.7265760135f); q = q * t + 0.7107068705f; q = q * t + (-0.142248368f); q = q * t + 0.127414796f; q = q * t;
    const f32x2 s = (v * v) * (-0.72134752044f);
    f32x2 e; e.x = __builtin_amdgcn_exp2f(s.x); e.y = __builtin_amdgcn_exp2f(s.y);
    const f32x2 m = v * (q * e), r = v - m;
    f32x2 o; o.x = v.x < 0.f ? m.x : r.x; o.y = v.y < 0.f ? m.y : r.y; return o;
}

typedef unsigned u32x2 __attribute__((ext_vector_type(2)));
struct EpiProj {
    static constexpr bool PERM = true, AFTER_DRAIN = false;
    bf16_t* O; int ldc;
    __device__ __forceinline__ void operator()(const f32x4 (&acc)[2][2][4][2], const Unit& u, int wr, int wc, int fr, int fq) const {
        const int row0 = u.pm * BM + wr * 64 + fr, col0 = u.pn * BM + wc * 32 + 8 * fq;
#pragma unroll
        for (int ai = 0; ai < 2; ++ai)
#pragma unroll
            for (int m = 0; m < 4; ++m) { bf16_t* rowp = O + (size_t)(row0 + ai * HALF + m * 16) * ldc + col0;
#pragma unroll
                for (int bj = 0; bj < 2; ++bj) { const f32x4 v0 = acc[ai][bj][m][0], v1 = acc[ai][bj][m][1];
                    u32x4 w; w.x = cvt_pk_bf16(v0[0], v0[1]); w.y = cvt_pk_bf16(v0[2], v0[3]); w.z = cvt_pk_bf16(v1[0], v1[1]); w.w = cvt_pk_bf16(v1[2], v1[3]);
                    *(u32x4*)(rowp + bj * HALF) = w; } }
    }
};
struct EpiX1 {
    static constexpr bool PERM = false, AFTER_DRAIN = false;
    const float* xp; const float* xs; bf16_t* x1b; float* ss;
    __device__ __forceinline__ void operator()(const f32x4 (&acc)[2][2][4][2], const Unit& u, int wr, int wc, int fr, int fq) const {
        const int row0 = u.pm * BM + wr * 64 + fr, col0 = u.pn * BM + wc * 32 + 4 * fq;
        const float* xin = (u.pm < 64) ? xp : xs - (size_t)16384 * 1024;
#pragma unroll
        for (int ai = 0; ai < 2; ++ai)
#pragma unroll
            for (int m = 0; m < 4; ++m) { const size_t off = (size_t)(row0 + ai * HALF + m * 16) * 1024 + col0; float s = 0.f;
#pragma unroll
                for (int bj = 0; bj < 2; ++bj)
#pragma unroll
                    for (int n = 0; n < 2; ++n) { const size_t o = off + bj * HALF + n * 16; const f32x4 v = *(const f32x4*)(xin + o) + acc[ai][bj][m][n];
                        u32x2 w; w.x = cvt_pk_bf16(v[0], v[1]); w.y = cvt_pk_bf16(v[2], v[3]); *(u32x2*)(x1b + o) = w;
                        s += (v[0] * v[0] + v[1] * v[1]) + (v[2] * v[2] + v[3] * v[3]); }
                s += __shfl_xor(s, 16); s += __shfl_xor(s, 32);
                if (fq == 0) ss[(size_t)(row0 + ai * HALF + m * 16) * 16 + u.pn * 4 + wc] = s; }
    }
};
struct EpiUp {
    static constexpr bool PERM = true, AFTER_DRAIN = false;
    bf16_t* H; const float* ss; float eps;
    __device__ __forceinline__ void operator()(const f32x4 (&acc)[2][2][4][2], const Unit& u, int wr, int wc, int fr, int fq) const {
        const int row0 = u.pm * BM + wr * 64 + fr, col0 = u.pn * BM + wc * 32 + 8 * fq;
#pragma unroll
        for (int ai = 0; ai < 2; ++ai)
#pragma unroll
            for (int m = 0; m < 4; ++m) { const int r = row0 + ai * HALF + m * 16; const f32x4* sp = (const f32x4*)(ss + (size_t)r * 16);
                const f32x4 t = (sp[0] + sp[1]) + (sp[2] + sp[3]); const float rs2 = 1.0f / (((t[0] + t[1]) + (t[2] + t[3])) * (1.0f / 1024.0f) + eps);
                bf16_t* rowp = H + (size_t)r * 4096 + col0;
#pragma unroll
                for (int bj = 0; bj < 2; ++bj) { f32x4 v0 = acc[ai][bj][m][0], v1 = acc[ai][bj][m][1];
#pragma unroll
                    for (int j = 0; j < 4; ++j) { const float a = fmaxf(v0[j], 0.f), b = fmaxf(v1[j], 0.f); v0[j] = a * a * rs2; v1[j] = b * b * rs2; }
                    u32x4 w; w.x = cvt_pk_bf16(v0[0], v0[1]); w.y = cvt_pk_bf16(v0[2], v0[3]); w.z = cvt_pk_bf16(v1[0], v1[1]); w.w = cvt_pk_bf16(v1[2], v1[3]);
                    *(u32x4*)(rowp + bj * HALF) = w; } }
    }
};
struct EpiDown {
    static constexpr bool PERM = false, AFTER_DRAIN = false;
    float* out; const bf16_t* x1b;
    __device__ __forceinline__ void operator()(const f32x4 (&acc)[2][2][4][2], const Unit& u, int wr, int wc, int fr, int fq) const {
        const int row0 = u.pm * BM + wr * 64 + fr, col0 = u.pn * BM + wc * 32 + 4 * fq;
#pragma unroll
        for (int ai = 0; ai < 2; ++ai)
#pragma unroll
            for (int m = 0; m < 4; ++m) { const size_t off = (size_t)(row0 + ai * HALF + m * 16) * 1024 + col0;
#pragma unroll
                for (int bj = 0; bj < 2; ++bj)
#pragma unroll
                    for (int n = 0; n < 2; ++n) { const size_t o = off + bj * HALF + n * 16; const u32x2 w = *(const u32x2*)(x1b + o);
                        f32x4 v; v[0] = __uint_as_float(w.x << 16); v[1] = __uint_as_float(w.x & 0xffff0000u); v[2] = __uint_as_float(w.y << 16); v[3] = __uint_as_float(w.y & 0xffff0000u);
                        *(f32x4*)(out + o) = v + acc[ai][bj][m][n]; } }
    }
};
struct EpiSlab {
    static constexpr bool PERM = true, AFTER_DRAIN = false;
    bf16_t* slab; int rows;
    __device__ __forceinline__ void operator()(const f32x4 (&acc)[2][2][4][2], const Unit& u, int wr, int wc, int fr, int fq) const {
        const int row0 = u.pm * BM + wr * 64 + fr, col0 = u.pn * BM + wc * 32 + 8 * fq;
#pragma unroll
        for (int ai = 0; ai < 2; ++ai)
#pragma unroll
            for (int m = 0; m < 4; ++m) { bf16_t* rowp = slab + ((size_t)u.ks * rows + row0 + ai * HALF + m * 16) * 1024 + col0;
#pragma unroll
                for (int bj = 0; bj < 2; ++bj) { const f32x4 v0 = acc[ai][bj][m][0], v1 = acc[ai][bj][m][1];
                    u32x4 w; w.x = cvt_pk_bf16(v0[0], v0[1]); w.y = cvt_pk_bf16(v0[2], v0[3]); w.z = cvt_pk_bf16(v1[0], v1[1]); w.w = cvt_pk_bf16(v1[2], v1[3]);
                    *(u32x4*)(rowp + bj * HALF) = w; } }
    }
};

template <class Epi, class Sched, bool ALIGN_EPI = false, bool SP2 = false>
__device__ __forceinline__ void gemm_phase(PG8_LAS unsigned char* lds, const Gemm g, const Sched& S, const Epi& E) {
    const int tid = threadIdx.x, wid = __builtin_amdgcn_readfirstlane(tid >> 6), lane = tid & 63, wr = wid >> 2, wc = wid & 3, fr = lane & 15, fq = lane >> 4;
    const int K = g.K, nt = K / BK, LD = g.ld;
    unsigned voffA[2], voffB[2];
#pragma unroll
    for (int i = 0; i < 2; ++i) { int R, C; stage_rc(tid * 16 + i * 8192, R, C); const int Rb = Epi::PERM ? ((R & ~31) + perm32(R & 31)) : R;
        voffA[i] = (unsigned)(R * LD + C) * 2u; voffB[i] = (unsigned)(Rb * LD + C) * 2u; }
    const size_t kstep = (size_t)(BK * 2);
    const size_t hstep = (size_t)HALF * LD * 2, sstep = (size_t)K * 2;
    const size_t tstep = 2 * hstep;
    const unsigned ldsw = (unsigned)wid * 1024u;
    const int aoff = lds_byte(wr * 64 + fr, fq * 8), boff = lds_byte(wc * 32 + fr, fq * 8);
#define PG8_SA(b, h) (((b) * 2 + (h)) * HTB)
#define PG8_SB(b, h) ((4 + (b) * 2 + (h)) * HTB)
#define PG8_STAGE(bufoff, gbase, voff) do { _Pragma("unroll") for (int _i = 0; _i < 2; ++_i) \
        __builtin_amdgcn_global_load_lds((const unsigned*)((const char*)(gbase) + (voff)[_i]), (PG8_LAS unsigned*)(lds + (bufoff) + ldsw + _i * 8192), 16, 0, 0); } while (0)
#define PG8_LDA(dst, b, h) do { _Pragma("unroll") for (int m = 0; m < 4; ++m) _Pragma("unroll") for (int k = 0; k < 2; ++k) dst[m][k] = *(const PG8_LAS bf16x8*)(lds + PG8_SA(b, h) + aoff + m * 2048 + k * 1024); } while (0)
#define PG8_LDB(dst, b, h) do { _Pragma("unroll") for (int n = 0; n < 2; ++n) _Pragma("unroll") for (int k = 0; k < 2; ++k) dst[n][k] = *(const PG8_LAS bf16x8*)(lds + PG8_SB(b, h) + boff + n * 2048 + k * 1024); } while (0)
#define PG8_MMA(ai, bj, At, Bt) do { __builtin_amdgcn_s_setprio(1); _Pragma("unroll") for (int m = 0; m < 4; ++m) _Pragma("unroll") for (int n = 0; n < 2; ++n) _Pragma("unroll") for (int k = 0; k < 2; ++k) \
        acc[ai][bj][m][n] = __builtin_amdgcn_mfma_f32_16x16x32_bf16(Bt[n][k], At[m][k], acc[ai][bj][m][n], 0, 0, 0); __builtin_amdgcn_s_setprio(0); } while (0)
#define PG8_WAIT_V(n) asm volatile("s_waitcnt vmcnt(" #n ")" ::: "memory")
#define PG8_WAIT_L(n) asm volatile("s_waitcnt lgkmcnt(" #n ")" ::: "memory")
#define PG8_BAR __builtin_amdgcn_s_barrier()
#define PG8_SCHED __builtin_amdgcn_sched_barrier(0)
    Unit cur, nxt; int ui = 0;
    if (!S.next(0, cur)) return;
    f32x4 acc[2][2][4][2];
#pragma unroll
    for (int a = 0; a < 2; ++a)
#pragma unroll
        for (int b = 0; b < 2; ++b)
#pragma unroll
            for (int m = 0; m < 4; ++m)
#pragma unroll
                for (int n = 0; n < 2; ++n) acc[a][b][m][n] = (f32x4){0.f, 0.f, 0.f, 0.f};
    bf16x8 At[4][2], B0[2][2], B1[2][2];
    const char* cA = (const char*)g.A + (size_t)cur.pm * tstep + (size_t)cur.ks * sstep; const char* cB = (const char*)g.Bt + (size_t)cur.pn * tstep + (size_t)cur.ks * sstep;
    S.a_ready(cur);
    if constexpr (SP2) {
        PG8_STAGE(PG8_SB(0, 0), cB, voffB); PG8_STAGE(PG8_SB(0, 1), cB + hstep, voffB); PG8_STAGE(PG8_SA(0, 0), cA, voffA); PG8_STAGE(PG8_SA(0, 1), cA + hstep, voffA);
        if (wr == 1) PG8_BAR;
        PG8_WAIT_V(2); PG8_BAR;
        PG8_STAGE(PG8_SB(1, 0), cB + kstep, voffB); PG8_STAGE(PG8_SA(1, 0), cA + kstep, voffA); PG8_STAGE(PG8_SB(1, 1), cB + hstep + kstep, voffB);
        PG8_WAIT_V(6); PG8_BAR;
    } else {
        PG8_STAGE(PG8_SB(0, 0), cB, voffB); PG8_STAGE(PG8_SA(0, 0), cA, voffA); PG8_STAGE(PG8_SB(0, 1), cB + hstep, voffB); PG8_STAGE(PG8_SA(0, 1), cA + hstep, voffA);
        if (wr == 1) PG8_BAR;
        PG8_WAIT_V(4); PG8_BAR;
        PG8_STAGE(PG8_SB(1, 0), cB + kstep, voffB); PG8_STAGE(PG8_SA(1, 0), cA + kstep, voffA); PG8_STAGE(PG8_SB(1, 1), cB + hstep + kstep, voffB);
        PG8_WAIT_V(6); PG8_BAR;
    }
    for (;;) {
        const bool has_next = S.next(ui + 1, nxt);
        const char* nA = has_next ? (const char*)g.A + (size_t)nxt.pm * tstep + (size_t)nxt.ks * sstep : cA; const char* nB = has_next ? (const char*)g.Bt + (size_t)nxt.pn * tstep + (size_t)nxt.ks * sstep : cB;
        for (int t = 0; t < nt; t += 2) {
            const bool last = (t == nt - 2);
            const char* a1 = cA + (size_t)(t + 1) * kstep;
            const char* a2 = last ? nA : cA + (size_t)(t + 2) * kstep; const char* b2 = last ? nB : cB + (size_t)(t + 2) * kstep;
            const char* a3 = a2 + kstep; const char* b3 = b2 + kstep;
            if (last && has_next) S.a_ready(nxt);
            if constexpr (SP2) {
            PG8_LDB(B0, 0, 0); PG8_LDB(B1, 0, 1); PG8_SCHED; PG8_LDA(At, 0, 0); PG8_STAGE(PG8_SA(1, 1), a1 + hstep, voffA);
            PG8_WAIT_V(8); PG8_WAIT_L(0); PG8_BAR; PG8_MMA(0, 0, At, B0); PG8_MMA(0, 1, At, B1); PG8_BAR; PG8_SCHED;
            PG8_LDA(At, 0, 1); PG8_STAGE(PG8_SB(0, 0), b2, voffB); PG8_STAGE(PG8_SB(0, 1), b2 + hstep, voffB); PG8_STAGE(PG8_SA(0, 0), a2, voffA);
            PG8_WAIT_V(8); PG8_WAIT_L(0); PG8_BAR; PG8_MMA(1, 0, At, B0); PG8_MMA(1, 1, At, B1); PG8_BAR; PG8_SCHED;
            PG8_LDB(B0, 1, 0); PG8_LDB(B1, 1, 1); PG8_SCHED; PG8_LDA(At, 1, 0); PG8_STAGE(PG8_SA(0, 1), a2 + hstep, voffA);
            PG8_WAIT_V(8); PG8_WAIT_L(0); PG8_BAR; PG8_MMA(0, 0, At, B0); PG8_MMA(0, 1, At, B1); PG8_BAR; PG8_SCHED;
            PG8_LDA(At, 1, 1); PG8_STAGE(PG8_SB(1, 0), b3, voffB); PG8_STAGE(PG8_SB(1, 1), b3 + hstep, voffB); PG8_STAGE(PG8_SA(1, 0), a3, voffA);
            PG8_WAIT_V(8); PG8_WAIT_L(0); PG8_BAR; PG8_MMA(1, 0, At, B0); PG8_MMA(1, 1, At, B1); PG8_BAR; PG8_SCHED;
            } else {
            PG8_LDB(B0, 0, 0); PG8_SCHED; PG8_LDA(At, 0, 0); PG8_STAGE(PG8_SA(1, 1), a1 + hstep, voffA);
            PG8_WAIT_L(8); PG8_BAR; PG8_WAIT_L(0); PG8_MMA(0, 0, At, B0); PG8_BAR; PG8_SCHED;
            PG8_LDB(B1, 0, 1); PG8_STAGE(PG8_SB(0, 0), b2, voffB);
            PG8_BAR; PG8_WAIT_L(0); PG8_MMA(0, 1, At, B1); PG8_BAR;
            PG8_LDA(At, 0, 1); PG8_STAGE(PG8_SA(0, 0), a2, voffA);
            PG8_BAR; PG8_WAIT_L(0); PG8_MMA(1, 0, At, B0); PG8_BAR; PG8_SCHED;
            PG8_STAGE(PG8_SB(0, 1), b2 + hstep, voffB);
            PG8_WAIT_V(6); PG8_BAR; PG8_MMA(1, 1, At, B1); PG8_BAR;
            PG8_LDB(B0, 1, 0); PG8_SCHED; PG8_LDA(At, 1, 0); PG8_STAGE(PG8_SA(0, 1), a2 + hstep, voffA);
            PG8_WAIT_L(8); PG8_BAR; PG8_WAIT_L(0); PG8_MMA(0, 0, At, B0); PG8_BAR; PG8_SCHED;
            PG8_LDB(B1, 1, 1); PG8_STAGE(PG8_SB(1, 0), b3, voffB);
            PG8_BAR; PG8_WAIT_L(0); PG8_MMA(0, 1, At, B1); PG8_BAR;
            PG8_LDA(At, 1, 1); PG8_STAGE(PG8_SA(1, 0), a3, voffA);
            PG8_BAR; PG8_WAIT_L(0); PG8_MMA(1, 0, At, B0); PG8_BAR; PG8_SCHED;
            PG8_STAGE(PG8_SB(1, 1), b3 + hstep, voffB);
            PG8_WAIT_V(6); PG8_BAR; PG8_MMA(1, 1, At, B1); PG8_BAR;
            }
        }
        if constexpr (ALIGN_EPI) { if (wr == 0) PG8_BAR; }
        if constexpr (!Epi::AFTER_DRAIN) { E(acc, cur, wr, wc, fr, fq); S.done(cur); }
        if (!has_next) break;
#pragma unroll
        for (int a = 0; a < 2; ++a)
#pragma unroll
            for (int b = 0; b < 2; ++b)
#pragma unroll
                for (int m = 0; m < 4; ++m)
#pragma unroll
                    for (int n = 0; n < 2; ++n) acc[a][b][m][n] = (f32x4){0.f, 0.f, 0.f, 0.f};
        cur = nxt; cA = nA; cB = nB; ++ui;
        if constexpr (ALIGN_EPI) { if (wr == 1) PG8_BAR; }
    }
    PG8_WAIT_V(0);
    if constexpr (!ALIGN_EPI) { if (wr == 0) PG8_BAR; }
    PG8_BAR;
    if constexpr (Epi::AFTER_DRAIN) { E.fused(acc, cur, wr, wc, fr, fq, lds, wid, lane); S.done(cur); }
#undef PG8_SA
#undef PG8_SB
#undef PG8_STAGE
#undef PG8_LDA
#undef PG8_LDB
#undef PG8_MMA
#undef PG8_WAIT_V
#undef PG8_WAIT_L
#undef PG8_BAR
#undef PG8_SCHED
}
}
#ifndef PG8_SP2
#define PG8_SP2 true
#endif
#ifndef PG8_ALIGN
#define PG8_ALIGN true
#endif
constexpr int NWAVES = 8;
constexpr int D = 1024, DIN = 2560, FF = 4096, DC = 512, DL = 512;
constexpr int MP = 4 * 4096, MS = 32 * 64, M = MP + MS;
constexpr int NCHUNK = M / 64, NPCHUNK = MP / 64;
constexpr float EPS = 1e-6f;
constexpr size_t O_YP = 0, O_YS = (size_t)MP * D, O_CAP = (size_t)M * D, O_LCP = O_CAP + 4 * 2 * 512, O_LHP = O_LCP + 4 * 3 * 512, O_CAS = O_LHP + 4 * 512, O_LCS = O_CAS + 32 * 2 * 512, O_LHS = O_LCS + 32 * 3 * 512, O_END = O_LHS + 32 * 512;
constexpr size_t MiB = 1u << 20;
constexpr size_t WS_CTL = 0, CTL_ZERO_BYTES = 1 * MiB;
constexpr size_t WS_WIN = 2 * MiB, WS_WOUT = 8 * MiB, WS_WUP = 10 * MiB, WS_WDN = 18 * MiB;
constexpr size_t WS_GW = 26 * MiB;
constexpr size_t WS_HC = WS_GW + 131072;
constexpr size_t WS_SS = 27 * MiB;
constexpr size_t WS_SUM = 29 * MiB;
constexpr size_t WS_XN = 32 * MiB;
constexpr size_t WS_H = 68 * MiB;
constexpr size_t WS_PROJ = 68 * MiB;
constexpr size_t WS_MIX = 160 * MiB;
constexpr size_t WS_X1B = 212 * MiB;
constexpr int KSPLIT = 8;
constexpr size_t WS_SLAB = WS_XN;
constexpr size_t WS_END = 248 * MiB;
static_assert(WS_XN + (size_t)M * D * 2 <= WS_H && WS_PROJ + (size_t)M * DIN * 2 <= WS_MIX && WS_MIX + (size_t)M * D * 2 <= WS_X1B && WS_H + (size_t)M * FF * 2 <= WS_X1B && WS_X1B + (size_t)M * D * 2 <= WS_END && WS_SLAB + (size_t)KSPLIT * MS * D * 2 <= WS_H, "d_ws map");
static_assert(WS_SS + (size_t)M * 16 * 4 <= WS_SUM && WS_SUM + (size_t)NPCHUNK * 2 * 512 * 4 <= WS_XN, "d_ws map (small)");
constexpr int CW_BAR = 4096;
constexpr int RING_OFF = 0, RING_BYTES = 131072;
constexpr int LDSCTL_OFF = RING_BYTES, MISC_OFF = LDSCTL_OFF + 320;
constexpr int LDS_BYTES = 147456;
#define GAS __attribute__((address_space(1)))
#define LAS __attribute__((address_space(3)))
typedef unsigned short bf16;
typedef unsigned v4u __attribute__((ext_vector_type(4)));
typedef unsigned v2u __attribute__((ext_vector_type(2)));
typedef float f32x4 __attribute__((ext_vector_type(4)));
typedef short bf16x8 __attribute__((ext_vector_type(8)));
typedef GAS unsigned gu32;
#define RLX_AGENT __ATOMIC_RELAXED, __HIP_MEMORY_SCOPE_AGENT
#define LDS_WAIT() asm volatile("s_waitcnt lgkmcnt(0)" ::: "memory")
#define VM_WAIT() asm volatile("s_waitcnt vmcnt(0)" ::: "memory")
__device__ __forceinline__ unsigned f2bf(float f) { unsigned u = __builtin_bit_cast(unsigned, f); return (u + 0x7fffu + ((u >> 16) & 1u)) >> 16; }
__device__ __forceinline__ unsigned pk2(float lo, float hi) { return f2bf(lo) | (f2bf(hi) << 16); }
__device__ __forceinline__ f32x4 ld_bf16x4(const bf16* p) { const v2u w = *(const v2u*)p; f32x4 r; r.x = __uint_as_float(w.x << 16); r.y = __uint_as_float(w.x & 0xffff0000u); r.z = __uint_as_float(w.y << 16); r.w = __uint_as_float(w.y & 0xffff0000u); return r; }
__device__ __forceinline__ void st_bf16x4(bf16* p, f32x4 v) { v2u w; w.x = pg8::cvt_pk_bf16(v.x, v.y); w.y = pg8::cvt_pk_bf16(v.z, v.w); *(v2u*)p = w; }
__device__ __forceinline__ float fast_rcp(float x) { return __builtin_amdgcn_rcpf(x); }
__device__ __forceinline__ float fast_exp(float x) { return __builtin_amdgcn_exp2f(x * 1.44269504089f); }
__device__ __forceinline__ float sigmoidf_(float x) { return fast_rcp(1.0f + fast_exp(-x)); }
template <int S> __device__ __forceinline__ float dpp_shr(float v, float ident) {
    return __builtin_bit_cast(float, __builtin_amdgcn_update_dpp(__builtin_bit_cast(int, ident), __builtin_bit_cast(int, v), 0x110 + S, 0xf, 0xf, false));
}
#if MK_MODE == 2
#define XB_TMO      128
#define XB_XCNT(j)  (256  + 64 * (j))
#define XB_XSUB(j)  (1280 + 64 * (j))
#define XB_XGEN(j)  (2304 + 64 * (j))
#define XB_TOP      3328
#define XB_TOPGEN   3392
#define XCD_BAR_WORDS 3456
#define XB_SPIN_CAP (1u << 18)

__device__ __forceinline__ unsigned xb_ld(unsigned* p)              { return __hip_atomic_load(p, __ATOMIC_RELAXED, __HIP_MEMORY_SCOPE_AGENT); }
__device__ __forceinline__ unsigned xb_add(unsigned* p, unsigned v) { return __hip_atomic_fetch_add(p, v, __ATOMIC_RELAXED, __HIP_MEMORY_SCOPE_AGENT); }
__device__ __forceinline__ unsigned xb_xcc_id() { return (unsigned)__builtin_amdgcn_s_getreg((3 << 11) | 20) & 0xFu; }
#define XB_SPIN(cond, bar) do { unsigned _sp = 0; while (cond) { __builtin_amdgcn_s_sleep(1); \
    if ((++_sp & 255u) == 0u) { if (xb_ld(&(bar)[XB_TMO])) break; if (_sp > XB_SPIN_CAP) { atomicAdd(&(bar)[XB_TMO], 1u); break; } } } } while (0)

struct XcdBarrier {
    unsigned* bar; unsigned x;
    volatile LAS unsigned* st;
};

__device__ __forceinline__ XcdBarrier xcd_barrier_post(unsigned* bar, volatile LAS unsigned* st) {
    XcdBarrier b; b.bar = bar; b.x = xb_xcc_id(); b.st = st;
    if (threadIdx.x == 0) (void)xb_add(&bar[XB_XCNT(b.x)], 1u);
    return b;
}
__device__ __forceinline__ void xcd_barrier_complete(unsigned* bar, unsigned x, unsigned& nloc, unsigned& nx) {
    const unsigned G = gridDim.x * gridDim.y * gridDim.z;
    unsigned sum, cnt, mine, sp = 0u;
    for (;;) {
        sum = 0u; cnt = 0u; mine = 0u;
#pragma unroll
        for (unsigned j = 0; j < 16; ++j) { const unsigned c = xb_ld(&bar[XB_XCNT(j)]); sum += c; cnt += (c > 0u) ? 1u : 0u; mine = (j == x) ? c : mine; }
        if (sum == G) break;
        __builtin_amdgcn_s_sleep(1);
        if ((++sp & 255u) == 0u) { if (xb_ld(&bar[XB_TMO])) break; if (sp > XB_SPIN_CAP) { atomicAdd(&bar[XB_TMO], 1u); break; } }
    }
    nloc = mine > 0u ? mine : 1u; nx = cnt > 0u ? cnt : 1u;
}

__device__ __forceinline__ void xcd_barrier(const XcdBarrier& b) {
    asm volatile("s_waitcnt vmcnt(0)" ::: "memory");
    __syncthreads();
    if (threadIdx.x == 0) {
        unsigned* bar = b.bar;
        __builtin_amdgcn_s_waitcnt(0);
        unsigned nloc = b.st[0], nx = b.st[1];
        if (nloc == 0u) { xcd_barrier_complete(bar, b.x, nloc, nx); b.st[0] = nloc; b.st[1] = nx; }
        const unsigned old = xb_add(&bar[XB_XSUB(b.x)], 1u);
        const unsigned gen = old / nloc;
        if (old + 1u == (gen + 1u) * nloc) {
            __builtin_amdgcn_fence(__ATOMIC_RELEASE, "agent");
            asm volatile("s_waitcnt vmcnt(0)" ::: "memory");
            const unsigned og = xb_add(&bar[XB_TOP], 1u);
            const unsigned tg = og / nx;
            if (og + 1u == (tg + 1u) * nx) xb_add(&bar[XB_TOPGEN], 1u);
            else XB_SPIN(xb_ld(&bar[XB_TOPGEN]) == tg, bar);
            __builtin_amdgcn_fence(__ATOMIC_ACQUIRE, "agent");
            xb_add(&bar[XB_XGEN(b.x)], 1u);
            asm volatile("s_waitcnt vmcnt(0)" ::: "memory");
        } else {
            XB_SPIN(xb_ld(&bar[XB_XGEN(b.x)]) == gen, bar);
            __builtin_amdgcn_fence(__ATOMIC_ACQUIRE, "agent");
            asm volatile("s_waitcnt vmcnt(0)" ::: "memory");
        }
    }
    __syncthreads();
}
#endif
struct Args {
    const float* xp; const float* xs; const float* st_ca; const float* st_lc; const float* st_lh; const float* g1; const float* w_in; const float* conv_a_w; const float* lru_conv_w;
    const float* lru_conv_b; const float* lru_wa; const float* lru_ba; const float* lru_wx; const float* lru_bx; const float* lru_a_param; const float* w_out; const float* g2;
    const float* w_up; const float* w_down; const float* gf; float* out; unsigned char* ws; int ph_lo, ph_hi;
};
__device__ __forceinline__ float wave_sum(float v) {
#pragma unroll
    for (int o = 1; o < 64; o <<= 1) v += __shfl_xor(v, o);
    return v;
}
__device__ __forceinline__ void p0_transpose_item(const float* W, const float* g, int K, int N, bf16* WT, LAS float* scr, int item, int lane) {
    const int nblk = N / 32, kb = item / nblk, nb = item % nblk, k0 = 64 * kb, n0 = 32 * nb;
#pragma unroll 8
    for (int i = 0; i < 32; ++i) { const int kk = 2 * i + (lane >> 5); float v = W[(size_t)(k0 + kk) * N + n0 + (lane & 31)]; if (g) v *= g[k0 + kk]; scr[kk * 33 + (lane & 31)] = v; }
    LDS_WAIT(); asm volatile("" ::: "memory");
    const int c = lane & 7;
#pragma unroll
    for (int j = 0; j < 4; ++j) { const int n = (lane >> 3) + 8 * j; const LAS float* s = scr + (8 * c) * 33 + n;
        v4u o; o.x = pk2(s[0 * 33], s[1 * 33]); o.y = pk2(s[2 * 33], s[3 * 33]); o.z = pk2(s[4 * 33], s[5 * 33]); o.w = pk2(s[6 * 33], s[7 * 33]);
        *(GAS v4u*)(WT + (size_t)(n0 + n) * K + k0 + 8 * c) = o; }
    LDS_WAIT(); asm volatile("" ::: "memory");
}
__device__ __forceinline__ void rms_row_bf16(const float* xrow, const float* g, bf16* orow, int lane) {
    const GAS f32x4* xr = (const GAS f32x4*)xrow + lane; const GAS f32x4* gr = (const GAS f32x4*)g + lane;
    f32x4 v[4]; float s = 0.f;
#pragma unroll
    for (int j = 0; j < 4; ++j) { v[j] = xr[64 * j]; s += (v[j].x * v[j].x + v[j].y * v[j].y) + (v[j].z * v[j].z + v[j].w * v[j].w); }
    const float rs = 1.0f / sqrtf(wave_sum(s) * (1.f / D) + EPS);
    GAS v2u* o8 = (GAS v2u*)orow + lane;
#pragma unroll
    for (int j = 0; j < 4; ++j) { const f32x4 gg = gr[64 * j]; v2u w; w.x = pk2(v[j].x * rs * gg.x, v[j].y * rs * gg.y); w.y = pk2(v[j].z * rs * gg.z, v[j].w * rs * gg.w); o8[64 * j] = w; }
}
__device__ __forceinline__ void rms_row_final(float* xrow, const bf16* x1row, const bf16* slabrow, const float* g, int lane) {
    GAS f32x4* xr = (GAS f32x4*)xrow + lane; const GAS f32x4* gr = (const GAS f32x4*)g + lane;
    f32x4 v[4]; float s = 0.f;
    if (x1row == nullptr) {
#pragma unroll
        for (int j = 0; j < 4; ++j) v[j] = xr[64 * j];
    } else {
#pragma unroll
        for (int j = 0; j < 4; ++j) { v[j] = ld_bf16x4(x1row + 4 * lane + 256 * j);
#pragma unroll
            for (int sl = 0; sl < KSPLIT; ++sl) v[j] = v[j] + ld_bf16x4(slabrow + (size_t)sl * MS * D + 4 * lane + 256 * j); }
    }
#pragma unroll
    for (int j = 0; j < 4; ++j) s += (v[j].x * v[j].x + v[j].y * v[j].y) + (v[j].z * v[j].z + v[j].w * v[j].w);
    const float rs = 1.0f / sqrtf(wave_sum(s) * (1.f / D) + EPS);
#pragma unroll
    for (int j = 0; j < 4; ++j) { const f32x4 gg = gr[64 * j]; xr[64 * j] = v[j] * rs * gg; }
}
__device__ __forceinline__ void p0_prologue(const Args& A, LAS unsigned char* lds, int gw, int NGW, int wave, int lane) {
    LAS float* scr = (LAS float*)(lds + RING_OFF + wave * 16384);
    unsigned char* ws = A.ws;
    constexpr int I_IN = (D / 64) * (DIN / 32), I_OUT = (D / 64) * (D / 32), I_UP = (D / 64) * (FF / 32), I_DN = (FF / 64) * (D / 32);
    constexpr int NITEMS = I_IN + I_OUT + I_UP + I_DN;
    for (int it = gw; it < NITEMS; it += NGW) {
        int r = it;
        if (r < I_IN) { p0_transpose_item(A.w_in, nullptr, D, DIN, (bf16*)(ws + WS_WIN), scr, r, lane); continue; } r -= I_IN;
        if (r < I_OUT) { p0_transpose_item(A.w_out, nullptr, D, D, (bf16*)(ws + WS_WOUT), scr, r, lane); continue; } r -= I_OUT;
        if (r < I_UP) { p0_transpose_item(A.w_up, A.g2, D, FF, (bf16*)(ws + WS_WUP), scr, r, lane); continue; } r -= I_UP;
        p0_transpose_item(A.w_down, nullptr, FF, D, (bf16*)(ws + WS_WDN), scr, r, lane);
    }
    for (int idx = gw; idx < 128; idx += NGW) {
        const int hd = idx >> 4, gate = (idx >> 3) & 1, jt = (idx >> 1) & 3, ks = idx & 1, jj = lane & 15, qa = lane >> 4;
        const float* W = (gate ? A.lru_wx : A.lru_wa) + hd * 4096 + 32 * (jt >> 1) + 8 * (jj >> 2) + 4 * (jt & 1) + (jj & 3);
        float v[8];
#pragma unroll
        for (int e = 0; e < 8; ++e) v[e] = W[(32 * ks + 8 * qa + e) * 64];
        v4u o; o.x = pk2(v[0], v[1]); o.y = pk2(v[2], v[3]); o.z = pk2(v[4], v[5]); o.w = pk2(v[6], v[7]);
        *(GAS v4u*)((bf16*)(ws + WS_GW) + (size_t)idx * 512 + lane * 8) = o;
    }
    if (gw >= NGW - 8) {
        const int hd = NGW - 1 - gw, c = hd * 64 + lane; float* hc = (float*)(ws + WS_HC) + hd * 704 + lane;
#pragma unroll
        for (int k = 0; k < 4; ++k) hc[k * 64] = A.lru_conv_w[k * 512 + c];
        hc[256] = A.lru_conv_b[c]; hc[320] = A.lru_ba[c]; hc[384] = A.lru_bx[c];
        { const float x = A.lru_a_param[c]; hc[448] = x > 20.f ? x : log1pf(expf(x)); }
#pragma unroll
        for (int k = 0; k < 3; ++k) hc[512 + k * 64] = A.conv_a_w[k * 512 + c];
    }
    for (int m = gw; m < M; m += NGW) rms_row_bf16(m < MP ? A.xp + (size_t)m * D : A.xs + (size_t)(m - MP) * D, A.g1, (bf16*)(ws + WS_XN) + (size_t)m * D, lane);
}
typedef __amdgpu_buffer_rsrc_t rsrc_t;
struct f32x8 { f32x4 lo, hi; };
__device__ __forceinline__ f32x8 bld_bf16x8(rsrc_t r, int voff, int soff) { const v4u w = __builtin_amdgcn_raw_buffer_load_b128(r, voff, soff, 0); f32x8 o;
    o.lo.x = __uint_as_float(w.x << 16); o.lo.y = __uint_as_float(w.x & 0xffff0000u); o.lo.z = __uint_as_float(w.y << 16); o.lo.w = __uint_as_float(w.y & 0xffff0000u);
    o.hi.x = __uint_as_float(w.z << 16); o.hi.y = __uint_as_float(w.z & 0xffff0000u); o.hi.z = __uint_as_float(w.w << 16); o.hi.w = __uint_as_float(w.w & 0xffff0000u); return o; }
__device__ __forceinline__ v4u pack_bf16x8(f32x4 lo, f32x4 hi) { v4u w; w.x = pg8::cvt_pk_bf16(lo.x, lo.y); w.y = pg8::cvt_pk_bf16(lo.z, lo.w); w.z = pg8::cvt_pk_bf16(hi.x, hi.y); w.w = pg8::cvt_pk_bf16(hi.z, hi.w); return w; }
__device__ __forceinline__ f32x4 ld_bf16x4_buf(rsrc_t r, int voff, int soff) { const v2u w = __builtin_amdgcn_raw_buffer_load_b64(r, voff, soff, 0); f32x4 o; o.x = __uint_as_float(w.x << 16); o.y = __uint_as_float(w.x & 0xffff0000u); o.z = __uint_as_float(w.y << 16); o.w = __uint_as_float(w.y & 0xffff0000u); return o; }
__device__ __forceinline__ void st_bf16x4_buf(rsrc_t r, int voff, int soff, f32x4 v) { v2u w; w.x = pg8::cvt_pk_bf16(v.x, v.y); w.y = pg8::cvt_pk_bf16(v.z, v.w); __builtin_amdgcn_raw_buffer_store_b64(w, r, voff, soff, 0); }
__device__ __forceinline__ f32x4 bld_f32x4(rsrc_t r, int voff, int soff) { return __builtin_bit_cast(f32x4, __builtin_amdgcn_raw_buffer_load_b128(r, voff, soff, 0)); }
#define MEMFENCE() asm volatile("" ::: "memory")
__device__ __forceinline__ f32x4 exp2v(f32x4 x) { f32x4 r; r.x = __builtin_amdgcn_exp2f(x.x); r.y = __builtin_amdgcn_exp2f(x.y); r.z = __builtin_amdgcn_exp2f(x.z); r.w = __builtin_amdgcn_exp2f(x.w); return r; }
__device__ __forceinline__ f32x4 rcpv(f32x4 x) { f32x4 r; r.x = __builtin_amdgcn_rcpf(x.x); r.y = __builtin_amdgcn_rcpf(x.y); r.z = __builtin_amdgcn_rcpf(x.z); r.w = __builtin_amdgcn_rcpf(x.w); return r; }
__device__ __forceinline__ f32x4 sqrtv(f32x4 x) { f32x4 r; r.x = __builtin_amdgcn_sqrtf(x.x); r.y = __builtin_amdgcn_sqrtf(x.y); r.z = __builtin_amdgcn_sqrtf(x.z); r.w = __builtin_amdgcn_sqrtf(x.w); return r; }
__device__ __forceinline__ float bcast15(float v) { return __builtin_bit_cast(float, __builtin_amdgcn_update_dpp(0, __builtin_bit_cast(int, v), 0x15F, 0xf, 0xf, false)); }
#define KS4_STEP(S) \
    "v_fmac_f32_dpp %4, %4, %0 row_shr:" #S " row_mask:0xf bank_mask:0xf\n\tv_fmac_f32_dpp %5, %5, %1 row_shr:" #S " row_mask:0xf bank_mask:0xf\n\t" \
    "v_fmac_f32_dpp %6, %6, %2 row_shr:" #S " row_mask:0xf bank_mask:0xf\n\tv_fmac_f32_dpp %7, %7, %3 row_shr:" #S " row_mask:0xf bank_mask:0xf\n\t" \
    "v_mul_f32_dpp %0, %0, %0 row_shr:" #S " row_mask:0xf bank_mask:0xf\n\tv_mul_f32_dpp %1, %1, %1 row_shr:" #S " row_mask:0xf bank_mask:0xf\n\t" \
    "v_mul_f32_dpp %2, %2, %2 row_shr:" #S " row_mask:0xf bank_mask:0xf\n\tv_mul_f32_dpp %3, %3, %3 row_shr:" #S " row_mask:0xf bank_mask:0xf\n\t"
__device__ __forceinline__ void scan16x4(f32x4& a, f32x4& b) {
    float a0 = a.x, a1 = a.y, a2 = a.z, a3 = a.w, b0 = b.x, b1 = b.y, b2 = b.z, b3 = b.w;
    asm("s_nop 1\n\t" KS4_STEP(1) KS4_STEP(2) KS4_STEP(4) KS4_STEP(8) "s_nop 1" : "+v"(a0), "+v"(a1), "+v"(a2), "+v"(a3), "+v"(b0), "+v"(b1), "+v"(b2), "+v"(b3));
    a = (f32x4){a0, a1, a2, a3}; b = (f32x4){b0, b1, b2, b3};
}
#define KS_STEP(S, a, b) { const float ap_ = dpp_shr<S>(a, 1.0f), bp_ = dpp_shr<S>(b, 0.0f); b = fmaf(a, bp_, b); a = a * ap_; }
struct LruState { f32x4 hl[2][2][4], acp[2][2][4]; };
#define LDC(arr, off) bld_f32x4(rC, vc, (arr) * 256 + (off))
#define LDG(gate, jt, ks) __builtin_bit_cast(bf16x8, __builtin_amdgcn_raw_buffer_load_b128(rC, vg, (((gate) * 4 + (jt)) * 2 + (ks)) * 1024, 0))
template <bool SAMPLE>
__device__ __forceinline__ void conv_front(const Args& A, rsrc_t rP, rsrc_t rC, int ck, int hd, int lane, bool write_lc, f32x8 (&cl)[4][2], bf16x8 (&bfr)[4][2]) {
    const int tl = lane & 15, q = lane >> 4, vc = 131072 + hd * 2816 + q * 32;
    const bool first = SAMPLE || ((ck & 63) == 0), lastc = SAMPLE || ((ck & 63) == 63);
    const int sb = SAMPLE ? ck - NPCHUNK : ck >> 6, row0 = ck * 64, cb = hd * 64 + 8 * q, vb0 = ((row0 + tl) * DIN + cb) * 2;
#pragma unroll
    for (int ks = 0; ks < 2; ++ks) {
        const int c = cb + 32 * ks;
        f32x4 wl[4], wh[4];
#pragma unroll
        for (int k = 0; k < 4; ++k) { wl[k] = LDC(k, ks * 128); wh[k] = LDC(k, ks * 128 + 16); }
        const f32x4 bl = LDC(4, ks * 128), bh = LDC(4, ks * 128 + 16);
#pragma unroll
        for (int m = 0; m < 4; ++m) {
            f32x8 x[4];
#pragma unroll
            for (int k = 0; k < 4; ++k) {
                if (m > 0 || k == 3) x[k] = bld_bf16x8(rP, vb0, ((16 * m - 3 + k) * DIN + 1536 + 32 * ks) * 2);
                else { const int tk = tl - 3 + k;
                    if (!first || tk >= 0) x[k] = bld_bf16x8(rP, vb0 - (3 - k) * DIN * 2, (1536 + 32 * ks) * 2);
                    else if (SAMPLE) { const float* p = A.st_lc + (size_t)(sb * 3 + 3 + tk) * 512 + c; x[k].lo = *(const f32x4*)p; x[k].hi = *(const f32x4*)(p + 4); }
                    else { x[k].lo = (f32x4){0.f, 0.f, 0.f, 0.f}; x[k].hi = x[k].lo; } } }
            cl[m][ks].lo = bl + wl[0] * x[0].lo + wl[1] * x[1].lo + wl[2] * x[2].lo + wl[3] * x[3].lo;
            cl[m][ks].hi = bh + wh[0] * x[0].hi + wh[1] * x[1].hi + wh[2] * x[2].hi + wh[3] * x[3].hi;
            if (m == 3) { if (write_lc && lastc && tl >= 13) { float* p = A.out + (SAMPLE ? O_LCS : O_LCP) + (size_t)(sb * 3 + tl - 13) * 512 + c; *(f32x4*)p = x[3].lo; *(f32x4*)(p + 4) = x[3].hi; } }
        }
        asm volatile("" : "+v"(cl[0][ks].lo), "+v"(cl[0][ks].hi), "+v"(cl[1][ks].lo), "+v"(cl[1][ks].hi), "+v"(cl[2][ks].lo), "+v"(cl[2][ks].hi), "+v"(cl[3][ks].lo), "+v"(cl[3][ks].hi) :: "memory");
    }
#pragma unroll
    for (int m = 0; m < 4; ++m)
#pragma unroll
        for (int ks = 0; ks < 2; ++ks) bfr[m][ks] = __builtin_bit_cast(bf16x8, pack_bf16x8(cl[m][ks].lo, cl[m][ks].hi));
}
__device__ __forceinline__ void gate_tile(const bf16x8 (&bm)[2], bf16x8 ar0, bf16x8 ar1, bf16x8 ai0, bf16x8 ai1, f32x4 ba4, f32x4 bx4, f32x4 spl, f32x4 sp16, f32x4 clv, bool reset, f32x4& a, f32x4& b) {
    f32x4 zr = {0.f, 0.f, 0.f, 0.f}, zi = {0.f, 0.f, 0.f, 0.f};
    zr = __builtin_amdgcn_mfma_f32_16x16x32_bf16(ar0, bm[0], zr, 0, 0, 0); zr = __builtin_amdgcn_mfma_f32_16x16x32_bf16(ar1, bm[1], zr, 0, 0, 0);
    zi = __builtin_amdgcn_mfma_f32_16x16x32_bf16(ai0, bm[0], zi, 0, 0, 0); zi = __builtin_amdgcn_mfma_f32_16x16x32_bf16(ai1, bm[1], zi, 0, 0, 0);
    const f32x4 rr = rcpv(exp2v((zr + ba4) * (-1.44269504089f)) + 1.0f), ii = rcpv(exp2v((zi + bx4) * (-1.44269504089f)) + 1.0f);
    a = exp2v(rr * spl); const f32x4 x2 = rr * sp16;
    f32x4 t = 1.0f - a * a; const f32x4 tp = -x2 * (1.0f + x2 * (0.5f + x2 * (1.0f / 6.0f)));
#pragma unroll
    for (int r = 0; r < 4; ++r) t[r] = x2[r] > -0.02f ? tp[r] : t[r];
    f32x4 mult = sqrtv(t);
    if (reset) mult = (f32x4){1.f, 1.f, 1.f, 1.f};
    b = mult * (ii * clv);
    scan16x4(a, b);
}
__device__ __forceinline__ f32x4 bcast15v(f32x4 v) { return (f32x4){bcast15(v.x), bcast15(v.y), bcast15(v.z), bcast15(v.w)}; }
__device__ __forceinline__ f32x4 gelu_gate(f32x4 g) { return g * rcpv(exp2v((g + 0.044715f * g * g * g) * (-1.5957691216f * 1.44269504089f)) + 1.0f); }

__device__ __forceinline__ void mix_pre(const Args& A, rsrc_t rP, rsrc_t rC, rsrc_t rS, int ck, int hd, int lane, LruState& st) {
    const int tl = lane & 15, q = lane >> 4, vg = hd * 16384 + lane * 16, vc = 131072 + hd * 2816 + q * 32, cb = hd * 64 + 8 * q;
    f32x8 cl[4][2]; bf16x8 bfr[4][2];
    conv_front<false>(A, rP, rC, ck, hd, lane, true, cl, bfr);
    const bool reset0 = ((ck & 63) == 0) && tl == 0;
#pragma unroll
    for (int ks = 0; ks < 2; ++ks)
#pragma unroll
        for (int jj = 0; jj < 2; ++jj) {
            const int jt = 2 * ks + jj;
            const bf16x8 ar0 = LDG(0, jt, 0), ar1 = LDG(0, jt, 1), ai0 = LDG(1, jt, 0), ai1 = LDG(1, jt, 1);
            const f32x4 ba4 = LDC(5, ks * 128 + jj * 16), bx4 = LDC(6, ks * 128 + jj * 16), sp4 = LDC(7, ks * 128 + jj * 16);
            const f32x4 spl = sp4 * (-8.0f * 1.44269504089f), sp16 = sp4 * (-16.0f);
            f32x4 hc = {0.f, 0.f, 0.f, 0.f}, ac = {1.f, 1.f, 1.f, 1.f};
#pragma unroll
            for (int m = 0; m < 4; ++m) {
                f32x4 a, b; gate_tile(bfr[m], ar0, ar1, ai0, ai1, ba4, bx4, spl, sp16, jj ? cl[m][ks].hi : cl[m][ks].lo, m == 0 && reset0, a, b);
                const f32x4 h = a * hc + b, ap = a * ac;
                st.hl[ks][jj][m] = h; st.acp[ks][jj][m] = ap;
                hc = bcast15v(h); ac = bcast15v(ap);
            }
            if (tl == 0) { __builtin_amdgcn_raw_buffer_store_b128(__builtin_bit_cast(v4u, ac), rS, cb * 4, ck * 4096 + (32 * ks + 4 * jj) * 4, 0); __builtin_amdgcn_raw_buffer_store_b128(__builtin_bit_cast(v4u, hc), rS, cb * 4, ck * 4096 + 2048 + (32 * ks + 4 * jj) * 4, 0); }
            MEMFENCE();
        }
}
template <bool SAMPLE>
__device__ __forceinline__ void mixa_half(const Args& A, rsrc_t rP, rsrc_t rM, rsrc_t rC, int ck, int hd, int lane, int ks) {
    const int tl = lane & 15, q = lane >> 4, vc = 131072 + hd * 2816 + q * 32;
    const bool first = SAMPLE || ((ck & 63) == 0), lastc = SAMPLE || ((ck & 63) == 63);
    const int sb = SAMPLE ? ck - NPCHUNK : ck >> 6, row0 = ck * 64, cb = hd * 64 + 8 * q, vb0 = ((row0 + tl) * DIN + cb) * 2 + 64 * ks, mb0 = ((row0 + tl) * D + cb) * 2 + 64 * ks, c = cb + 32 * ks;
    f32x4 wl[3], wh[3];
#pragma unroll
    for (int k = 0; k < 3; ++k) { wl[k] = bld_f32x4(rC, vc + ks * 128, (8 + k) * 256); wh[k] = bld_f32x4(rC, vc + ks * 128, (8 + k) * 256 + 16); }
    v4u ow[4];
#pragma unroll
    for (int m = 0; m < 4; ++m) {
        f32x8 u[3];
#pragma unroll
        for (int k = 0; k < 3; ++k) {
            if (m > 0 || k == 2) { const int so = ((16 * m - 2 + k) * DIN) * 2; const f32x8 gc = bld_bf16x8(rP, vb0, so + 1024), xa = bld_bf16x8(rP, vb0, so + 2048); u[k].lo = gc.lo * xa.lo; u[k].hi = gc.hi * xa.hi; }
            else { const int tk = tl - 2 + k;
                if (!first || tk >= 0) { const int vo = vb0 - (2 - k) * DIN * 2; const f32x8 gc = bld_bf16x8(rP, vo, 1024), xa = bld_bf16x8(rP, vo, 2048); u[k].lo = gc.lo * xa.lo; u[k].hi = gc.hi * xa.hi; }
                else if (SAMPLE) { const float* p = A.st_ca + (size_t)(sb * 2 + 2 + tk) * 512 + c; u[k].lo = *(const f32x4*)p; u[k].hi = *(const f32x4*)(p + 4); }
                else { u[k].lo = (f32x4){0.f, 0.f, 0.f, 0.f}; u[k].hi = u[k].lo; } } }
        const f32x8 gb = bld_bf16x8(rP, vb0, (16 * m * DIN) * 2);
        ow[m] = pack_bf16x8(gb.lo * (wl[0] * u[0].lo + wl[1] * u[1].lo + wl[2] * u[2].lo), gb.hi * (wh[0] * u[0].hi + wh[1] * u[1].hi + wh[2] * u[2].hi));
        if (m == 3) { if (lastc && tl >= 14) { float* p = A.out + (SAMPLE ? O_CAS : O_CAP) + (size_t)(sb * 2 + tl - 14) * 512 + c; *(f32x4*)p = u[2].lo; *(f32x4*)(p + 4) = u[2].hi; } }
    }
#pragma unroll
    for (int m = 0; m < 4; ++m) __builtin_amdgcn_raw_buffer_store_b128(ow[m], rM, mb0, (16 * m * D) * 2, 0);
    MEMFENCE();
}
__device__ __forceinline__ void mix_post(const Args& A, rsrc_t rP, rsrc_t rM, rsrc_t rC, rsrc_t rS, int ck, int hd, int lane, const LruState& st) {
    const int tl = lane & 15, q = lane >> 4, cb = hd * 64 + 8 * q, row0 = ck * 64;
    const bool lastc = (ck & 63) == 63; const int sb = ck >> 6;
    const int vb0 = ((row0 + tl) * DIN + cb) * 2, mb0 = ((row0 + tl) * D + cb) * 2;
    const int vs = cb * 4 + ((ck & ~63) + 4 * tl) * 4096;
#pragma unroll
    for (int ks = 0; ks < 2; ++ks) {
        f32x4 hv[4][2];
#pragma unroll
        for (int jj = 0; jj < 2; ++jj) {
            f32x4 pa = {1.f, 1.f, 1.f, 1.f}, sa = {0.f, 0.f, 0.f, 0.f};
#pragma unroll
            for (int u = 0; u < 4; ++u) { f32x4 pv = bld_f32x4(rS, vs, u * 4096 + (32 * ks + 4 * jj) * 4), sv = bld_f32x4(rS, vs, u * 4096 + 2048 + (32 * ks + 4 * jj) * 4);
                if ((ck & ~63) + 4 * tl + u >= ck) { pv = (f32x4){1.f, 1.f, 1.f, 1.f}; sv = (f32x4){0.f, 0.f, 0.f, 0.f}; }
                sa = pv * sa + sv; pa = pv * pa; }
            scan16x4(pa, sa);
            const f32x4 hc = bcast15v(sa);
#pragma unroll
            for (int m = 0; m < 4; ++m) hv[m][jj] = st.hl[ks][jj][m] + st.acp[ks][jj][m] * hc;
            if (lastc && tl == 15) *(f32x4*)(A.out + O_LHP + (size_t)sb * 512 + cb + 32 * ks + 4 * jj) = hv[3][jj];
        }
#pragma unroll
        for (int m = 0; m < 4; ++m) {
            const f32x8 g = bld_bf16x8(rP, vb0, (16 * m * DIN + 2048 + 32 * ks) * 2);
            __builtin_amdgcn_raw_buffer_store_b128(pack_bf16x8(hv[m][0] * gelu_gate(g.lo), hv[m][1] * gelu_gate(g.hi)), rM, mb0, (16 * m * D + 512 + 32 * ks) * 2, 0);
        }
        MEMFENCE();
    }
    mixa_half<false>(A, rP, rM, rC, ck, hd, lane, 0);
    mixa_half<false>(A, rP, rM, rC, ck, hd, lane, 1);
}
__device__ __forceinline__ void mix_sample_q(const Args& A, rsrc_t rP, rsrc_t rM, rsrc_t rC, int ck, int hd, int jsel, int lane) {
    const int tl = lane & 15, q = lane >> 4, vg = hd * 16384 + lane * 16, vc = 131072 + hd * 2816 + q * 32, cb = hd * 64 + 8 * q, row0 = ck * 64, sb = ck - NPCHUNK;
    f32x8 cl[4][2]; bf16x8 bfr[4][2];
    conv_front<true>(A, rP, rC, ck, hd, lane, jsel == 0, cl, bfr);
    const int ks = jsel >> 1, jj = jsel & 1, cq = cb + 32 * ks + 4 * jj;
    const int so = (jsel * 2) * 1024;
    const bf16x8 ar0 = __builtin_bit_cast(bf16x8, __builtin_amdgcn_raw_buffer_load_b128(rC, vg, so, 0)), ar1 = __builtin_bit_cast(bf16x8, __builtin_amdgcn_raw_buffer_load_b128(rC, vg, so + 1024, 0));
    const bf16x8 ai0 = __builtin_bit_cast(bf16x8, __builtin_amdgcn_raw_buffer_load_b128(rC, vg, so + 8192, 0)), ai1 = __builtin_bit_cast(bf16x8, __builtin_amdgcn_raw_buffer_load_b128(rC, vg, so + 8192 + 1024, 0));
    const int co = ks * 128 + jj * 16;
    const f32x4 ba4 = bld_f32x4(rC, vc, 5 * 256 + co), bx4 = bld_f32x4(rC, vc, 6 * 256 + co), sp4 = bld_f32x4(rC, vc, 7 * 256 + co);
    const f32x4 spl = sp4 * (-8.0f * 1.44269504089f), sp16 = sp4 * (-16.0f);
    f32x4 hc = *(const f32x4*)(A.st_lh + (size_t)sb * 512 + cq);
    const int vb0 = ((row0 + tl) * DIN + cq) * 2, mb0 = ((row0 + tl) * D + cq) * 2;
#pragma unroll
    for (int m = 0; m < 4; ++m) {
        f32x4 clv;
        { const f32x4 c00 = cl[m][0].lo, c01 = cl[m][0].hi, c10 = cl[m][1].lo, c11 = cl[m][1].hi; clv = ks ? (jj ? c11 : c10) : (jj ? c01 : c00); }
        f32x4 a, b; gate_tile(bfr[m], ar0, ar1, ai0, ai1, ba4, bx4, spl, sp16, clv, false, a, b);
        const f32x4 h = a * hc + b; hc = bcast15v(h);
        const f32x4 g = ld_bf16x4_buf(rP, vb0, (16 * m * DIN + 2048) * 2);
        st_bf16x4_buf(rM, mb0, (16 * m * D + 512) * 2, h * gelu_gate(g));
    }
    if (tl == 15) *(f32x4*)(A.out + O_LHS + (size_t)sb * 512 + cq) = hc;
    if (jsel < 2) mixa_half<true>(A, rP, rM, rC, ck, hd, lane, jsel);
}
#undef LDC
#undef LDG
constexpr int N_PHASES = 8;
__global__ void __launch_bounds__(NWAVES * 64, 2) fwd_kernel(Args args) {
    extern __shared__ __attribute__((aligned(16))) unsigned char lds_raw[];
    LAS unsigned char* lds = (LAS unsigned char*)lds_raw;
    const int tid = threadIdx.x, lane = tid & 63, wave = __builtin_amdgcn_readfirstlane(tid >> 6);
    const int G = gridDim.x, bx = blockIdx.x, vcu = (G % 8 == 0) ? (bx % 8) * (G / 8) + bx / 8 : bx;
    const int gw = vcu * NWAVES + wave, NGW = G * NWAVES;
    unsigned char* ws = args.ws;
#if MK_MODE == 2
    volatile LAS unsigned* MISC = (volatile LAS unsigned*)(lds + MISC_OFF);
    for (int u = tid; u < (LDS_BYTES - LDSCTL_OFF) / 4; u += NWAVES * 64) ((LAS unsigned*)(lds + LDSCTL_OFF))[u] = 0u;
    __syncthreads();
    XcdBarrier bar = xcd_barrier_post((unsigned*)(ws + WS_CTL) + CW_BAR, MISC + 8);
#define GRID_BAR() xcd_barrier(bar)
#elif MK_MODE == 0
    cg::grid_group grid = cg::this_grid();
#define GRID_BAR() grid.sync()
#else
#define GRID_BAR() do {} while (0)
#endif
    const int lo = args.ph_lo, hi = args.ph_hi;
#ifndef PH_MASK
#define PH_MASK 0xff
#endif
#define IN(k) (((PH_MASK >> (k)) & 1) && lo <= (k) && (k) < hi)
#define SEAM(k) do { if (IN(k) && IN((k) + 1)) GRID_BAR(); } while (0)

#ifndef PH_REP
#define PH_REP 0
#endif
#define REPS(k) (1 + ((PH_REP >> (k)) & 1))
    if (IN(0)) for (int rep = 0; rep < REPS(0); ++rep) { if (rep) GRID_BAR(); p0_prologue(args, lds, gw, NGW, wave, lane); }
    SEAM(0);
    if (IN(1)) for (int rep = 0; rep < REPS(1); ++rep) {
        if (rep) GRID_BAR();
        pg8::Gemm g{(const bf16*)(ws + WS_XN), (const bf16*)(ws + WS_WIN), M, DIN, D, D, 1}; pg8::StaticOrder S; S.init(M, DIN, G, bx);
        pg8::EpiProj E{(bf16*)(ws + WS_PROJ), DIN};
        pg8::gemm_phase<pg8::EpiProj, pg8::StaticOrder, PG8_ALIGN, PG8_SP2>(lds + RING_OFF, g, S, E);
    }
    SEAM(1);
    const rsrc_t rP = __builtin_amdgcn_make_buffer_rsrc((void*)(ws + WS_PROJ), 0, (int)((size_t)M * DIN * 2), 0x00020000), rM = __builtin_amdgcn_make_buffer_rsrc((void*)(ws + WS_MIX), 0, (int)((size_t)M * D * 2), 0x00020000),
        rC = __builtin_amdgcn_make_buffer_rsrc((void*)(ws + WS_GW), 0, 131072 + 8 * 2816, 0x00020000), rS = __builtin_amdgcn_make_buffer_rsrc((void*)(ws + WS_SUM), 0, NPCHUNK * 4096, 0x00020000);
    {
        LruState st;
        if (IN(2) && G == 256) mix_pre(args, rP, rC, rS, vcu, wave, lane, st);
        SEAM(2);
        if (IN(3) && G == 256) { mix_post(args, rP, rM, rC, rS, vcu, wave, lane, st); if (wave < 4) mix_sample_q(args, rP, rM, rC, NPCHUNK + (vcu >> 3), vcu & 7, wave, lane); }
        SEAM(3);
    }
    if (IN(4)) for (int rep = 0; rep < REPS(4); ++rep) {
        if (rep) GRID_BAR();
        pg8::Gemm g{(const bf16*)(ws + WS_MIX), (const bf16*)(ws + WS_WOUT), M, D, D, D, 1}; pg8::StaticOrder S; S.init(M, D, G, bx);
        pg8::EpiX1 E{args.xp, args.xs, (bf16*)(ws + WS_X1B), (float*)(ws + WS_SS)};
        pg8::gemm_phase<pg8::EpiX1, pg8::StaticOrder, PG8_ALIGN, PG8_SP2>(lds + RING_OFF, g, S, E);
    }
    SEAM(4);
    if (IN(5)) for (int rep = 0; rep < REPS(5); ++rep) {
        if (rep) GRID_BAR();
        pg8::Gemm g{(const bf16*)(ws + WS_X1B), (const bf16*)(ws + WS_WUP), M, FF, D, D, 1}; pg8::StaticOrder S; S.init(M, FF, G, bx);
        pg8::EpiUp E{(bf16*)(ws + WS_H), (const float*)(ws + WS_SS), EPS};
        pg8::gemm_phase<pg8::EpiUp, pg8::StaticOrder, PG8_ALIGN, PG8_SP2>(lds + RING_OFF, g, S, E);
    }
    SEAM(5);
    if (IN(6)) {
        { pg8::Gemm g{(const bf16*)(ws + WS_H), (const bf16*)(ws + WS_WDN), MP, D, FF, FF, 1}; pg8::StaticOrder S; S.init(MP, D, G, bx);
          pg8::EpiDown E{args.out, (const bf16*)(ws + WS_X1B)};
          pg8::gemm_phase<pg8::EpiDown, pg8::StaticOrder, PG8_ALIGN, PG8_SP2>(lds + RING_OFF, g, S, E); }
        { pg8::Gemm g{(const bf16*)(ws + WS_H) + (size_t)MP * FF, (const bf16*)(ws + WS_WDN), MS, D, FF / KSPLIT, FF, KSPLIT}; pg8::StaticOrder S; S.init(MS, D, G, bx, KSPLIT);
          pg8::EpiSlab E{(bf16*)(ws + WS_SLAB), MS};
          pg8::gemm_phase<pg8::EpiSlab, pg8::StaticOrder, PG8_ALIGN, PG8_SP2>(lds + RING_OFF, g, S, E); }
    }
    SEAM(6);
    if (IN(7)) { for (int m = gw; m < M; m += NGW) rms_row_final(args.out + (size_t)m * D, m < MP ? nullptr : (const bf16*)(ws + WS_X1B) + (size_t)m * D, (const bf16*)(ws + WS_SLAB) + (size_t)(m < MP ? 0 : m - MP) * D, args.gf, lane); }
#undef IN
#undef SEAM
}

extern "C" void kernel_launch(void* const* d_in, const int* in_sizes, int n_in, void* d_out, int out_size, void* d_ws, size_t ws_size, hipStream_t stream) {
    static int grid = 0;
    if (grid == 0) {
        if (n_in != 20 || out_size != (int)O_END || ws_size < WS_END) { fprintf(stderr, "kernel_launch: unexpected shapes (n_in %d out %d ws %zu)\n", n_in, out_size, ws_size); grid = -1; return; }
        int dev = 0, cus = 0, per_cu = 0;
        if (hipGetDevice(&dev) != hipSuccess || hipDeviceGetAttribute(&cus, hipDeviceAttributeMultiprocessorCount, dev) != hipSuccess) { grid = -1; return; }
        if (hipFuncSetAttribute((const void*)fwd_kernel, hipFuncAttributeMaxDynamicSharedMemorySize, LDS_BYTES) != hipSuccess) { fprintf(stderr, "kernel_launch: hipFuncSetAttribute failed\n"); grid = -1; return; }
        if (hipOccupancyMaxActiveBlocksPerMultiprocessor(&per_cu, (const void*)fwd_kernel, NWAVES * 64, LDS_BYTES) != hipSuccess || per_cu < 1) { fprintf(stderr, "kernel_launch: occupancy query says %d blocks per CU\n", per_cu); per_cu = 1; }
        (void)hipGetLastError();
        grid = cus;
    }
    if (grid < 0) return;
    Args a{};
    a.xp = (const float*)d_in[0]; a.xs = (const float*)d_in[1]; a.st_ca = (const float*)d_in[2]; a.st_lc = (const float*)d_in[3]; a.st_lh = (const float*)d_in[4]; a.g1 = (const float*)d_in[5];
    a.w_in = (const float*)d_in[6]; a.conv_a_w = (const float*)d_in[7]; a.lru_conv_w = (const float*)d_in[8]; a.lru_conv_b = (const float*)d_in[9]; a.lru_wa = (const float*)d_in[10];
    a.lru_ba = (const float*)d_in[11]; a.lru_wx = (const float*)d_in[12]; a.lru_bx = (const float*)d_in[13]; a.lru_a_param = (const float*)d_in[14]; a.w_out = (const float*)d_in[15];
    a.g2 = (const float*)d_in[16]; a.w_up = (const float*)d_in[17]; a.w_down = (const float*)d_in[18]; a.gf = (const float*)d_in[19]; a.out = (float*)d_out; a.ws = (unsigned char*)d_ws;
#if MK_MODE == 1
    for (int p = 0; p < N_PHASES; ++p) { a.ph_lo = p; a.ph_hi = p + 1; hipLaunchKernelGGL(fwd_kernel, dim3(grid), dim3(NWAVES * 64), LDS_BYTES, stream, a); }
#elif MK_MODE == 0
    a.ph_lo = 0; a.ph_hi = N_PHASES;
    void* kargs[] = {&a};
    hipError_t e = hipLaunchCooperativeKernel((const void*)fwd_kernel, dim3(grid), dim3(NWAVES * 64), kargs, LDS_BYTES, stream);
    if (e != hipSuccess) fprintf(stderr, "kernel_launch: cooperative launch failed: %s (grid %d)\n", hipGetErrorString(e), grid);
#else
    if (hipMemsetAsync((char*)d_ws + WS_CTL, 0, CTL_ZERO_BYTES, stream) != hipSuccess) { fprintf(stderr, "kernel_launch: memset failed\n"); return; }
    a.ph_lo = 0; a.ph_hi = N_PHASES;
    hipLaunchKernelGGL(fwd_kernel, dim3(grid), dim3(NWAVES * 64), LDS_BYTES, stream, a);
#endif
    const hipError_t le = hipPeekAtLastError();
    if (le != hipSuccess) fprintf(stderr, "kernel_launch: launch failed: %s\n", hipGetErrorName(le));
}
```
